# Optimizing an MI355X kernel written in HIP

```python
import math
import jax, jax.numpy as jnp
from jax import lax
import numpy as np

D_MODEL = 1024
BATCH = 8
SEQ = 2048
DEPTH = 1
DEC_BATCH = 32
DEC_SEQ = 16
PAST_LEN = 2048

CHUNK = 64
N_HEADS = 8
N_KV_HEADS = 2
HEAD_DIM = 64
GROUP = N_HEADS // N_KV_HEADS
ATT_WIDTH = N_HEADS * HEAD_DIM
KV_WIDTH = N_KV_HEADS * HEAD_DIM
N_IDX_HEADS = 8
IDX_DIM = 64
MAX_TOPK = 256
Q_BLOCK = 128
N_BUCKETS = 32
MAX_DISTANCE = 128
RW_HEADS = 8
RW_HEAD = 64
RW_WIDTH = RW_HEADS * RW_HEAD
DECAY_LORA = 64
AAA_LORA = 64
GATE_LORA = 128
GN_EPS = 64e-5
D_FF = 4 * D_MODEL
NORM_EPS = 1e-6
NEG = -1e30

RW_SPLITS = (RW_WIDTH, RW_WIDTH, RW_WIDTH, DECAY_LORA, AAA_LORA, GATE_LORA)
RW_COLS = sum(RW_SPLITS)
IN_SPLITS = (ATT_WIDTH, KV_WIDTH, KV_WIDTH, N_IDX_HEADS * IDX_DIM, IDX_DIM, N_IDX_HEADS,
             RW_COLS, D_MODEL, D_MODEL)
IN_COLS = sum(IN_SPLITS)

kernel_name = "dsa_rwkv7_gated_streaming_step"


def split_cols(a, sizes):
    offs = np.cumsum(sizes)[:-1].tolist()
    return jnp.split(a, offs, axis=-1)


def rms_norm(x, g):
    xf = x.astype(jnp.float32)
    y = xf * lax.rsqrt(jnp.mean(xf * xf, axis=-1, keepdims=True) + NORM_EPS)
    return (y * g.astype(jnp.float32)).astype(x.dtype)


def t5_bucket(rel):
    half = N_BUCKETS // 2
    max_exact = half // 2
    ret = jnp.where(rel > 0, half, 0)
    n = jnp.abs(rel)
    nf = jnp.maximum(n, 1).astype(jnp.float32)
    large = max_exact + (jnp.log(nf / max_exact) / math.log(MAX_DISTANCE / max_exact)
                         * (half - max_exact)).astype(jnp.int32)
    large = jnp.minimum(large, half - 1)
    return ret + jnp.where(n < max_exact, n, large)


def dsa_attention(q, q_idx, w_idx, k, v, k_idx, q_pos, k_pos, rel_bias):
    B, T = q.shape[0], q.shape[1]
    L = k.shape[1]
    topk = min(MAX_TOPK, L // 4)
    qb = Q_BLOCK if T % Q_BLOCK == 0 else T
    nb = T // qb
    k_chunk = k_pos // CHUNK

    def blocks(a):
        return jnp.moveaxis(a.reshape((B, nb, qb) + a.shape[2:]), 1, 0)

    def one_block(args):
        q_b, qi_b, wi_b, qp = args
        q_chunk = qp // CHUNK
        s = jnp.einsum('bqhd,bsd->bqhs', qi_b, k_idx,
                       preferred_element_type=jnp.float32) * (IDX_DIM ** -0.5)
        score = jnp.einsum('bqh,bqhs->bqs', wi_b.astype(jnp.float32), jax.nn.relu(s))
        adm = k_chunk[None, :] <= q_chunk[:, None]
        score = jnp.where(adm[None], score, NEG)
        _, idx = lax.top_k(score, topk)
        sel_pos = k_pos[idx]
        valid = (sel_pos // CHUNK) <= q_chunk[None, :, None]
        k_sel = jax.vmap(lambda kb, ib: kb[ib])(k, idx)
        v_sel = jax.vmap(lambda vb, ib: vb[ib])(v, idx)
        qg = q_b.reshape(B, qb, N_KV_HEADS, GROUP, HEAD_DIM)
        logits = jnp.einsum('bqjgd,bqnjd->bqjgn', qg, k_sel,
                            preferred_element_type=jnp.float32) * (HEAD_DIM ** -0.5)
        bias = rel_bias[t5_bucket(sel_pos - qp[None, :, None])]
        bias = jnp.moveaxis(bias.reshape(B, qb, topk, N_KV_HEADS, GROUP), 2, -1)
        logits = jnp.where(valid[:, :, None, None, :], logits + bias.astype(jnp.float32), NEG)
        probs = jax.nn.softmax(logits, axis=-1)
        o = jnp.einsum('bqjgn,bqnjd->bqjgd', probs.astype(v.dtype), v_sel)
        return o.reshape(B, qb, ATT_WIDTH)

    out = lax.map(one_block, (blocks(q), blocks(q_idx), blocks(w_idx), q_pos.reshape(nb, qb)))
    return jnp.moveaxis(out, 0, 1).reshape(B, T, ATT_WIDTH)


def rwkv7_mix(p_rw, shift0, wkv0, p):
    B, T = p_rw.shape[0], p_rw.shape[1]
    f32 = jnp.float32
    prev = jnp.concatenate([shift0.astype(p_rw.dtype), p_rw[:, :-1]], axis=1)
    xs = p_rw + (prev - p_rw) * p['mu_shift']
    r, k, v, wd, ad, gd = split_cols(xs, RW_SPLITS)
    w = -jax.nn.softplus(-(p['w0'] + jnp.tanh(wd) @ p['w_decay_up'])) - 0.5
    a = jax.nn.sigmoid(p['a0'] + ad @ p['w_a_up'])
    g = jax.nn.sigmoid(gd) @ p['w_g_up']

    def heads(t):
        return t.reshape(B, T, RW_HEADS, RW_HEAD).astype(f32)

    kk = heads(k * p['k_k'])
    kk = kk / jnp.maximum(jnp.sqrt(jnp.sum(kk * kk, axis=-1, keepdims=True)), 1e-12)
    a_h = heads(a)
    k_h = heads(k) * (1.0 + (a_h - 1.0) * heads(p['k_a'] * jnp.ones_like(k)))
    r_h, v_h = heads(r), heads(v)
    decay = jnp.exp(-jnp.exp(heads(w)))
    b_h = kk * a_h

    def step(S, inp):
        r_t, d_t, k_t, v_t, kk_t, b_t = inp
        sa = jnp.einsum('bhij,bhj->bhi', S, kk_t)
        S = (S * d_t[:, :, None, :] - sa[..., None] * b_t[:, :, None, :]
             + v_t[..., None] * k_t[:, :, None, :])
        return S, jnp.einsum('bhij,bhj->bhi', S, r_t)

    def tm(t):
        return jnp.moveaxis(t, 1, 0)

    S_T, ys = lax.scan(step, wkv0.astype(f32),
                       (tm(r_h), tm(decay), tm(k_h), tm(v_h), tm(kk), tm(b_h)))
    y = jnp.moveaxis(ys, 0, 1)
    mean = jnp.mean(y, axis=-1, keepdims=True)
    var = jnp.mean(jnp.square(y - mean), axis=-1, keepdims=True)
    yn = ((y - mean) * lax.rsqrt(var + GN_EPS)).reshape(B, T, RW_WIDTH)
    yn = yn * p['lnx_w'].astype(f32) + p['lnx_b'].astype(f32)
    bonus = jnp.sum(r_h * k_h * p['r_k'].astype(f32), axis=-1, keepdims=True) * v_h
    out = (yn + bonus.reshape(B, T, RW_WIDTH)) * g.astype(f32)
    return out.astype(p_rw.dtype), S_T.astype(wkv0.dtype)


def trunk_layer(x, k_hist, v_hist, kidx_hist, wkv0, shift0, rel_bias, p):
    B, T = x.shape[0], x.shape[1]
    past = k_hist.shape[1]
    h = rms_norm(x, p['norm1_g'])
    proj = h @ p['w_in']
    q, k, v, qi, ki, wi, p_rw, ga, gb = split_cols(proj, IN_SPLITS)
    q = q.reshape(B, T, N_HEADS, HEAD_DIM)
    k = k.reshape(B, T, N_KV_HEADS, HEAD_DIM)
    v = v.reshape(B, T, N_KV_HEADS, HEAD_DIM)
    qi = qi.reshape(B, T, N_IDX_HEADS, IDX_DIM)
    wi = wi * (N_IDX_HEADS ** -0.5)
    k_all = jnp.concatenate([k_hist.astype(k.dtype), k], axis=1)
    v_all = jnp.concatenate([v_hist.astype(v.dtype), v], axis=1)
    ki_all = jnp.concatenate([kidx_hist.astype(ki.dtype), ki], axis=1)
    k_pos = jnp.arange(past + T, dtype=jnp.int32)
    q_pos = past + jnp.arange(T, dtype=jnp.int32)
    att = dsa_attention(q, qi, wi, k_all, v_all, ki_all, q_pos, k_pos, rel_bias)
    z_a = att @ p['w_att_out']
    rw, wkv_T = rwkv7_mix(p_rw, shift0, wkv0, p)
    z_b = rw @ p['w_rw_out']
    mixed = jax.nn.sigmoid(ga) * z_a + jax.nn.sigmoid(gb) * z_b
    x = x + mixed @ p['w_out']
    h2 = rms_norm(x, p['norm2_g'])
    x = x + jnp.square(jax.nn.relu(h2 @ p['w_ff1'])) @ p['w_ff2']
    return x, (k, v, ki, wkv_T, p_rw[:, -1:])


def setup_inputs(seed: int = 0) -> dict:
    key = jax.random.key(seed)
    keys = iter(jax.random.split(key, 40))

    def nrm(shape, scale):
        return scale * jax.random.normal(next(keys), shape, jnp.float32)

    def unif(shape, lo, hi):
        return jax.random.uniform(next(keys), shape, jnp.float32, lo, hi)

    D = D_MODEL
    return {
        "x_prompt": nrm((BATCH, SEQ, D), 1.0),
        "x_sample": nrm((DEC_BATCH, DEC_SEQ, D), 1.0),
        "cache_k": nrm((DEPTH, DEC_BATCH, PAST_LEN, N_KV_HEADS, HEAD_DIM), 1.0),
        "cache_v": nrm((DEPTH, DEC_BATCH, PAST_LEN, N_KV_HEADS, HEAD_DIM), 1.0),
        "cache_kidx": nrm((DEPTH, DEC_BATCH, PAST_LEN, IDX_DIM), 1.0),
        "state_wkv": nrm((DEPTH, DEC_BATCH, RW_HEADS, RW_HEAD, RW_HEAD), 0.1),
        "state_shift": nrm((DEPTH, DEC_BATCH, 1, RW_COLS), 1.0),
        "rel_bias": nrm((N_BUCKETS, N_HEADS), 0.5),
        "norm1_g": 1.0 + nrm((DEPTH, D), 0.02),
        "w_in": nrm((DEPTH, D, IN_COLS), D ** -0.5),
        "w_att_out": nrm((DEPTH, ATT_WIDTH, D), ATT_WIDTH ** -0.5),
        "mu_shift": unif((DEPTH, RW_COLS), 0.0, 1.0),
        "w0": unif((DEPTH, RW_WIDTH), -6.0, 0.0),
        "w_decay_up": nrm((DEPTH, DECAY_LORA, RW_WIDTH), 0.1),
        "a0": nrm((DEPTH, RW_WIDTH), 0.1),
        "w_a_up": nrm((DEPTH, AAA_LORA, RW_WIDTH), AAA_LORA ** -0.5),
        "w_g_up": nrm((DEPTH, GATE_LORA, RW_WIDTH), GATE_LORA ** -0.5),
        "k_k": 0.85 + nrm((DEPTH, RW_WIDTH), 0.02),
        "k_a": 1.0 + nrm((DEPTH, RW_WIDTH), 0.02),
        "r_k": nrm((DEPTH, RW_HEADS, RW_HEAD), 0.1),
        "lnx_w": 1.0 + nrm((DEPTH, RW_WIDTH), 0.02),
        "lnx_b": nrm((DEPTH, RW_WIDTH), 0.01),
        "w_rw_out": nrm((DEPTH, RW_WIDTH, D), RW_WIDTH ** -0.5),
        "w_out": nrm((DEPTH, D, D), D ** -0.5),
        "norm2_g": 1.0 + nrm((DEPTH, D), 0.02),
        "w_ff1": nrm((DEPTH, D, D_FF), D ** -0.5),
        "w_ff2": nrm((DEPTH, D_FF, D), D_FF ** -0.5),
        "norm_f_g": 1.0 + nrm((D,), 0.02),
    }


def reference(x_prompt, x_sample, cache_k, cache_v, cache_kidx, state_wkv, state_shift,
              rel_bias, norm1_g, w_in, w_att_out, mu_shift, w0, w_decay_up, a0, w_a_up,
              w_g_up, k_k, k_a, r_k, lnx_w, lnx_b, w_rw_out, w_out, norm2_g, w_ff1, w_ff2,
              norm_f_g):
    xp, xs = x_prompt, x_sample
    Bp = x_prompt.shape[0]
    dt = x_prompt.dtype
    st_p = [[], [], [], [], []]
    st_s = [[], [], [], [], []]
    for l in range(DEPTH):
        p = dict(norm1_g=norm1_g[l], w_in=w_in[l], w_att_out=w_att_out[l], mu_shift=mu_shift[l],
                 w0=w0[l], w_decay_up=w_decay_up[l], a0=a0[l], w_a_up=w_a_up[l],
                 w_g_up=w_g_up[l], k_k=k_k[l], k_a=k_a[l], r_k=r_k[l], lnx_w=lnx_w[l],
                 lnx_b=lnx_b[l], w_rw_out=w_rw_out[l], w_out=w_out[l], norm2_g=norm2_g[l],
                 w_ff1=w_ff1[l], w_ff2=w_ff2[l])
        xp, sp = trunk_layer(
            xp,
            jnp.zeros((Bp, 0, N_KV_HEADS, HEAD_DIM), dt),
            jnp.zeros((Bp, 0, N_KV_HEADS, HEAD_DIM), dt),
            jnp.zeros((Bp, 0, IDX_DIM), dt),
            jnp.zeros((Bp, RW_HEADS, RW_HEAD, RW_HEAD), dt),
            jnp.zeros((Bp, 1, RW_COLS), dt),
            rel_bias, p)
        xs, ss = trunk_layer(xs, cache_k[l], cache_v[l], cache_kidx[l], state_wkv[l],
                             state_shift[l], rel_bias, p)
        for i in range(5):
            st_p[i].append(sp[i])
            st_s[i].append(ss[i])
    y_prompt = rms_norm(xp, norm_f_g)
    y_sample = rms_norm(xs, norm_f_g)
    return (y_prompt, y_sample,
            jnp.stack(st_p[0]), jnp.stack(st_p[1]), jnp.stack(st_p[2]),
            jnp.stack(st_p[3]), jnp.stack(st_p[4]),
            jnp.stack(st_s[0]), jnp.stack(st_s[1]), jnp.stack(st_s[2]),
            jnp.stack(st_s[3]), jnp.stack(st_s[4]))
```

```cpp
#include <hip/hip_runtime.h>
#include <cstdio>
#include <cstdint>
namespace pg8 {
#define PG8_LAS __attribute__((address_space(3)))
typedef unsigned short bf16_t;
typedef short bf16x8 __attribute__((ext_vector_type(8)));
typedef float f32x4 __attribute__((ext_vector_type(4)));
typedef unsigned u32x4 __attribute__((ext_vector_type(4)));
typedef unsigned u32x2 __attribute__((ext_vector_type(2)));
constexpr int BM = 256, BK = 64, HALF = 128, HTB = HALF * BK * 2  , STAGE_BYTES = 8 * HTB, NXCD = 8, WGM = 8;

__host__ __device__ __forceinline__ int lds_byte(int r, int c) { const int st = (r >> 4) * 2 + (c >> 5), rr = r & 15, cc = c & 31, ob = rr * 64 + cc * 2; return st * 1024 + (ob ^ (((ob >> 9) & 1) << 5)); }
__host__ __device__ __forceinline__ void stage_rc(int b, int& R, int& C) { const int st = b / 1024, sb = b % 1024, swz = sb ^ (((sb >> 9) & 1) << 5); R = (st >> 1) * 16 + swz / 64; C = (st & 1) * 32 + (swz % 64) / 2; }
__host__ __device__ __forceinline__ int perm32(int rho) { const int n = rho >> 4, i = rho & 15; return 8 * (i >> 2) + 4 * n + (i & 3); }

struct Unit { int pm, pn; };
struct Gemm { const bf16_t* A; const bf16_t* Bt; int M, N, K; };

struct StaticOrder {
    int nM, nN, nwg, G, c;
    __host__ __device__ void init(int M, int N, int G_, int c_) { nM = M / BM; nN = N / BM; nwg = nM * nN; G = G_; c = c_; }
    __host__ __device__ bool next(int i, Unit& u) const {
        const long L = (long)i * G + c; if (L >= nwg) return false;
        int wgid = (int)L; { const int q = nwg / NXCD, r = nwg % NXCD, xcd = wgid % NXCD, off = wgid / NXCD; wgid = (xcd < r ? xcd * (q + 1) : r * (q + 1) + (xcd - r) * q) + off; }
        const int nig = WGM * nN, gid = wgid / nig, fm = gid * WGM, gsz = (nM - fm) < WGM ? (nM - fm) : WGM;
        u.pm = fm + ((wgid % nig) % gsz); u.pn = (wgid % nig) / gsz; return true;
    }
    __device__ __forceinline__ void a_ready(const Unit&) const {}
    __device__ __forceinline__ void done(const Unit&) const {}
};
__device__ __forceinline__ unsigned cvt_pk_bf16(float lo, float hi) { unsigned r; asm volatile("v_cvt_pk_bf16_f32 %0, %1, %2" : "=v"(r) : "v"(lo), "v"(hi)); return r; }

template <class Epi, class Sched, bool ALIGN_EPI = false, bool SP2 = false>
__device__ __forceinline__ void gemm_phase(PG8_LAS unsigned char* lds, const Gemm g, const Sched& S, const Epi& E) {
    const int tid = threadIdx.x, wid = __builtin_amdgcn_readfirstlane(tid >> 6), lane = tid & 63, wr = wid >> 2, wc = wid & 3, fr = lane & 15, fq = lane >> 4;
    const int K = g.K, nt = K / BK;
    unsigned voffA[2], voffB[2];
#pragma unroll
    for (int i = 0; i < 2; ++i) { int R, C; stage_rc(tid * 16 + i * 8192, R, C); const int Rb = Epi::PERM ? ((R & ~31) + perm32(R & 31)) : R;
        voffA[i] = (unsigned)(R * K + C) * 2u; voffB[i] = (unsigned)(Rb * K + C) * 2u; }
    const size_t kstep = (size_t)(BK * 2);
    const size_t hstep = (size_t)HALF * K * 2;
    const size_t tstep = 2 * hstep;
    const unsigned ldsw = (unsigned)wid * 1024u;
    const int aoff = lds_byte(wr * 64 + fr, fq * 8), boff = lds_byte(wc * 32 + fr, fq * 8);
#define PG8_SA(b, h) (((b) * 2 + (h)) * HTB)
#define PG8_SB(b, h) ((4 + (b) * 2 + (h)) * HTB)
#define PG8_STAGE(bufoff, gbase, voff) do { _Pragma("unroll") for (int _i = 0; _i < 2; ++_i) \
        __builtin_amdgcn_global_load_lds((const unsigned*)((const char*)(gbase) + (voff)[_i]), (PG8_LAS unsigned*)(lds + (bufoff) + ldsw + _i * 8192), 16, 0, 0); } while (0)
#define PG8_LDA(dst, b, h) do { _Pragma("unroll") for (int m = 0; m < 4; ++m) _Pragma("unroll") for (int k = 0; k < 2; ++k) dst[m][k] = *(const PG8_LAS bf16x8*)(lds + PG8_SA(b, h) + aoff + m * 2048 + k * 1024); } while (0)
#define PG8_LDB(dst, b, h) do { _Pragma("unroll") for (int n = 0; n < 2; ++n) _Pragma("unroll") for (int k = 0; k < 2; ++k) dst[n][k] = *(const PG8_LAS bf16x8*)(lds + PG8_SB(b, h) + boff + n * 2048 + k * 1024); } while (0)
#define PG8_MMA(ai, bj, At, Bt) do { __builtin_amdgcn_s_setprio(1); _Pragma("unroll") for (int m = 0; m < 4; ++m) _Pragma("unroll") for (int n = 0; n < 2; ++n) _Pragma("unroll") for (int k = 0; k < 2; ++k) \
        acc[ai][bj][m][n] = __builtin_amdgcn_mfma_f32_16x16x32_bf16(Bt[n][k], At[m][k], acc[ai][bj][m][n], 0, 0, 0); __builtin_amdgcn_s_setprio(0); } while (0)
#define PG8_WAIT_V(n) asm volatile("s_waitcnt vmcnt(" #n ")" ::: "memory")
#define PG8_WAIT_L(n) asm volatile("s_waitcnt lgkmcnt(" #n ")" ::: "memory")
#define PG8_BAR __builtin_amdgcn_s_barrier()
#define PG8_SCHED __builtin_amdgcn_sched_barrier(0)
    Unit cur, nxt; int ui = 0;
    if (!S.next(0, cur)) return;
    f32x4 acc[2][2][4][2];
#pragma unroll
    for (int a = 0; a < 2; ++a)
#pragma unroll
        for (int b = 0; b < 2; ++b)
#pragma unroll
            for (int m = 0; m < 4; ++m)
#pragma unroll
                for (int n = 0; n < 2; ++n) acc[a][b][m][n] = (f32x4){0.f, 0.f, 0.f, 0.f};
    bf16x8 At[4][2], B0[2][2], B1[2][2];
    const char* cA = (const char*)g.A + (size_t)cur.pm * tstep; const char* cB = (const char*)g.Bt + (size_t)cur.pn * tstep;
    S.a_ready(cur);
    if constexpr (SP2) {
        PG8_STAGE(PG8_SB(0, 0), cB, voffB); PG8_STAGE(PG8_SB(0, 1), cB + hstep, voffB); PG8_STAGE(PG8_SA(0, 0), cA, voffA); PG8_STAGE(PG8_SA(0, 1), cA + hstep, voffA);
        if (wr == 1) PG8_BAR;
        PG8_WAIT_V(2); PG8_BAR;
        PG8_STAGE(PG8_SB(1, 0), cB + kstep, voffB); PG8_STAGE(PG8_SA(1, 0), cA + kstep, voffA); PG8_STAGE(PG8_SB(1, 1), cB + hstep + kstep, voffB);
        PG8_WAIT_V(6); PG8_BAR;
    } else {
        PG8_STAGE(PG8_SB(0, 0), cB, voffB); PG8_STAGE(PG8_SA(0, 0), cA, voffA); PG8_STAGE(PG8_SB(0, 1), cB + hstep, voffB); PG8_STAGE(PG8_SA(0, 1), cA + hstep, voffA);
        if (wr == 1) PG8_BAR;
        PG8_WAIT_V(4); PG8_BAR;
        PG8_STAGE(PG8_SB(1, 0), cB + kstep, voffB); PG8_STAGE(PG8_SA(1, 0), cA + kstep, voffA); PG8_STAGE(PG8_SB(1, 1), cB + hstep + kstep, voffB);
        PG8_WAIT_V(6); PG8_BAR;
    }
    for (;;) {
        const bool has_next = S.next(ui + 1, nxt);
        const char* nA = has_next ? (const char*)g.A + (size_t)nxt.pm * tstep : cA; const char* nB = has_next ? (const char*)g.Bt + (size_t)nxt.pn * tstep : cB;
        for (int t = 0; t < nt; t += 2) {
            const bool last = (t == nt - 2);
            const char* a1 = cA + (size_t)(t + 1) * kstep;
            const char* a2 = last ? nA : cA + (size_t)(t + 2) * kstep; const char* b2 = last ? nB : cB + (size_t)(t + 2) * kstep;
            const char* a3 = a2 + kstep; const char* b3 = b2 + kstep;
            if (last && has_next) S.a_ready(nxt);
            if constexpr (SP2) {
            PG8_LDB(B0, 0, 0); PG8_LDB(B1, 0, 1); PG8_SCHED; PG8_LDA(At, 0, 0); PG8_STAGE(PG8_SA(1, 1), a1 + hstep, voffA);
            PG8_WAIT_V(8); PG8_WAIT_L(0); PG8_BAR; PG8_MMA(0, 0, At, B0); PG8_MMA(0, 1, At, B1); PG8_BAR; PG8_SCHED;
            PG8_LDA(At, 0, 1); PG8_STAGE(PG8_SB(0, 0), b2, voffB); PG8_STAGE(PG8_SB(0, 1), b2 + hstep, voffB); PG8_STAGE(PG8_SA(0, 0), a2, voffA);
            PG8_WAIT_V(8); PG8_WAIT_L(0); PG8_BAR; PG8_MMA(1, 0, At, B0); PG8_MMA(1, 1, At, B1); PG8_BAR; PG8_SCHED;
            PG8_LDB(B0, 1, 0); PG8_LDB(B1, 1, 1); PG8_SCHED; PG8_LDA(At, 1, 0); PG8_STAGE(PG8_SA(0, 1), a2 + hstep, voffA);
            PG8_WAIT_V(8); PG8_WAIT_L(0); PG8_BAR; PG8_MMA(0, 0, At, B0); PG8_MMA(0, 1, At, B1); PG8_BAR; PG8_SCHED;
            PG8_LDA(At, 1, 1); PG8_STAGE(PG8_SB(1, 0), b3, voffB); PG8_STAGE(PG8_SB(1, 1), b3 + hstep, voffB); PG8_STAGE(PG8_SA(1, 0), a3, voffA);
            PG8_WAIT_V(8); PG8_WAIT_L(0); PG8_BAR; PG8_MMA(1, 0, At, B0); PG8_MMA(1, 1, At, B1); PG8_BAR; PG8_SCHED;
            } else {
            PG8_LDB(B0, 0, 0); PG8_SCHED; PG8_LDA(At, 0, 0); PG8_STAGE(PG8_SA(1, 1), a1 + hstep, voffA);
            PG8_WAIT_L(8); PG8_BAR; PG8_WAIT_L(0); PG8_MMA(0, 0, At, B0); PG8_BAR; PG8_SCHED;
            PG8_LDB(B1, 0, 1); PG8_STAGE(PG8_SB(0, 0), b2, voffB);
            PG8_BAR; PG8_WAIT_L(0); PG8_MMA(0, 1, At, B1); PG8_BAR;
            PG8_LDA(At, 0, 1); PG8_STAGE(PG8_SA(0, 0), a2, voffA);
            PG8_BAR; PG8_WAIT_L(0); PG8_MMA(1, 0, At, B0); PG8_BAR; PG8_SCHED;
            PG8_STAGE(PG8_SB(0, 1), b2 + hstep, voffB);
            PG8_WAIT_V(6); PG8_BAR; PG8_MMA(1, 1, At, B1); PG8_BAR;
            PG8_LDB(B0, 1, 0); PG8_SCHED; PG8_LDA(At, 1, 0); PG8_STAGE(PG8_SA(0, 1), a2 + hstep, voffA);
            PG8_WAIT_L(8); PG8_BAR; PG8_WAIT_L(0); PG8_MMA(0, 0, At, B0); PG8_BAR; PG8_SCHED;
            PG8_LDB(B1, 1, 1); PG8_STAGE(PG8_SB(1, 0), b3, voffB);
            PG8_BAR; PG8_WAIT_L(0); PG8_MMA(0, 1, At, B1); PG8_BAR;
            PG8_LDA(At, 1, 1); PG8_STAGE(PG8_SA(1, 0), a3, voffA);
            PG8_BAR; PG8_WAIT_L(0); PG8_MMA(1, 0, At, B0); PG8_BAR; PG8_SCHED;
            PG8_STAGE(PG8_SB(1, 1), b3 + hstep, voffB);
            PG8_WAIT_V(6); PG8_BAR; PG8_MMA(1, 1, At, B1); PG8_BAR;
            }
        }
        if constexpr (ALIGN_EPI) { if (wr == 0) PG8_BAR; }
        if constexpr (!Epi::AFTER_DRAIN) { E(acc, cur, wr, wc, fr, fq); S.done(cur); }
        if (!has_next) break;
#pragma unroll
        for (int a = 0; a < 2; ++a)
#pragma unroll
            for (int b = 0; b < 2; ++b)
#pragma unroll
                for (int m = 0; m < 4; ++m)
#pragma unroll
                    for (int n = 0; n < 2; ++n) acc[a][b][m][n] = (f32x4){0.f, 0.f, 0.f, 0.f};
        cur = nxt; cA = nA; cB = nB; ++ui;
        if constexpr (ALIGN_EPI) { if (wr == 1) PG8_BAR; }
    }
    PG8_WAIT_V(0);
    if constexpr (!ALIGN_EPI) { if (wr == 0) PG8_BAR; }
    PG8_BAR;
    if constexpr (Epi::AFTER_DRAIN) { E.fused(acc, cur, wr, wc, fr, fq, lds, wid, lane); S.done(cur); }
#undef PG8_SA
#undef PG8_SB
#undef PG8_STAGE
#undef PG8_LDA
#undef PG8_LDB
#undef PG8_MMA
#undef PG8_WAIT_V
#undef PG8_WAIT_L
#undef PG8_BAR
#undef PG8_SCHED
}
}

constexpr int DM = 1024, MP = 16384, MS = 512, MT_ROWS = MP + MS;
constexpr int SEQ = 2048, PAST = 2048, DSEQ = 16, NB_P = 8, NB_S = 32, LS = PAST + DSEQ, LSP = 2112;
constexpr int NPAD = 5376, RWC = 1792, DFF = 4096;
constexpr int C_Q = 0, C_K = 512, C_V = 640, C_QI = 768, C_KI = 1280, C_WI = 1344, C_P = 1536, C_GA = 3328, C_GB = 4352;
constexpr size_t O_YP = 0, O_YS = 16777216, O_NKP = 17301504, O_NVP = 19398656, O_NKIP = 21495808, O_WKVP = 22544384, O_SHP = 22806528,
                 O_NKS = 22820864, O_NVS = 22886400, O_NKIS = 22951936, O_WKVS = 22984704, O_SHS = 24033280, O_END = 24090624;
constexpr float QSCALE = 0.125f * 1.4426950408889634f;
constexpr float NORM_EPS = 1e-6f;
constexpr size_t MiB = 1u << 20;
constexpr size_t WS_CTL = 0, CTL_ZERO_BYTES = 1 * MiB;
constexpr size_t WS_WT_IN = 1 * MiB, WS_WT_AB = 12 * MiB, WS_WT_OUT = 14 * MiB, WS_WT_FF1 = 16 * MiB, WS_WT_FF2 = 24 * MiB;
constexpr size_t WS_WT_D = 32 * MiB, WS_WT_A = WS_WT_D + 65536, WS_WT_G = WS_WT_A + 65536;
constexpr size_t WS_H = 33 * MiB;
constexpr size_t WS_P = 66 * MiB;
constexpr size_t WS_QB = 124 * MiB, WS_QIB = 141 * MiB, WS_KBP = 158 * MiB, WS_VBP = 162 * MiB, WS_KIBP = 166 * MiB;
constexpr size_t WS_KS = 168 * MiB, WS_VS = 185 * MiB, WS_KIS = 202 * MiB, WS_WI = 211 * MiB, WS_SGS = 212 * MiB;
constexpr size_t WS_ATT = 214 * MiB, WS_RW = 231 * MiB;
constexpr size_t WS_X1S = 247 * MiB;
constexpr size_t WS_MT = 33 * MiB, WS_NT = 124 * MiB, WS_WY = 142 * MiB, WS_YL = 160 * MiB, WS_G1 = 178 * MiB, WS_E = 195 * MiB, WS_SSN = 66 * MiB;
constexpr size_t WS_MIX = 33 * MiB, WS_H2 = 66 * MiB, WS_HFF = 99 * MiB;
constexpr size_t WS_END = 256 * MiB;
static_assert(WS_HFF + (size_t)MT_ROWS * DFF * 2 <= WS_X1S, "ws map");
constexpr int CW_QUEUE = 64;
constexpr int CW_BAR = 4096;

constexpr int NWAVES = 8, NTHREADS = 512;
constexpr int LDS_BYTES = 163840;

#define GAS __attribute__((address_space(1)))
#define LAS __attribute__((address_space(3)))
typedef unsigned short bf16;
typedef unsigned v4u __attribute__((ext_vector_type(4)));
typedef unsigned v2u __attribute__((ext_vector_type(2)));
typedef float f32x4 __attribute__((ext_vector_type(4)));
typedef float f32x16 __attribute__((ext_vector_type(16)));
typedef short bf16x8 __attribute__((ext_vector_type(8)));
typedef short s16x4 __attribute__((ext_vector_type(4)));
#define LDS_WAIT() asm volatile("s_waitcnt lgkmcnt(0)" ::: "memory")
#define VM_WAIT() asm volatile("s_waitcnt vmcnt(0)" ::: "memory")
__device__ __forceinline__ unsigned f2bf(float f) { unsigned u = __builtin_bit_cast(unsigned, f); return (u + 0x7fffu + ((u >> 16) & 1u)) >> 16; }
__device__ __forceinline__ unsigned pk2(float lo, float hi) { return f2bf(lo) | (f2bf(hi) << 16); }
__device__ __forceinline__ float bf2f(unsigned short h) { return __builtin_bit_cast(float, (unsigned)h << 16); }
__device__ __forceinline__ float bflo(unsigned w) { return __builtin_bit_cast(float, w << 16); }
__device__ __forceinline__ float bfhi(unsigned w) { return __builtin_bit_cast(float, w & 0xffff0000u); }
__device__ __forceinline__ float wave_sum(float v) {
#pragma unroll
    for (int o = 1; o < 64; o <<= 1) v += __shfl_xor(v, o);
    return v;
}
__device__ __forceinline__ float sigmoidf_(float x) { return 1.0f / (1.0f + __expf(-x)); }

struct Args {
    const float* in[28];
    float* out; unsigned char* ws;
    int ph_lo, ph_hi;
};
struct Frame {
    LAS unsigned char* lds;
    int tid, lane, wave, vcu, G;
};

__device__ __forceinline__ void p0_transpose_item(const float* W, int ldw, int src_col0, bf16* WT, int dst_ld, int dst_row0, int dst_k0, int nblk, LAS float* scr, int item, int lane) {
    const int kb = item / nblk, nb = item % nblk, k0 = 64 * kb, n0 = 32 * nb;
#pragma unroll 8
    for (int i = 0; i < 32; ++i) { const int kk = 2 * i + (lane >> 5); scr[kk * 33 + (lane & 31)] = W[(size_t)(k0 + kk) * ldw + src_col0 + n0 + (lane & 31)]; }
    LDS_WAIT(); asm volatile("" ::: "memory");
    const int c = lane & 7;
#pragma unroll
    for (int j = 0; j < 4; ++j) { const int n = (lane >> 3) + 8 * j; const LAS float* s = scr + (8 * c) * 33 + n;
        v4u o; o.x = pk2(s[0 * 33], s[1 * 33]); o.y = pk2(s[2 * 33], s[3 * 33]); o.z = pk2(s[4 * 33], s[5 * 33]); o.w = pk2(s[6 * 33], s[7 * 33]);
        *(GAS v4u*)(WT + (size_t)(dst_row0 + n0 + n) * dst_ld + dst_k0 + k0 + 8 * c) = o; }
    LDS_WAIT(); asm volatile("" ::: "memory");
}
__device__ __forceinline__ void rms_row_to_bf16(int lane, const float* xrow, const float* g, bf16* orow) {
    const GAS f32x4* xr = (const GAS f32x4*)xrow + lane; const GAS f32x4* gr = (const GAS f32x4*)g + lane;
    f32x4 v[4]; float s = 0.f;
#pragma unroll
    for (int j = 0; j < 4; ++j) { v[j] = xr[64 * j]; s += (v[j].x * v[j].x + v[j].y * v[j].y) + (v[j].z * v[j].z + v[j].w * v[j].w); }
    const float rstd = 1.0f / sqrtf(wave_sum(s) * (1.f / DM) + NORM_EPS);
    GAS v2u* o8 = (GAS v2u*)orow + lane;
#pragma unroll
    for (int j = 0; j < 4; ++j) { const f32x4 gg = gr[64 * j]; v2u o; o.x = pk2(v[j].x * rstd * gg.x, v[j].y * rstd * gg.y); o.y = pk2(v[j].z * rstd * gg.z, v[j].w * rstd * gg.w); o8[64 * j] = o; }
}
__device__ __forceinline__ void p0_prologue(Frame& F, const Args& a) {
    unsigned char* ws = a.ws;
    LAS float* scr = (LAS float*)(F.lds + F.wave * 16384);
    const int gw = F.vcu * NWAVES + F.wave, NGW = F.G * NWAVES;
    int base = 0;
#define TRJ(in_idx, ldw, sc0, ncols, K, dst, dld, dr0, dk0) { const int nblk = (ncols) / 32, nit = ((K) / 64) * nblk; int first = (gw - base) % NGW; if (first < 0) first += NGW; \
        for (int it = first; it < nit; it += NGW) p0_transpose_item(a.in[in_idx], ldw, sc0, (bf16*)(ws + (dst)), dld, dr0, dk0, nblk, scr, it, F.lane); base += nit; }
    TRJ(9, 5192, 0, 512, 1024, WS_WT_IN, 1024, C_Q, 0) TRJ(9, 5192, 512, 128, 1024, WS_WT_IN, 1024, C_K, 0) TRJ(9, 5192, 640, 128, 1024, WS_WT_IN, 1024, C_V, 0)
    TRJ(9, 5192, 768, 512, 1024, WS_WT_IN, 1024, C_QI, 0) TRJ(9, 5192, 1280, 64, 1024, WS_WT_IN, 1024, C_KI, 0) TRJ(9, 5192, 1352, 1792, 1024, WS_WT_IN, 1024, C_P, 0)
    TRJ(9, 5192, 3144, 1024, 1024, WS_WT_IN, 1024, C_GA, 0) TRJ(9, 5192, 4168, 1024, 1024, WS_WT_IN, 1024, C_GB, 0)
    TRJ(10, 1024, 0, 1024, 512, WS_WT_AB, 512, 0, 0) TRJ(22, 1024, 0, 1024, 512, WS_WT_AB + MiB, 512, 0, 0)
    TRJ(23, 1024, 0, 1024, 1024, WS_WT_OUT, 1024, 0, 0) TRJ(25, 4096, 0, 4096, 1024, WS_WT_FF1, 1024, 0, 0) TRJ(26, 1024, 0, 1024, 4096, WS_WT_FF2, 4096, 0, 0)
    TRJ(13, 512, 0, 512, 64, WS_WT_D, 64, 0, 0) TRJ(15, 512, 0, 512, 64, WS_WT_A, 64, 0, 0) TRJ(16, 512, 0, 512, 128, WS_WT_G, 128, 0, 0)
#undef TRJ
    if (gw == NGW - 1) {
        const float* W = a.in[9]; bf16* WT = (bf16*)(ws + WS_WT_IN);
        for (int e = F.lane; e < 8 * 1024; e += 64) { const int n = e >> 10, k = e & 1023; WT[(size_t)(C_WI + n) * 1024 + k] = (bf16)f2bf(W[(size_t)k * 5192 + 1344 + n]); }
    }
    bf16* H = (bf16*)(ws + WS_H);
    for (int m = gw; m < MT_ROWS; m += NGW) { const float* xr = (m < MP) ? a.in[0] + (size_t)m * DM : a.in[1] + (size_t)(m - MP) * DM; rms_row_to_bf16(F.lane, xr, a.in[8], H + (size_t)m * DM); }
    const int gt = F.vcu * NTHREADS + F.tid, NGT = F.G * NTHREADS;
    {
        const int nit = NB_S * PAST * 128 / 8;
        for (int it = gt; it < 2 * nit; it += NGT) { const int which = it >= nit, e = (which ? it - nit : it) * 8; const float* src = a.in[2 + which] + e;
            const int b = e / (PAST * 128), rem = e % (PAST * 128); bf16* dst = (bf16*)(ws + (which ? WS_VS : WS_KS)) + (size_t)b * LSP * 128 + rem;
            const f32x4 x0 = *(const GAS f32x4*)src, x1 = *(const GAS f32x4*)(src + 4); v4u o; o.x = pk2(x0.x, x0.y); o.y = pk2(x0.z, x0.w); o.z = pk2(x1.x, x1.y); o.w = pk2(x1.z, x1.w); *(GAS v4u*)dst = o; }
        const int nit2 = NB_S * PAST * 64 / 8;
        for (int it = gt; it < nit2; it += NGT) { const int e = it * 8; const float* src = a.in[4] + e; const int b = e / (PAST * 64), rem = e % (PAST * 64); bf16* dst = (bf16*)(ws + WS_KIS) + (size_t)b * LSP * 64 + rem;
            const f32x4 x0 = *(const GAS f32x4*)src, x1 = *(const GAS f32x4*)(src + 4); v4u o; o.x = pk2(x0.x, x0.y); o.y = pk2(x0.z, x0.w); o.z = pk2(x1.x, x1.y); o.w = pk2(x1.z, x1.w); *(GAS v4u*)dst = o; }
        const int npad = NB_S * (LSP - LS) * 128 / 8;
        for (int it = gt; it < 2 * npad; it += NGT) { const int which = it >= npad, e = (which ? it - npad : it) * 8; const int b = e / ((LSP - LS) * 128), rem = e % ((LSP - LS) * 128);
            *(GAS v4u*)((bf16*)(ws + (which ? WS_VS : WS_KS)) + ((size_t)b * LSP + LS) * 128 + rem) = (v4u){0u, 0u, 0u, 0u}; }
        const int npad2 = NB_S * (LSP - LS) * 64 / 8;
        for (int it = gt; it < npad2; it += NGT) { const int e = it * 8; const int b = e / ((LSP - LS) * 64), rem = e % ((LSP - LS) * 64);
            *(GAS v4u*)((bf16*)(ws + WS_KIS) + ((size_t)b * LSP + LS) * 64 + rem) = (v4u){0u, 0u, 0u, 0u}; }
    }
}

struct EpiInProj {
    static constexpr bool PERM = true, AFTER_DRAIN = false;
    unsigned char* ws; float* out; bf16* sga_p; bf16* sgb_p;
    __device__ __forceinline__ void operator()(const f32x4 (&acc)[2][2][4][2], const pg8::Unit& u, int wr, int wc, int fr, int fq) const {
        const int pn = u.pn;
#pragma unroll
        for (int ai = 0; ai < 2; ++ai)
#pragma unroll
            for (int m = 0; m < 4; ++m) {
                const int row = u.pm * 256 + ai * 128 + wr * 64 + m * 16 + fr;
                const bool smp = row >= MP; const int rs = row - MP, sb = rs >> 4, st = rs & 15;
#pragma unroll
                for (int bj = 0; bj < 2; ++bj) {
                    const int c0 = pn * 256 + bj * 128 + wc * 32 + fq * 8;
                    const f32x4 v0 = acc[ai][bj][m][0], v1 = acc[ai][bj][m][1];
                    if (pn < 2) {
                        v4u o; o.x = pk2(v0.x * QSCALE, v0.y * QSCALE); o.y = pk2(v0.z * QSCALE, v0.w * QSCALE); o.z = pk2(v1.x * QSCALE, v1.y * QSCALE); o.w = pk2(v1.z * QSCALE, v1.w * QSCALE);
                        *(GAS v4u*)((bf16*)(ws + WS_QB) + (size_t)row * 512 + c0) = o;
                    } else if (pn == 2) {
                        const int c = c0 - (bj ? C_V : C_K);
                        float* of = out + (smp ? (bj ? O_NVS : O_NKS) + (size_t)rs * 128 : (bj ? O_NVP : O_NKP) + (size_t)row * 128) + c;
                        *(GAS f32x4*)of = v0; *(GAS f32x4*)(of + 4) = v1;
                        bf16* ob = smp ? (bf16*)(ws + (bj ? WS_VS : WS_KS)) + ((size_t)sb * LSP + PAST + st) * 128 + c : (bf16*)(ws + (bj ? WS_VBP : WS_KBP)) + (size_t)row * 128 + c;
                        v4u o; o.x = pk2(v0.x, v0.y); o.y = pk2(v0.z, v0.w); o.z = pk2(v1.x, v1.y); o.w = pk2(v1.z, v1.w); *(GAS v4u*)ob = o;
                    } else if (pn < 5) {
                        v4u o; o.x = pk2(v0.x * 0.125f, v0.y * 0.125f); o.y = pk2(v0.z * 0.125f, v0.w * 0.125f); o.z = pk2(v1.x * 0.125f, v1.y * 0.125f); o.w = pk2(v1.z * 0.125f, v1.w * 0.125f);
                        *(GAS v4u*)((bf16*)(ws + WS_QIB) + (size_t)row * 512 + (c0 - C_QI)) = o;
                    } else if (pn == 5) {
                        if (c0 < C_WI) {
                            const int c = c0 - C_KI;
                            float* of = out + (smp ? O_NKIS + (size_t)rs * 64 : O_NKIP + (size_t)row * 64) + c;
                            *(GAS f32x4*)of = v0; *(GAS f32x4*)(of + 4) = v1;
                            bf16* ob = smp ? (bf16*)(ws + WS_KIS) + ((size_t)sb * LSP + PAST + st) * 64 + c : (bf16*)(ws + WS_KIBP) + (size_t)row * 64 + c;
                            v4u o; o.x = pk2(v0.x, v0.y); o.y = pk2(v0.z, v0.w); o.z = pk2(v1.x, v1.y); o.w = pk2(v1.z, v1.w); *(GAS v4u*)ob = o;
                        } else if (c0 == C_WI) {
                            const float s = 0.35355339059327373f; float* of = (float*)(ws + WS_WI) + (size_t)row * 8;
                            *(GAS f32x4*)of = v0 * s; *(GAS f32x4*)(of + 4) = v1 * s;
                        }
                    } else if (pn < 13) {
                        const int c = c0 - C_P;
                        v4u o; o.x = pk2(v0.x, v0.y); o.y = pk2(v0.z, v0.w); o.z = pk2(v1.x, v1.y); o.w = pk2(v1.z, v1.w);
                        *(GAS v4u*)((bf16*)(ws + WS_P) + (size_t)row * RWC + c) = o;
                        const bool last = smp ? (st == DSEQ - 1) : ((row & (SEQ - 1)) == SEQ - 1);
                        if (last) { float* of = out + (smp ? O_SHS + (size_t)sb * RWC : O_SHP + (size_t)(row >> 11) * RWC) + c; *(GAS f32x4*)of = v0; *(GAS f32x4*)(of + 4) = v1; }
                    } else {
                        const bool isb = pn >= 17; const int c = c0 - (isb ? C_GB : C_GA);
                        v4u o; o.x = pk2(sigmoidf_(v0.x), sigmoidf_(v0.y)); o.y = pk2(sigmoidf_(v0.z), sigmoidf_(v0.w)); o.z = pk2(sigmoidf_(v1.x), sigmoidf_(v1.y)); o.w = pk2(sigmoidf_(v1.z), sigmoidf_(v1.w));
                        bf16* ob = smp ? (bf16*)(ws + WS_SGS) + (size_t)(isb ? MS : 0) * DM + (size_t)rs * DM + c : (isb ? sgb_p : sga_p) + (size_t)row * DM + c;
                        *(GAS v4u*)ob = o;
                    }
                }
            }
    }
};
template <bool ACCUM> struct EpiGate {
    static constexpr bool PERM = true, AFTER_DRAIN = false;
    const bf16* sg_p; const bf16* sg_s; bf16* mix;
    __device__ __forceinline__ void operator()(const f32x4 (&acc)[2][2][4][2], const pg8::Unit& u, int wr, int wc, int fr, int fq) const {
#pragma unroll
        for (int ai = 0; ai < 2; ++ai)
#pragma unroll
            for (int m = 0; m < 4; ++m) {
                const int row = u.pm * 256 + ai * 128 + wr * 64 + m * 16 + fr; const bool smp = row >= MP;
#pragma unroll
                for (int bj = 0; bj < 2; ++bj) {
                    const int c0 = u.pn * 256 + bj * 128 + wc * 32 + fq * 8;
                    const v4u g = *(const GAS v4u*)((smp ? sg_s + (size_t)(row - MP) * DM : sg_p + (size_t)row * DM) + c0);
                    f32x4 v0 = acc[ai][bj][m][0], v1 = acc[ai][bj][m][1];
                    v0.x *= bflo(g.x); v0.y *= bfhi(g.x); v0.z *= bflo(g.y); v0.w *= bfhi(g.y); v1.x *= bflo(g.z); v1.y *= bfhi(g.z); v1.z *= bflo(g.w); v1.w *= bfhi(g.w);
                    bf16* op = mix + (size_t)row * DM + c0;
                    if (ACCUM) { const v4u p = *(const GAS v4u*)op; v0.x += bflo(p.x); v0.y += bfhi(p.x); v0.z += bflo(p.y); v0.w += bfhi(p.y); v1.x += bflo(p.z); v1.y += bfhi(p.z); v1.z += bflo(p.w); v1.w += bfhi(p.w); }
                    v4u o; o.x = pk2(v0.x, v0.y); o.y = pk2(v0.z, v0.w); o.z = pk2(v1.x, v1.y); o.w = pk2(v1.z, v1.w); *(GAS v4u*)op = o;
                }
            }
    }
};
struct EpiResid {
    static constexpr bool PERM = false, AFTER_DRAIN = false;
    const float* src_p; const float* src_s; float* dst_p; float* dst_s;
    __device__ __forceinline__ void operator()(const f32x4 (&acc)[2][2][4][2], const pg8::Unit& u, int wr, int wc, int fr, int fq) const {
#pragma unroll
        for (int ai = 0; ai < 2; ++ai)
#pragma unroll
            for (int m = 0; m < 4; ++m) {
                const int row = u.pm * 256 + ai * 128 + wr * 64 + m * 16 + fr; const bool smp = row >= MP;
                const float* s = smp ? src_s + (size_t)(row - MP) * DM : src_p + (size_t)row * DM; float* d = smp ? dst_s + (size_t)(row - MP) * DM : dst_p + (size_t)row * DM;
#pragma unroll
                for (int bj = 0; bj < 2; ++bj)
#pragma unroll
                    for (int n = 0; n < 2; ++n) { const int c = u.pn * 256 + bj * 128 + wc * 32 + n * 16 + fq * 4; *(GAS f32x4*)(d + c) = *(const GAS f32x4*)(s + c) + acc[ai][bj][m][n]; }
            }
    }
};
struct EpiRelu2 {
    static constexpr bool PERM = true, AFTER_DRAIN = false;
    bf16* O;
    __device__ __forceinline__ void operator()(const f32x4 (&acc)[2][2][4][2], const pg8::Unit& u, int wr, int wc, int fr, int fq) const {
#pragma unroll
        for (int ai = 0; ai < 2; ++ai)
#pragma unroll
            for (int m = 0; m < 4; ++m) {
                const int row = u.pm * 256 + ai * 128 + wr * 64 + m * 16 + fr;
#pragma unroll
                for (int bj = 0; bj < 2; ++bj) {
                    const int c0 = u.pn * 256 + bj * 128 + wc * 32 + fq * 8;
                    f32x4 v0 = acc[ai][bj][m][0], v1 = acc[ai][bj][m][1];
                    v0 = __builtin_elementwise_max(v0, (f32x4){0.f, 0.f, 0.f, 0.f}); v1 = __builtin_elementwise_max(v1, (f32x4){0.f, 0.f, 0.f, 0.f}); v0 = v0 * v0; v1 = v1 * v1;
                    v4u o; o.x = pk2(v0.x, v0.y); o.y = pk2(v0.z, v0.w); o.z = pk2(v1.x, v1.y); o.w = pk2(v1.z, v1.w); *(GAS v4u*)(O + (size_t)row * DFF + c0) = o;
                }
            }
    }
};

__device__ __forceinline__ void rms_row_to_f32(int lane, const float* xrow, const float* g, float* orow) {
    const GAS f32x4* xr = (const GAS f32x4*)xrow + lane; const GAS f32x4* gr = (const GAS f32x4*)g + lane;
    f32x4 v[4]; float s = 0.f;
#pragma unroll
    for (int j = 0; j < 4; ++j) { v[j] = xr[64 * j]; s += (v[j].x * v[j].x + v[j].y * v[j].y) + (v[j].z * v[j].z + v[j].w * v[j].w); }
    const float rstd = 1.0f / sqrtf(wave_sum(s) * (1.f / DM) + NORM_EPS);
    GAS f32x4* o = (GAS f32x4*)orow + lane;
#pragma unroll
    for (int j = 0; j < 4; ++j) { const f32x4 gg = gr[64 * j]; o[64 * j] = v[j] * rstd * gg; }
}
#define PHASE6 { pg8::StaticOrder S; S.init(MT_ROWS, DM, F.G, (int)blockIdx.x); \
    { pg8::Gemm g{(const bf16*)(ws + WS_ATT), (const bf16*)(ws + WS_WT_AB), MT_ROWS, DM, 512}; EpiGate<false> E{sga_p, (const bf16*)(ws + WS_SGS), (bf16*)(ws + WS_MIX)}; \
      pg8::gemm_phase<EpiGate<false>, pg8::StaticOrder, true, true>(F.lds, g, S, E); } \
    { pg8::Gemm g{(const bf16*)(ws + WS_RW), (const bf16*)(ws + WS_WT_AB + MiB), MT_ROWS, DM, 512}; EpiGate<true> E{sgb_p, (const bf16*)(ws + WS_SGS) + (size_t)MS * DM, (bf16*)(ws + WS_MIX)}; \
      pg8::gemm_phase<EpiGate<true>, pg8::StaticOrder, true, true>(F.lds, g, S, E); } }
#define PHASE7 { pg8::StaticOrder S; S.init(MT_ROWS, DM, F.G, (int)blockIdx.x); pg8::Gemm g{(const bf16*)(ws + WS_MIX), (const bf16*)(ws + WS_WT_OUT), MT_ROWS, DM, DM}; \
    EpiResid E{args.in[0], args.in[1], args.out + O_YP, (float*)(ws + WS_X1S)}; pg8::gemm_phase<EpiResid, pg8::StaticOrder, true, true>(F.lds, g, S, E); }
#define PHASE8 { const int gw = F.vcu * NWAVES + F.wave, NGW = F.G * NWAVES; \
    for (int m = gw; m < MT_ROWS; m += NGW) { const float* xr = (m < MP) ? args.out + O_YP + (size_t)m * DM : (const float*)(ws + WS_X1S) + (size_t)(m - MP) * DM; rms_row_to_bf16(F.lane, xr, args.in[24], (bf16*)(ws + WS_H2) + (size_t)m * DM); } }
#define PHASE9 { pg8::StaticOrder S; S.init(MT_ROWS, DFF, F.G, (int)blockIdx.x); pg8::Gemm g{(const bf16*)(ws + WS_H2), (const bf16*)(ws + WS_WT_FF1), MT_ROWS, DFF, DM}; \
    EpiRelu2 E{(bf16*)(ws + WS_HFF)}; pg8::gemm_phase<EpiRelu2, pg8::StaticOrder, true, true>(F.lds, g, S, E); }
#define PHASE10 { pg8::StaticOrder S; S.init(MT_ROWS, DM, F.G, (int)blockIdx.x); pg8::Gemm g{(const bf16*)(ws + WS_HFF), (const bf16*)(ws + WS_WT_FF2), MT_ROWS, DM, DFF}; \
    EpiResid E{args.out + O_YP, (const float*)(ws + WS_X1S), args.out + O_YP, (float*)(ws + WS_X1S)}; pg8::gemm_phase<EpiResid, pg8::StaticOrder, true, true>(F.lds, g, S, E); }
#define PHASE11 { const int gw = F.vcu * NWAVES + F.wave, NGW = F.G * NWAVES; \
    for (int m = gw; m < MT_ROWS; m += NGW) { const float* xr = (m < MP) ? args.out + O_YP + (size_t)m * DM : (const float*)(ws + WS_X1S) + (size_t)(m - MP) * DM; \
        float* yr = (m < MP) ? args.out + O_YP + (size_t)m * DM : args.out + O_YS + (size_t)(m - MP) * DM; rms_row_to_f32(F.lane, xr, args.in[27], yr); } }

__device__ __forceinline__ int t5_bucket(int rel) {
    const int n = rel < 0 ? -rel : rel; int r = rel > 0 ? 16 : 0;
    if (n < 8) return r + n;
    return r + 8 + (n >= 12) + (n >= 16) + (n >= 23) + (n >= 32) + (n >= 46) + (n >= 64) + (n >= 91);
}
__device__ __forceinline__ unsigned ordkey(float f) { const unsigned u = __builtin_bit_cast(unsigned, f); return (u & 0x80000000u) ? ~u : (u | 0x80000000u); }

__global__ void __launch_bounds__(256) nv_attn(Args a) {
    __shared__ float qi_s[512]; __shared__ float q_s[512]; __shared__ float wi_s[8]; __shared__ unsigned key_s[LSP]; __shared__ unsigned char sel_s[LSP]; __shared__ float lg_s[LSP];
    __shared__ unsigned cnt_s; __shared__ float red_s[256]; __shared__ float o_s[4][64];
    unsigned char* ws = a.ws; const int m = blockIdx.x, tid = threadIdx.x;
    const bool smp = m >= MP; const int b = smp ? (m - MP) >> 4 : m >> 11, t = smp ? (m - MP) & 15 : m & 2047;
    const int qpos = smp ? PAST + t : t; const int n = smp ? LS : 64 * (t / 64 + 1);
    const bf16* Ki = smp ? (const bf16*)(ws + WS_KIS) + (size_t)b * LSP * 64 : (const bf16*)(ws + WS_KIBP) + (size_t)b * SEQ * 64;
    const bf16* Kb = smp ? (const bf16*)(ws + WS_KS) + (size_t)b * LSP * 128 : (const bf16*)(ws + WS_KBP) + (size_t)b * SEQ * 128;
    const bf16* Vb = smp ? (const bf16*)(ws + WS_VS) + (size_t)b * LSP * 128 : (const bf16*)(ws + WS_VBP) + (size_t)b * SEQ * 128;
    for (int i = tid; i < 512; i += 256) { qi_s[i] = bf2f(((const bf16*)(ws + WS_QIB))[(size_t)m * 512 + i]); q_s[i] = bf2f(((const bf16*)(ws + WS_QB))[(size_t)m * 512 + i]); }
    if (tid < 8) wi_s[tid] = ((const float*)(ws + WS_WI))[(size_t)m * 8 + tid];
    __syncthreads();
    for (int s = tid; s < n; s += 256) {
        float kd[64];
#pragma unroll
        for (int d = 0; d < 64; ++d) kd[d] = bf2f(Ki[(size_t)s * 64 + d]);
        float sc = 0.f;
        for (int h = 0; h < 8; ++h) { float dot = 0.f;
#pragma unroll
            for (int d = 0; d < 64; ++d) dot = fmaf(qi_s[h * 64 + d], kd[d], dot);
            sc = fmaf(wi_s[h], fmaxf(dot, 0.f), sc); }
        key_s[s] = ordkey(sc); sel_s[s] = 1;
    }
    __syncthreads();
    if (n > 256) {
        unsigned prefix = 0u;
        for (int bit = 31; bit >= 0; --bit) {
            const unsigned cand = prefix | (1u << bit);
            if (tid == 0) cnt_s = 0u;
            __syncthreads();
            unsigned c = 0; for (int s = tid; s < n; s += 256) c += key_s[s] >= cand;
            atomicAdd(&cnt_s, c);
            __syncthreads();
            if (cnt_s >= 256u) prefix = cand;
            __syncthreads();
        }
        if (tid == 0) { int gt = 0; for (int s = 0; s < n; ++s) gt += key_s[s] > prefix; int need = 256 - gt;
            for (int s = 0; s < n; ++s) { const unsigned k = key_s[s]; unsigned char v = 0; if (k > prefix) v = 1; else if (k == prefix && need > 0) { v = 1; --need; } sel_s[s] = v; } }
        __syncthreads();
    }
    const float* relb = a.in[7];
    for (int h = 0; h < 8; ++h) {
        const int j = h >> 2; float mx = -3.0e38f;
        for (int s = tid; s < n; s += 256) { float lg = -3.0e38f;
            if (sel_s[s]) { float dot = 0.f;
#pragma unroll 8
                for (int d = 0; d < 64; ++d) dot = fmaf(q_s[h * 64 + d], bf2f(Kb[(size_t)s * 128 + j * 64 + d]), dot);
                lg = dot + relb[t5_bucket(s - qpos) * 8 + h] * 1.4426950408889634f; }
            lg_s[s] = lg; mx = fmaxf(mx, lg); }
        red_s[tid] = mx; __syncthreads();
        for (int o = 128; o > 0; o >>= 1) { if (tid < o) red_s[tid] = fmaxf(red_s[tid], red_s[tid + o]); __syncthreads(); }
        mx = red_s[0]; __syncthreads();
        float sum = 0.f;
        for (int s = tid; s < n; s += 256) { const float p = sel_s[s] ? exp2f(lg_s[s] - mx) : 0.f; lg_s[s] = p; sum += p; }
        red_s[tid] = sum; __syncthreads();
        for (int o = 128; o > 0; o >>= 1) { if (tid < o) red_s[tid] += red_s[tid + o]; __syncthreads(); }
        sum = red_s[0]; __syncthreads();
        const int d = tid & 63, grp = tid >> 6; float acc = 0.f;
        for (int s = grp; s < n; s += 4) { const float p = lg_s[s]; if (p != 0.f) acc = fmaf(p, bf2f(Vb[(size_t)s * 128 + j * 64 + d]), acc); }
        o_s[grp][d] = acc; __syncthreads();
        if (tid < 64) ((bf16*)(ws + WS_ATT))[(size_t)m * 512 + h * 64 + tid] = (bf16)f2bf((o_s[0][tid] + o_s[1][tid] + o_s[2][tid] + o_s[3][tid]) / sum);
        __syncthreads();
    }
}

struct RwTok { float r, k, v, decay, a, g, kk, kh, b, bonus; };
__device__ __forceinline__ RwTok rw_token_prep(const Args& a, int m, int c, float* xs  , float* red  ) {
    unsigned char* ws = a.ws; const bf16* P = (const bf16*)(ws + WS_P);
    const bool smp = m >= MP; const int b = smp ? (m - MP) >> 4 : m >> 11, t = smp ? (m - MP) & 15 : m & 2047;
    const float* mu = a.in[11];
    for (int col = c; col < RWC; col += 512) { const float p = bf2f(P[(size_t)m * RWC + col]); const float pv = (t > 0) ? bf2f(P[(size_t)(m - 1) * RWC + col]) : (smp ? a.in[6][(size_t)b * RWC + col] : 0.f);
        xs[col] = p + (pv - p) * mu[col]; }
    __syncthreads();
    RwTok o; o.r = xs[c]; o.k = xs[512 + c]; o.v = xs[1024 + c];
    float wl = a.in[12][c], al = a.in[14][c], g = 0.f;
    for (int mm = 0; mm < 64; ++mm) { wl = fmaf(tanhf(xs[1536 + mm]), a.in[13][mm * 512 + c], wl); al = fmaf(xs[1600 + mm], a.in[15][mm * 512 + c], al); }
    for (int mm = 0; mm < 128; ++mm) g = fmaf(sigmoidf_(xs[1664 + mm]), a.in[16][mm * 512 + c], g);
    const float sp = (-wl > 20.f) ? -wl : log1pf(__expf(-wl));
    const float w = -sp - 0.5f; o.decay = __expf(-__expf(w)); o.a = sigmoidf_(al); o.g = g;
    const float kkr = o.k * a.in[17][c];
    red[c] = kkr * kkr; __syncthreads();
    float ss = 0.f; for (int j = 0; j < 64; ++j) ss += red[(c & ~63) + j];
    __syncthreads();
    o.kk = kkr / fmaxf(sqrtf(ss), 1e-12f);
    o.kh = o.k * (1.0f + (o.a - 1.0f) * a.in[18][c]); o.b = o.kk * o.a;
    red[c] = o.r * o.kh * a.in[19][c]; __syncthreads();
    float bs = 0.f; for (int j = 0; j < 64; ++j) bs += red[(c & ~63) + j];
    __syncthreads();
    o.bonus = bs * o.v;
    return o;
}
constexpr size_t WS_NR = 124 * MiB, WS_NKH = 141 * MiB, WS_NV = 158 * MiB, WS_NKK = 175 * MiB, WS_NB = 192 * MiB, WS_NDEC = 33 * MiB;
__global__ void __launch_bounds__(512) nv_rw_prep(Args a) {
    __shared__ float xs[RWC]; __shared__ float red[512];
    const int m = blockIdx.x, c = threadIdx.x; const RwTok o = rw_token_prep(a, m, c, xs, red);
    unsigned char* ws = a.ws; const size_t i = (size_t)m * 512 + c;
    ((bf16*)(ws + WS_NR))[i] = (bf16)f2bf(o.r); ((bf16*)(ws + WS_NKH))[i] = (bf16)f2bf(o.kh); ((bf16*)(ws + WS_NV))[i] = (bf16)f2bf(o.v);
    ((bf16*)(ws + WS_NKK))[i] = (bf16)f2bf(o.kk); ((bf16*)(ws + WS_NB))[i] = (bf16)f2bf(o.b); ((float*)(ws + WS_NDEC))[i] = o.decay;
}
__global__ void __launch_bounds__(64) nv_rw_scan(Args a) {
    __shared__ float vec[5][64];
    unsigned char* ws = a.ws; const int chain = blockIdx.x, i = threadIdx.x;
    const bool smp = chain >= 64; const int b = smp ? (chain - 64) >> 3 : chain >> 3, h = chain & 7; const int T = smp ? DSEQ : SEQ; const size_t m0 = smp ? MP + (size_t)b * DSEQ : (size_t)b * SEQ;
    float S[64];
#pragma unroll
    for (int j = 0; j < 64; ++j) S[j] = smp ? a.in[5][(((size_t)b * 8 + h) * 64 + i) * 64 + j] : 0.f;
    for (int t = 0; t < T; ++t) {
        const size_t idx = (m0 + t) * 512 + h * 64 + i;
        vec[0][i] = bf2f(((const bf16*)(ws + WS_NKK))[idx]); vec[1][i] = ((const float*)(ws + WS_NDEC))[idx]; vec[2][i] = bf2f(((const bf16*)(ws + WS_NB))[idx]);
        vec[3][i] = bf2f(((const bf16*)(ws + WS_NKH))[idx]); vec[4][i] = bf2f(((const bf16*)(ws + WS_NR))[idx]);
        const float v = bf2f(((const bf16*)(ws + WS_NV))[idx]);
        __syncthreads();
        float sa = 0.f;
#pragma unroll
        for (int j = 0; j < 64; ++j) sa = fmaf(S[j], vec[0][j], sa);
        float y = 0.f;
#pragma unroll
        for (int j = 0; j < 64; ++j) { S[j] = S[j] * vec[1][j] - sa * vec[2][j] + v * vec[3][j]; y = fmaf(S[j], vec[4][j], y); }
        ((bf16*)(ws + WS_RW))[idx] = (bf16)f2bf(y);
        __syncthreads();
    }
    float* o = a.out + (smp ? O_WKVS : O_WKVP) + (((size_t)b * 8 + h) * 64 + i) * 64;
#pragma unroll
    for (int j = 0; j < 64; ++j) o[j] = S[j];
}
__global__ void __launch_bounds__(512) nv_rw_post(Args a) {
    __shared__ float xs[RWC]; __shared__ float red[512];
    const int m = blockIdx.x, c = threadIdx.x; const RwTok o = rw_token_prep(a, m, c, xs, red);
    const float y = bf2f(((const bf16*)(a.ws + WS_RW))[(size_t)m * 512 + c]);
    red[c] = y; __syncthreads();
    float s = 0.f; for (int j = 0; j < 64; ++j) s += red[(c & ~63) + j];
    __syncthreads();
    const float mean = s * (1.f / 64.f), dv = y - mean;
    red[c] = dv * dv; __syncthreads();
    float q = 0.f; for (int j = 0; j < 64; ++j) q += red[(c & ~63) + j];
    const float yn = dv * (1.0f / sqrtf(q * (1.f / 64.f) + 64e-5f)) * a.in[20][c] + a.in[21][c];
    ((bf16*)(a.ws + WS_RW))[(size_t)m * 512 + c] = (bf16)f2bf((yn + o.bonus) * o.g);
}
#define PHASE2 { }
#define PHASE3 { }
#define PHASE4 { }
#define PHASE5 { }
#define HOST_SEQUENCE RUN_PHASES(0, 1); RUN_PHASES(1, 2); \
    hipLaunchKernelGGL(nv_attn, dim3(MT_ROWS), dim3(256), 0, stream, a); \
    hipLaunchKernelGGL(nv_rw_prep, dim3(MT_ROWS), dim3(512), 0, stream, a); \
    hipLaunchKernelGGL(nv_rw_scan, dim3(320), dim3(64), 0, stream, a); \
    hipLaunchKernelGGL(nv_rw_post, dim3(MT_ROWS), dim3(512), 0, stream, a); \
    for (int p = 6; p < N_PHASES; ++p) RUN_PHASES(p, p + 1);

constexpr int N_PHASES = 12;
__global__ void __launch_bounds__(NTHREADS, 2) fwd_kernel(Args args) {
    extern __shared__ __attribute__((aligned(16))) unsigned char lds[];
    Frame F;
    F.lds = (LAS unsigned char*)lds;
    F.tid = threadIdx.x; F.lane = F.tid & 63; F.wave = __builtin_amdgcn_readfirstlane(F.tid >> 6);
    F.G = gridDim.x; { const int bx = blockIdx.x; F.vcu = (F.G % 8 == 0) ? (bx % 8) * (F.G / 8) + bx / 8 : bx; }
    unsigned char* ws = args.ws;
    const int lo = args.ph_lo, hi = args.ph_hi;
#define IN(k) (lo <= (k) && (k) < hi)
    bf16* sga_p = (bf16*)args.out; bf16* sgb_p = sga_p + (size_t)MP * DM;

    if (IN(0)) { p0_prologue(F, args); }
    if (IN(1)) {
        pg8::Gemm g{(const bf16*)(ws + WS_H), (const bf16*)(ws + WS_WT_IN), MT_ROWS, NPAD, DM}; pg8::StaticOrder S; S.init(MT_ROWS, NPAD, F.G, (int)blockIdx.x);
        EpiInProj E{ws, args.out, sga_p, sgb_p};
        pg8::gemm_phase<EpiInProj, pg8::StaticOrder, true, true>(F.lds, g, S, E);
    }
    if (IN(2)) { PHASE2 }
    if (IN(3)) { PHASE3 }
    if (IN(4)) { PHASE4 }
    if (IN(5)) { PHASE5 }
    if (IN(6)) { PHASE6 }
    if (IN(7)) { PHASE7 }
    if (IN(8)) { PHASE8 }
    if (IN(9)) { PHASE9 }
    if (IN(10)) { PHASE10 }
    if (IN(11)) { PHASE11 }
#undef IN
}

extern "C" void kernel_launch(void* const* d_in, const int* in_sizes, int n_in, void* d_out, int out_size, void* d_ws, size_t ws_size, hipStream_t stream) {
    static int grid = 0;
    if (grid == 0) {
        if (n_in != 28 || out_size != (int)O_END || ws_size < WS_END) { fprintf(stderr, "kernel_launch: unexpected shapes: n_in %d out %d ws %zu\n", n_in, out_size, ws_size); grid = -1; return; }
        int dev = 0, cus = 0;
        if (hipGetDevice(&dev) != hipSuccess || hipDeviceGetAttribute(&cus, hipDeviceAttributeMultiprocessorCount, dev) != hipSuccess) { grid = -1; return; }
        if (hipFuncSetAttribute((const void*)fwd_kernel, hipFuncAttributeMaxDynamicSharedMemorySize, LDS_BYTES) != hipSuccess) { fprintf(stderr, "kernel_launch: hipFuncSetAttribute failed\n"); grid = -1; return; }
        int per_cu = 0;
        if (hipOccupancyMaxActiveBlocksPerMultiprocessor(&per_cu, (const void*)fwd_kernel, NTHREADS, LDS_BYTES) != hipSuccess || per_cu < 1) fprintf(stderr, "kernel_launch: occupancy query says %d\n", per_cu);
        (void)hipGetLastError();
        grid = cus;
    }
    if (grid < 0) return;
    (void)hipMemsetAsync((char*)d_ws + WS_CTL, 0, CTL_ZERO_BYTES, stream);
    Args a{};
    for (int i = 0; i < 28; ++i) a.in[i] = (const float*)d_in[i];
    a.out = (float*)d_out; a.ws = (unsigned char*)d_ws;
#define RUN_PHASES(lo_, hi_) do { a.ph_lo = (lo_); a.ph_hi = (hi_); hipLaunchKernelGGL(fwd_kernel, dim3(grid), dim3(NTHREADS), LDS_BYTES, stream, a); } while (0)
    HOST_SEQUENCE
#undef RUN_PHASES
}
```

```cpp
#include <hip/hip_runtime.h>
#include <cstdio>
#include <cstdint>
namespace pg8 {
#define PG8_LAS __attribute__((address_space(3)))
typedef unsigned short bf16_t;
typedef short bf16x8 __attribute__((ext_vector_type(8)));
typedef float f32x4 __attribute__((ext_vector_type(4)));
typedef unsigned u32x4 __attribute__((ext_vector_type(4)));
typedef unsigned u32x2 __attribute__((ext_vector_type(2)));
constexpr int BM = 256, BK = 64, HALF = 128, HTB = HALF * BK * 2  , STAGE_BYTES = 8 * HTB, NXCD = 8, WGM = 8;

__host__ __device__ __forceinline__ int lds_byte(int r, int c) { const int st = (r >> 4) * 2 + (c >> 5), rr = r & 15, cc = c & 31, ob = rr * 64 + cc * 2; return st * 1024 + (ob ^ (((ob >> 9) & 1) << 5)); }
__host__ __device__ __forceinline__ void stage_rc(int b, int& R, int& C) { const int st = b / 1024, sb = b % 1024, swz = sb ^ (((sb >> 9) & 1) << 5); R = (st >> 1) * 16 + swz / 64; C = (st & 1) * 32 + (swz % 64) / 2; }
__host__ __device__ __forceinline__ int perm32(int rho) { const int n = rho >> 4, i = rho & 15; return 8 * (i >> 2) + 4 * n + (i & 3); }

struct Unit { int pm, pn; };
struct Gemm { const bf16_t* A; const bf16_t* Bt; int M, N, K; };

struct StaticOrder {
    int nM, nN, nwg, G, c;
    __host__ __device__ void init(int M, int N, int G_, int c_) { nM = M / BM; nN = N / BM; nwg = nM * nN; G = G_; c = c_; }
    __host__ __device__ bool next(int i, Unit& u) const {
        const long L = (long)i * G + c; if (L >= nwg) return false;
        int wgid = (int)L; { const int q = nwg / NXCD, r = nwg % NXCD, xcd = wgid % NXCD, off = wgid / NXCD; wgid = (xcd < r ? xcd * (q + 1) : r * (q + 1) + (xcd - r) * q) + off; }
        const int nig = WGM * nN, gid = wgid / nig, fm = gid * WGM, gsz = (nM - fm) < WGM ? (nM - fm) : WGM;
        u.pm = fm + ((wgid % nig) % gsz); u.pn = (wgid % nig) / gsz; return true;
    }
    __device__ __forceinline__ void a_ready(const Unit&) const {}
    __device__ __forceinline__ void done(const Unit&) const {}
};
__device__ __forceinline__ unsigned cvt_pk_bf16(float lo, float hi) { unsigned r; asm volatile("v_cvt_pk_bf16_f32 %0, %1, %2" : "=v"(r) : "v"(lo), "v"(hi)); return r; }

template <class Epi, class Sched, bool ALIGN_EPI = false, bool SP2 = false>
__device__ __forceinline__ void gemm_phase(PG8_LAS unsigned char* lds, const Gemm g, const Sched& S, const Epi& E) {
    const int tid = threadIdx.x, wid = __builtin_amdgcn_readfirstlane(tid >> 6), lane = tid & 63, wr = wid >> 2, wc = wid & 3, fr = lane & 15, fq = lane >> 4;
    const int K = g.K, nt = K / BK;
    unsigned voffA[2], voffB[2];
#pragma unroll
    for (int i = 0; i < 2; ++i) { int R, C; stage_rc(tid * 16 + i * 8192, R, C); const int Rb = Epi::PERM ? ((R & ~31) + perm32(R & 31)) : R;
        voffA[i] = (unsigned)(R * K + C) * 2u; voffB[i] = (unsigned)(Rb * K + C) * 2u; }
    const size_t kstep = (size_t)(BK * 2);
    const size_t hstep = (size_t)HALF * K * 2;
    const size_t tstep = 2 * hstep;
    const unsigned ldsw = (unsigned)wid * 1024u;
    const int aoff = lds_byte(wr * 64 + fr, fq * 8), boff = lds_byte(wc * 32 + fr, fq * 8);
#define PG8_SA(b, h) (((b) * 2 + (h)) * HTB)
#define PG8_SB(b, h) ((4 + (b) * 2 + (h)) * HTB)
#define PG8_STAGE(bufoff, gbase, voff) do { _Pragma("unroll") for (int _i = 0; _i < 2; ++_i) \
        __builtin_amdgcn_global_load_lds((const unsigned*)((const char*)(gbase) + (voff)[_i]), (PG8_LAS unsigned*)(lds + (bufoff) + ldsw + _i * 8192), 16, 0, 0); } while (0)
#define PG8_LDA(dst, b, h) do { _Pragma("unroll") for (int m = 0; m < 4; ++m) _Pragma("unroll") for (int k = 0; k < 2; ++k) dst[m][k] = *(const PG8_LAS bf16x8*)(lds + PG8_SA(b, h) + aoff + m * 2048 + k * 1024); } while (0)
#define PG8_LDB(dst, b, h) do { _Pragma("unroll") for (int n = 0; n < 2; ++n) _Pragma("unroll") for (int k = 0; k < 2; ++k) dst[n][k] = *(const PG8_LAS bf16x8*)(lds + PG8_SB(b, h) + boff + n * 2048 + k * 1024); } while (0)
#define PG8_MMA(ai, bj, At, Bt) do { __builtin_amdgcn_s_setprio(1); _Pragma("unroll") for (int m = 0; m < 4; ++m) _Pragma("unroll") for (int n = 0; n < 2; ++n) _Pragma("unroll") for (int k = 0; k < 2; ++k) \
        acc[ai][bj][m][n] = __builtin_amdgcn_mfma_f32_16x16x32_bf16(Bt[n][k], At[m][k], acc[ai][bj][m][n], 0, 0, 0); __builtin_amdgcn_s_setprio(0); } while (0)
#define PG8_WAIT_V(n) asm volatile("s_waitcnt vmcnt(" #n ")" ::: "memory")
#define PG8_WAIT_L(n) asm volatile("s_waitcnt lgkmcnt(" #n ")" ::: "memory")
#define PG8_BAR __builtin_amdgcn_s_barrier()
#define PG8_SCHED __builtin_amdgcn_sched_barrier(0)
    Unit cur, nxt; int ui = 0;
    if (!S.next(0, cur)) return;
    f32x4 acc[2][2][4][2];
#pragma unroll
    for (int a = 0; a < 2; ++a)
#pragma unroll
        for (int b = 0; b < 2; ++b)
#pragma unroll
            for (int m = 0; m < 4; ++m)
#pragma unroll
                for (int n = 0; n < 2; ++n) acc[a][b][m][n] = (f32x4){0.f, 0.f, 0.f, 0.f};
    bf16x8 At[4][2], B0[2][2], B1[2][2];
    const char* cA = (const char*)g.A + (size_t)cur.pm * tstep; const char* cB = (const char*)g.Bt + (size_t)cur.pn * tstep;
    S.a_ready(cur);
    if constexpr (SP2) {
        PG8_STAGE(PG8_SB(0, 0), cB, voffB); PG8_STAGE(PG8_SB(0, 1), cB + hstep, voffB); PG8_STAGE(PG8_SA(0, 0), cA, voffA); PG8_STAGE(PG8_SA(0, 1), cA + hstep, voffA);
        if (wr == 1) PG8_BAR;
        PG8_WAIT_V(2); PG8_BAR;
        PG8_STAGE(PG8_SB(1, 0), cB + kstep, voffB); PG8_STAGE(PG8_SA(1, 0), cA + kstep, voffA); PG8_STAGE(PG8_SB(1, 1), cB + hstep + kstep, voffB);
        PG8_WAIT_V(6); PG8_BAR;
    } else {
        PG8_STAGE(PG8_SB(0, 0), cB, voffB); PG8_STAGE(PG8_SA(0, 0), cA, voffA); PG8_STAGE(PG8_SB(0, 1), cB + hstep, voffB); PG8_STAGE(PG8_SA(0, 1), cA + hstep, voffA);
        if (wr == 1) PG8_BAR;
        PG8_WAIT_V(4); PG8_BAR;
        PG8_STAGE(PG8_SB(1, 0), cB + kstep, voffB); PG8_STAGE(PG8_SA(1, 0), cA + kstep, voffA); PG8_STAGE(PG8_SB(1, 1), cB + hstep + kstep, voffB);
        PG8_WAIT_V(6); PG8_BAR;
    }
    for (;;) {
        const bool has_next = S.next(ui + 1, nxt);
        const char* nA = has_next ? (const char*)g.A + (size_t)nxt.pm * tstep : cA; const char* nB = has_next ? (const char*)g.Bt + (size_t)nxt.pn * tstep : cB;
        for (int t = 0; t < nt; t += 2) {
            const bool last = (t == nt - 2);
            const char* a1 = cA + (size_t)(t + 1) * kstep;
            const char* a2 = last ? nA : cA + (size_t)(t + 2) * kstep; const char* b2 = last ? nB : cB + (size_t)(t + 2) * kstep;
            const char* a3 = a2 + kstep; const char* b3 = b2 + kstep;
            if (last && has_next) S.a_ready(nxt);
            if constexpr (SP2) {
            PG8_LDB(B0, 0, 0); PG8_LDB(B1, 0, 1); PG8_SCHED; PG8_LDA(At, 0, 0); PG8_STAGE(PG8_SA(1, 1), a1 + hstep, voffA);
            PG8_WAIT_V(8); PG8_WAIT_L(0); PG8_BAR; PG8_MMA(0, 0, At, B0); PG8_MMA(0, 1, At, B1); PG8_BAR; PG8_SCHED;
            PG8_LDA(At, 0, 1); PG8_STAGE(PG8_SB(0, 0), b2, voffB); PG8_STAGE(PG8_SB(0, 1), b2 + hstep, voffB); PG8_STAGE(PG8_SA(0, 0), a2, voffA);
            PG8_WAIT_V(8); PG8_WAIT_L(0); PG8_BAR; PG8_MMA(1, 0, At, B0); PG8_MMA(1, 1, At, B1); PG8_BAR; PG8_SCHED;
            PG8_LDB(B0, 1, 0); PG8_LDB(B1, 1, 1); PG8_SCHED; PG8_LDA(At, 1, 0); PG8_STAGE(PG8_SA(0, 1), a2 + hstep, voffA);
            PG8_WAIT_V(8); PG8_WAIT_L(0); PG8_BAR; PG8_MMA(0, 0, At, B0); PG8_MMA(0, 1, At, B1); PG8_BAR; PG8_SCHED;
            PG8_LDA(At, 1, 1); PG8_STAGE(PG8_SB(1, 0), b3, voffB); PG8_STAGE(PG8_SB(1, 1), b3 + hstep, voffB); PG8_STAGE(PG8_SA(1, 0), a3, voffA);
            PG8_WAIT_V(8); PG8_WAIT_L(0); PG8_BAR; PG8_MMA(1, 0, At, B0); PG8_MMA(1, 1, At, B1); PG8_BAR; PG8_SCHED;
            } else {
            PG8_LDB(B0, 0, 0); PG8_SCHED; PG8_LDA(At, 0, 0); PG8_STAGE(PG8_SA(1, 1), a1 + hstep, voffA);
            PG8_WAIT_L(8); PG8_BAR; PG8_WAIT_L(0); PG8_MMA(0, 0, At, B0); PG8_BAR; PG8_SCHED;
            PG8_LDB(B1, 0, 1); PG8_STAGE(PG8_SB(0, 0), b2, voffB);
            PG8_BAR; PG8_WAIT_L(0); PG8_MMA(0, 1, At, B1); PG8_BAR;
            PG8_LDA(At, 0, 1); PG8_STAGE(PG8_SA(0, 0), a2, voffA);
            PG8_BAR; PG8_WAIT_L(0); PG8_MMA(1, 0, At, B0); PG8_BAR; PG8_SCHED;
            PG8_STAGE(PG8_SB(0, 1), b2 + hstep, voffB);
            PG8_WAIT_V(6); PG8_BAR; PG8_MMA(1, 1, At, B1); PG8_BAR;
            PG8_LDB(B0, 1, 0); PG8_SCHED; PG8_LDA(At, 1, 0); PG8_STAGE(PG8_SA(0, 1), a2 + hstep, voffA);
            PG8_WAIT_L(8); PG8_BAR; PG8_WAIT_L(0); PG8_MMA(0, 0, At, B0); PG8_BAR; PG8_SCHED;
            PG8_LDB(B1, 1, 1); PG8_STAGE(PG8_SB(1, 0), b3, voffB);
            PG8_BAR; PG8_WAIT_L(0); PG8_MMA(0, 1, At, B1); PG8_BAR;
            PG8_LDA(At, 1, 1); PG8_STAGE(PG8_SA(1, 0), a3, voffA);
            PG8_BAR; PG8_WAIT_L(0); PG8_MMA(1, 0, At, B0); PG8_BAR; PG8_SCHED;
            PG8_STAGE(PG8_SB(1, 1), b3 + hstep, voffB);
            PG8_WAIT_V(6); PG8_BAR; PG8_MMA(1, 1, At, B1); PG8_BAR;
            }
        }
        if constexpr (ALIGN_EPI) { if (wr == 0) PG8_BAR; }
        if constexpr (!Epi::AFTER_DRAIN) { E(acc, cur, wr, wc, fr, fq); S.done(cur); }
        if (!has_next) break;
#pragma unroll
        for (int a = 0; a < 2; ++a)
#pragma unroll
            for (int b = 0; b < 2; ++b)
#pragma unroll
                for (int m = 0; m < 4; ++m)
#pragma unroll
                    for (int n = 0; n < 2; ++n) acc[a][b][m][n] = (f32x4){0.f, 0.f, 0.f, 0.f};
        cur = nxt; cA = nA; cB = nB; ++ui;
        if constexpr (ALIGN_EPI) { if (wr == 1) PG8_BAR; }
    }
    PG8_WAIT_V(0);
    if constexpr (!ALIGN_EPI) { if (wr == 0) PG8_BAR; }
    PG8_BAR;
    if constexpr (Epi::AFTER_DRAIN) { E.fused(acc, cur, wr, wc, fr, fq, lds, wid, lane); S.done(cur); }
#undef PG8_SA
#undef PG8_SB
#undef PG8_STAGE
#undef PG8_LDA
#undef PG8_LDB
#undef PG8_MMA
#undef PG8_WAIT_V
#undef PG8_WAIT_L
#undef PG8_BAR
#undef PG8_SCHED
}
}

constexpr int DM = 1024, MP = 16384, MS = 512, MT_ROWS = MP + MS;
constexpr int SEQ = 2048, PAST = 2048, DSEQ = 16, NB_P = 8, NB_S = 32, LS = PAST + DSEQ, LSP = 2112;
constexpr int NPAD = 5376, RWC = 1792, DFF = 4096;
constexpr int C_Q = 0, C_K = 512, C_V = 640, C_QI = 768, C_KI = 1280, C_WI = 1344, C_P = 1536, C_GA = 3328, C_GB = 4352;
constexpr size_t O_YP = 0, O_YS = 16777216, O_NKP = 17301504, O_NVP = 19398656, O_NKIP = 21495808, O_WKVP = 22544384, O_SHP = 22806528,
                 O_NKS = 22820864, O_NVS = 22886400, O_NKIS = 22951936, O_WKVS = 22984704, O_SHS = 24033280, O_END = 24090624;
constexpr float QSCALE = 0.125f * 1.4426950408889634f;
constexpr float NORM_EPS = 1e-6f;
constexpr size_t MiB = 1u << 20;
constexpr size_t WS_CTL = 0, CTL_ZERO_BYTES = 1 * MiB;
constexpr size_t WS_WT_IN = 1 * MiB, WS_WT_AB = 12 * MiB, WS_WT_OUT = 14 * MiB, WS_WT_FF1 = 16 * MiB, WS_WT_FF2 = 24 * MiB;
constexpr size_t WS_WT_D = 32 * MiB, WS_WT_A = WS_WT_D + 65536, WS_WT_G = WS_WT_A + 65536;
constexpr size_t WS_H = 33 * MiB;
constexpr size_t WS_P = 66 * MiB;
constexpr size_t WS_QB = 124 * MiB, WS_QIB = 141 * MiB, WS_KBP = 158 * MiB, WS_VBP = 162 * MiB, WS_KIBP = 166 * MiB;
constexpr size_t WS_KS = 168 * MiB, WS_VS = 185 * MiB, WS_KIS = 202 * MiB, WS_WI = 211 * MiB, WS_SGS = 212 * MiB;
constexpr size_t WS_ATT = 214 * MiB, WS_RW = 231 * MiB;
constexpr size_t WS_X1S = 247 * MiB;
constexpr size_t WS_MT = 33 * MiB, WS_NT = 124 * MiB, WS_WY = 142 * MiB, WS_YL = 160 * MiB, WS_G1 = 178 * MiB, WS_E = 195 * MiB, WS_SSN = 66 * MiB;
constexpr size_t WS_MIX = 33 * MiB, WS_H2 = 66 * MiB, WS_HFF = 99 * MiB;
constexpr size_t WS_END = 256 * MiB;
static_assert(WS_HFF + (size_t)MT_ROWS * DFF * 2 <= WS_X1S, "ws map");
constexpr int CW_QUEUE = 64;
constexpr int CW_BAR = 4096;

constexpr int NWAVES = 8, NTHREADS = 512;
constexpr int LDS_BYTES = 163840;
constexpr int MISC_OFF = LDS_BYTES - 1024;

#define GAS __attribute__((address_space(1)))
#define LAS __attribute__((address_space(3)))
typedef unsigned short bf16;
typedef unsigned v4u __attribute__((ext_vector_type(4)));
typedef unsigned v2u __attribute__((ext_vector_type(2)));
typedef float f32x4 __attribute__((ext_vector_type(4)));
typedef float f32x16 __attribute__((ext_vector_type(16)));
typedef short bf16x8 __attribute__((ext_vector_type(8)));
typedef short s16x4 __attribute__((ext_vector_type(4)));
#define LDS_WAIT() asm volatile("s_waitcnt lgkmcnt(0)" ::: "memory")
#define VM_WAIT() asm volatile("s_waitcnt vmcnt(0)" ::: "memory")
__device__ __forceinline__ unsigned f2bf(float f) { unsigned u = __builtin_bit_cast(unsigned, f); return (u + 0x7fffu + ((u >> 16) & 1u)) >> 16; }
__device__ __forceinline__ unsigned pk2(float lo, float hi) { return f2bf(lo) | (f2bf(hi) << 16); }
__device__ __forceinline__ float bf2f(unsigned short h) { return __builtin_bit_cast(float, (unsigned)h << 16); }
__device__ __forceinline__ float bflo(unsigned w) { return __builtin_bit_cast(float, w << 16); }
__device__ __forceinline__ float bfhi(unsigned w) { return __builtin_bit_cast(float, w & 0xffff0000u); }
__device__ __forceinline__ float wave_sum(float v) {
#pragma unroll
    for (int o = 1; o < 64; o <<= 1) v += __shfl_xor(v, o);
    return v;
}
__device__ __forceinline__ float sigmoidf_(float x) { return 1.0f / (1.0f + __expf(-x)); }

struct Args {
    const float* in[28];
    float* out; unsigned char* ws;
    int ph_lo, ph_hi;
};
struct Frame {
    LAS unsigned char* lds;
    int tid, lane, wave, vcu, G;
};

__device__ __forceinline__ void p0_transpose_item(const float* W, int ldw, int src_col0, bf16* WT, int dst_ld, int dst_row0, int dst_k0, int nblk, LAS float* scr, int item, int lane) {
    const int kb = item / nblk, nb = item % nblk, k0 = 64 * kb, n0 = 32 * nb;
#pragma unroll 8
    for (int i = 0; i < 32; ++i) { const int kk = 2 * i + (lane >> 5); scr[kk * 33 + (lane & 31)] = W[(size_t)(k0 + kk) * ldw + src_col0 + n0 + (lane & 31)]; }
    LDS_WAIT(); asm volatile("" ::: "memory");
    const int c = lane & 7;
#pragma unroll
    for (int j = 0; j < 4; ++j) { const int n = (lane >> 3) + 8 * j; const LAS float* s = scr + (8 * c) * 33 + n;
        v4u o; o.x = pk2(s[0 * 33], s[1 * 33]); o.y = pk2(s[2 * 33], s[3 * 33]); o.z = pk2(s[4 * 33], s[5 * 33]); o.w = pk2(s[6 * 33], s[7 * 33]);
        *(GAS v4u*)(WT + (size_t)(dst_row0 + n0 + n) * dst_ld + dst_k0 + k0 + 8 * c) = o; }
    LDS_WAIT(); asm volatile("" ::: "memory");
}
__device__ __forceinline__ void rms_row_to_bf16(int lane, const float* xrow, const float* g, bf16* orow) {
    const GAS f32x4* xr = (const GAS f32x4*)xrow + lane; const GAS f32x4* gr = (const GAS f32x4*)g + lane;
    f32x4 v[4]; float s = 0.f;
#pragma unroll
    for (int j = 0; j < 4; ++j) { v[j] = xr[64 * j]; s += (v[j].x * v[j].x + v[j].y * v[j].y) + (v[j].z * v[j].z + v[j].w * v[j].w); }
    const float rstd = 1.0f / sqrtf(wave_sum(s) * (1.f / DM) + NORM_EPS);
    GAS v2u* o8 = (GAS v2u*)orow + lane;
#pragma unroll
    for (int j = 0; j < 4; ++j) { const f32x4 gg = gr[64 * j]; v2u o; o.x = pk2(v[j].x * rstd * gg.x, v[j].y * rstd * gg.y); o.y = pk2(v[j].z * rstd * gg.z, v[j].w * rstd * gg.w); o8[64 * j] = o; }
}
__device__ __forceinline__ void p0_prologue(Frame& F, const Args& a) {
    unsigned char* ws = a.ws;
    LAS float* scr = (LAS float*)(F.lds + F.wave * 16384);
    const int gw = F.vcu * NWAVES + F.wave, NGW = F.G * NWAVES;
    int base = 0;
#define TRJ(in_idx, ldw, sc0, ncols, K, dst, dld, dr0, dk0) { const int nblk = (ncols) / 32, nit = ((K) / 64) * nblk; int first = (gw - base) % NGW; if (first < 0) first += NGW; \
        for (int it = first; it < nit; it += NGW) p0_transpose_item(a.in[in_idx], ldw, sc0, (bf16*)(ws + (dst)), dld, dr0, dk0, nblk, scr, it, F.lane); base += nit; }
    TRJ(9, 5192, 0, 512, 1024, WS_WT_IN, 1024, C_Q, 0) TRJ(9, 5192, 512, 128, 1024, WS_WT_IN, 1024, C_K, 0) TRJ(9, 5192, 640, 128, 1024, WS_WT_IN, 1024, C_V, 0)
    TRJ(9, 5192, 768, 512, 1024, WS_WT_IN, 1024, C_QI, 0) TRJ(9, 5192, 1280, 64, 1024, WS_WT_IN, 1024, C_KI, 0) TRJ(9, 5192, 1352, 1792, 1024, WS_WT_IN, 1024, C_P, 0)
    TRJ(9, 5192, 3144, 1024, 1024, WS_WT_IN, 1024, C_GA, 0) TRJ(9, 5192, 4168, 1024, 1024, WS_WT_IN, 1024, C_GB, 0)
    TRJ(10, 1024, 0, 1024, 512, WS_WT_AB, 512, 0, 0) TRJ(22, 1024, 0, 1024, 512, WS_WT_AB + MiB, 512, 0, 0)
    TRJ(23, 1024, 0, 1024, 1024, WS_WT_OUT, 1024, 0, 0) TRJ(25, 4096, 0, 4096, 1024, WS_WT_FF1, 1024, 0, 0) TRJ(26, 1024, 0, 1024, 4096, WS_WT_FF2, 4096, 0, 0)
    TRJ(13, 512, 0, 512, 64, WS_WT_D, 64, 0, 0) TRJ(15, 512, 0, 512, 64, WS_WT_A, 64, 0, 0) TRJ(16, 512, 0, 512, 128, WS_WT_G, 128, 0, 0)
#undef TRJ
    if (gw == NGW - 1) {
        const float* W = a.in[9]; bf16* WT = (bf16*)(ws + WS_WT_IN);
        for (int e = F.lane; e < 8 * 1024; e += 64) { const int n = e >> 10, k = e & 1023; WT[(size_t)(C_WI + n) * 1024 + k] = (bf16)f2bf(W[(size_t)k * 5192 + 1344 + n]); }
    }
    bf16* H = (bf16*)(ws + WS_H);
    for (int m = gw; m < MT_ROWS; m += NGW) { const float* xr = (m < MP) ? a.in[0] + (size_t)m * DM : a.in[1] + (size_t)(m - MP) * DM; rms_row_to_bf16(F.lane, xr, a.in[8], H + (size_t)m * DM); }
    const int gt = F.vcu * NTHREADS + F.tid, NGT = F.G * NTHREADS;
    {
        const int nit = NB_S * PAST * 128 / 8;
        for (int it = gt; it < 2 * nit; it += NGT) { const int which = it >= nit, e = (which ? it - nit : it) * 8; const float* src = a.in[2 + which] + e;
            const int b = e / (PAST * 128), rem = e % (PAST * 128); bf16* dst = (bf16*)(ws + (which ? WS_VS : WS_KS)) + (size_t)b * LSP * 128 + rem;
            const f32x4 x0 = *(const GAS f32x4*)src, x1 = *(const GAS f32x4*)(src + 4); v4u o; o.x = pk2(x0.x, x0.y); o.y = pk2(x0.z, x0.w); o.z = pk2(x1.x, x1.y); o.w = pk2(x1.z, x1.w); *(GAS v4u*)dst = o; }
        const int nit2 = NB_S * PAST * 64 / 8;
        for (int it = gt; it < nit2; it += NGT) { const int e = it * 8; const float* src = a.in[4] + e; const int b = e / (PAST * 64), rem = e % (PAST * 64); bf16* dst = (bf16*)(ws + WS_KIS) + (size_t)b * LSP * 64 + rem;
            const f32x4 x0 = *(const GAS f32x4*)src, x1 = *(const GAS f32x4*)(src + 4); v4u o; o.x = pk2(x0.x, x0.y); o.y = pk2(x0.z, x0.w); o.z = pk2(x1.x, x1.y); o.w = pk2(x1.z, x1.w); *(GAS v4u*)dst = o; }
        const int npad = NB_S * (LSP - LS) * 128 / 8;
        for (int it = gt; it < 2 * npad; it += NGT) { const int which = it >= npad, e = (which ? it - npad : it) * 8; const int b = e / ((LSP - LS) * 128), rem = e % ((LSP - LS) * 128);
            *(GAS v4u*)((bf16*)(ws + (which ? WS_VS : WS_KS)) + ((size_t)b * LSP + LS) * 128 + rem) = (v4u){0u, 0u, 0u, 0u}; }
        const int npad2 = NB_S * (LSP - LS) * 64 / 8;
        for (int it = gt; it < npad2; it += NGT) { const int e = it * 8; const int b = e / ((LSP - LS) * 64), rem = e % ((LSP - LS) * 64);
            *(GAS v4u*)((bf16*)(ws + WS_KIS) + ((size_t)b * LSP + LS) * 64 + rem) = (v4u){0u, 0u, 0u, 0u}; }
    }
}
typedef GAS unsigned gu32;
typedef GAS unsigned long long gu64;
#define RLX_AGENT __ATOMIC_RELAXED, __HIP_MEMORY_SCOPE_AGENT
__device__ __forceinline__ unsigned long long rt() { return __builtin_amdgcn_s_memrealtime(); }
#define XB_TMO      128
#define XB_XCNT(j)  (256  + 64 * (j))
#define XB_XSUB(j)  (1280 + 64 * (j))
#define XB_XGEN(j)  (2304 + 64 * (j))
#define XB_TOP      3328
#define XB_TOPGEN   3392
#define XCD_BAR_WORDS 3456
#define XB_SPIN_CAP (1u << 18)

__device__ __forceinline__ unsigned xb_ld(unsigned* p)              { return __hip_atomic_load(p, __ATOMIC_RELAXED, __HIP_MEMORY_SCOPE_AGENT); }
__device__ __forceinline__ unsigned xb_add(unsigned* p, unsigned v) { return __hip_atomic_fetch_add(p, v, __ATOMIC_RELAXED, __HIP_MEMORY_SCOPE_AGENT); }
__device__ __forceinline__ unsigned xb_xcc_id() { return (unsigned)__builtin_amdgcn_s_getreg((3 << 11) | 20) & 0xFu; }
#define XB_SPIN(cond, bar) do { unsigned _sp = 0; while (cond) { __builtin_amdgcn_s_sleep(1); \
    if ((++_sp & 255u) == 0u) { if (xb_ld(&(bar)[XB_TMO])) break; if (_sp > XB_SPIN_CAP) { atomicAdd(&(bar)[XB_TMO], 1u); break; } } } } while (0)

struct XcdBarrier {
    unsigned* bar; unsigned x;
    volatile LAS unsigned* st;
};

__device__ __forceinline__ XcdBarrier xcd_barrier_post(unsigned* bar, volatile LAS unsigned* st) {
    XcdBarrier b; b.bar = bar; b.x = xb_xcc_id(); b.st = st;
    if (threadIdx.x == 0) (void)xb_add(&bar[XB_XCNT(b.x)], 1u);
    return b;
}
__device__ __forceinline__ void xcd_barrier_complete(unsigned* bar, unsigned x, unsigned& nloc, unsigned& nx) {
    const unsigned G = gridDim.x * gridDim.y * gridDim.z;
    unsigned sum, cnt, mine, sp = 0u;
    for (;;) {
        sum = 0u; cnt = 0u; mine = 0u;
#pragma unroll
        for (unsigned j = 0; j < 16; ++j) { const unsigned c = xb_ld(&bar[XB_XCNT(j)]); sum += c; cnt += (c > 0u) ? 1u : 0u; mine = (j == x) ? c : mine; }
        if (sum == G) break;
        __builtin_amdgcn_s_sleep(1);
        if ((++sp & 255u) == 0u) { if (xb_ld(&bar[XB_TMO])) break; if (sp > XB_SPIN_CAP) { atomicAdd(&bar[XB_TMO], 1u); break; } }
    }
    nloc = mine > 0u ? mine : 1u; nx = cnt > 0u ? cnt : 1u;
}

__device__ __forceinline__ void xcd_barrier(const XcdBarrier& b) {
    asm volatile("s_waitcnt vmcnt(0)" ::: "memory");
    __syncthreads();
    if (threadIdx.x == 0) {
        unsigned* bar = b.bar;
        __builtin_amdgcn_s_waitcnt(0);
        unsigned nloc = b.st[0], nx = b.st[1];
        if (nloc == 0u) { xcd_barrier_complete(bar, b.x, nloc, nx); b.st[0] = nloc; b.st[1] = nx; }
        const unsigned old = xb_add(&bar[XB_XSUB(b.x)], 1u);
        const unsigned gen = old / nloc;
        if (old + 1u == (gen + 1u) * nloc) {
            __builtin_amdgcn_fence(__ATOMIC_RELEASE, "agent");
            asm volatile("s_waitcnt vmcnt(0)" ::: "memory");
            const unsigned og = xb_add(&bar[XB_TOP], 1u);
            const unsigned tg = og / nx;
            if (og + 1u == (tg + 1u) * nx) xb_add(&bar[XB_TOPGEN], 1u);
            else XB_SPIN(xb_ld(&bar[XB_TOPGEN]) == tg, bar);
            __builtin_amdgcn_fence(__ATOMIC_ACQUIRE, "agent");
            xb_add(&bar[XB_XGEN(b.x)], 1u);
            asm volatile("s_waitcnt vmcnt(0)" ::: "memory");
        } else {
            XB_SPIN(xb_ld(&bar[XB_XGEN(b.x)]) == gen, bar);
            __builtin_amdgcn_fence(__ATOMIC_ACQUIRE, "agent");
            asm volatile("s_waitcnt vmcnt(0)" ::: "memory");
        }
    }
    __syncthreads();
}

struct EpiInProj {
    static constexpr bool PERM = true, AFTER_DRAIN = false;
    unsigned char* ws; float* out; bf16* sga_p; bf16* sgb_p;
    __device__ __forceinline__ void operator()(const f32x4 (&acc)[2][2][4][2], const pg8::Unit& u, int wr, int wc, int fr, int fq) const {
        const int pn = u.pn;
#pragma unroll
        for (int ai = 0; ai < 2; ++ai)
#pragma unroll
            for (int m = 0; m < 4; ++m) {
                const int row = u.pm * 256 + ai * 128 + wr * 64 + m * 16 + fr;
                const bool smp = row >= MP; const int rs = row - MP, sb = rs >> 4, st = rs & 15;
#pragma unroll
                for (int bj = 0; bj < 2; ++bj) {
                    const int c0 = pn * 256 + bj * 128 + wc * 32 + fq * 8;
                    const f32x4 v0 = acc[ai][bj][m][0], v1 = acc[ai][bj][m][1];
                    if (pn < 2) {
                        v4u o; o.x = pk2(v0.x * QSCALE, v0.y * QSCALE); o.y = pk2(v0.z * QSCALE, v0.w * QSCALE); o.z = pk2(v1.x * QSCALE, v1.y * QSCALE); o.w = pk2(v1.z * QSCALE, v1.w * QSCALE);
                        *(GAS v4u*)((bf16*)(ws + WS_QB) + (size_t)row * 512 + c0) = o;
                    } else if (pn == 2) {
                        const int c = c0 - (bj ? C_V : C_K);
                        float* of = out + (smp ? (bj ? O_NVS : O_NKS) + (size_t)rs * 128 : (bj ? O_NVP : O_NKP) + (size_t)row * 128) + c;
                        *(GAS f32x4*)of = v0; *(GAS f32x4*)(of + 4) = v1;
                        bf16* ob = smp ? (bf16*)(ws + (bj ? WS_VS : WS_KS)) + ((size_t)sb * LSP + PAST + st) * 128 + c : (bf16*)(ws + (bj ? WS_VBP : WS_KBP)) + (size_t)row * 128 + c;
                        v4u o; o.x = pk2(v0.x, v0.y); o.y = pk2(v0.z, v0.w); o.z = pk2(v1.x, v1.y); o.w = pk2(v1.z, v1.w); *(GAS v4u*)ob = o;
                    } else if (pn < 5) {
                        v4u o; o.x = pk2(v0.x * 0.125f, v0.y * 0.125f); o.y = pk2(v0.z * 0.125f, v0.w * 0.125f); o.z = pk2(v1.x * 0.125f, v1.y * 0.125f); o.w = pk2(v1.z * 0.125f, v1.w * 0.125f);
                        *(GAS v4u*)((bf16*)(ws + WS_QIB) + (size_t)row * 512 + (c0 - C_QI)) = o;
                    } else if (pn == 5) {
                        if (c0 < C_WI) {
                            const int c = c0 - C_KI;
                            float* of = out + (smp ? O_NKIS + (size_t)rs * 64 : O_NKIP + (size_t)row * 64) + c;
                            *(GAS f32x4*)of = v0; *(GAS f32x4*)(of + 4) = v1;
                            bf16* ob = smp ? (bf16*)(ws + WS_KIS) + ((size_t)sb * LSP + PAST + st) * 64 + c : (bf16*)(ws + WS_KIBP) + (size_t)row * 64 + c;
                            v4u o; o.x = pk2(v0.x, v0.y); o.y = pk2(v0.z, v0.w); o.z = pk2(v1.x, v1.y); o.w = pk2(v1.z, v1.w); *(GAS v4u*)ob = o;
                        } else if (c0 == C_WI) {
                            const float s = 0.35355339059327373f; float* of = (float*)(ws + WS_WI) + (size_t)row * 8;
                            *(GAS f32x4*)of = v0 * s; *(GAS f32x4*)(of + 4) = v1 * s;
                        }
                    } else if (pn < 13) {
                        const int c = c0 - C_P;
                        v4u o; o.x = pk2(v0.x, v0.y); o.y = pk2(v0.z, v0.w); o.z = pk2(v1.x, v1.y); o.w = pk2(v1.z, v1.w);
                        *(GAS v4u*)((bf16*)(ws + WS_P) + (size_t)row * RWC + c) = o;
                        const bool last = smp ? (st == DSEQ - 1) : ((row & (SEQ - 1)) == SEQ - 1);
                        if (last) { float* of = out + (smp ? O_SHS + (size_t)sb * RWC : O_SHP + (size_t)(row >> 11) * RWC) + c; *(GAS f32x4*)of = v0; *(GAS f32x4*)(of + 4) = v1; }
                    } else {
                        const bool isb = pn >= 17; const int c = c0 - (isb ? C_GB : C_GA);
                        v4u o; o.x = pk2(sigmoidf_(v0.x), sigmoidf_(v0.y)); o.y = pk2(sigmoidf_(v0.z), sigmoidf_(v0.w)); o.z = pk2(sigmoidf_(v1.x), sigmoidf_(v1.y)); o.w = pk2(sigmoidf_(v1.z), sigmoidf_(v1.w));
                        bf16* ob = smp ? (bf16*)(ws + WS_SGS) + (size_t)(isb ? MS : 0) * DM + (size_t)rs * DM + c : (isb ? sgb_p : sga_p) + (size_t)row * DM + c;
                        *(GAS v4u*)ob = o;
                    }
                }
            }
    }
};
template <bool ACCUM> struct EpiGate {
    static constexpr bool PERM = true, AFTER_DRAIN = false;
    const bf16* sg_p; const bf16* sg_s; bf16* mix;
    __device__ __forceinline__ void operator()(const f32x4 (&acc)[2][2][4][2], const pg8::Unit& u, int wr, int wc, int fr, int fq) const {
#pragma unroll
        for (int ai = 0; ai < 2; ++ai)
#pragma unroll
            for (int m = 0; m < 4; ++m) {
                const int row = u.pm * 256 + ai * 128 + wr * 64 + m * 16 + fr; const bool smp = row >= MP;
#pragma unroll
                for (int bj = 0; bj < 2; ++bj) {
                    const int c0 = u.pn * 256 + bj * 128 + wc * 32 + fq * 8;
                    const v4u g = *(const GAS v4u*)((smp ? sg_s + (size_t)(row - MP) * DM : sg_p + (size_t)row * DM) + c0);
                    f32x4 v0 = acc[ai][bj][m][0], v1 = acc[ai][bj][m][1];
                    v0.x *= bflo(g.x); v0.y *= bfhi(g.x); v0.z *= bflo(g.y); v0.w *= bfhi(g.y); v1.x *= bflo(g.z); v1.y *= bfhi(g.z); v1.z *= bflo(g.w); v1.w *= bfhi(g.w);
                    bf16* op = mix + (size_t)row * DM + c0;
                    if (ACCUM) { const v4u p = *(const GAS v4u*)op; v0.x += bflo(p.x); v0.y += bfhi(p.x); v0.z += bflo(p.y); v0.w += bfhi(p.y); v1.x += bflo(p.z); v1.y += bfhi(p.z); v1.z += bflo(p.w); v1.w += bfhi(p.w); }
                    v4u o; o.x = pk2(v0.x, v0.y); o.y = pk2(v0.z, v0.w); o.z = pk2(v1.x, v1.y); o.w = pk2(v1.z, v1.w); *(GAS v4u*)op = o;
                }
            }
    }
};
struct EpiResid {
    static constexpr bool PERM = false, AFTER_DRAIN = false;
    const float* src_p; const float* src_s; float* dst_p; float* dst_s;
    __device__ __forceinline__ void operator()(const f32x4 (&acc)[2][2][4][2], const pg8::Unit& u, int wr, int wc, int fr, int fq) const {
#pragma unroll
        for (int ai = 0; ai < 2; ++ai)
#pragma unroll
            for (int m = 0; m < 4; ++m) {
                const int row = u.pm * 256 + ai * 128 + wr * 64 + m * 16 + fr; const bool smp = row >= MP;
                const float* s = smp ? src_s + (size_t)(row - MP) * DM : src_p + (size_t)row * DM; float* d = smp ? dst_s + (size_t)(row - MP) * DM : dst_p + (size_t)row * DM;
#pragma unroll
                for (int bj = 0; bj < 2; ++bj)
#pragma unroll
                    for (int n = 0; n < 2; ++n) { const int c = u.pn * 256 + bj * 128 + wc * 32 + n * 16 + fq * 4; *(GAS f32x4*)(d + c) = *(const GAS f32x4*)(s + c) + acc[ai][bj][m][n]; }
            }
    }
};
struct EpiRelu2 {
    static constexpr bool PERM = true, AFTER_DRAIN = false;
    bf16* O;
    __device__ __forceinline__ void operator()(const f32x4 (&acc)[2][2][4][2], const pg8::Unit& u, int wr, int wc, int fr, int fq) const {
#pragma unroll
        for (int ai = 0; ai < 2; ++ai)
#pragma unroll
            for (int m = 0; m < 4; ++m) {
                const int row = u.pm * 256 + ai * 128 + wr * 64 + m * 16 + fr;
#pragma unroll
                for (int bj = 0; bj < 2; ++bj) {
                    const int c0 = u.pn * 256 + bj * 128 + wc * 32 + fq * 8;
                    f32x4 v0 = acc[ai][bj][m][0], v1 = acc[ai][bj][m][1];
                    v0 = __builtin_elementwise_max(v0, (f32x4){0.f, 0.f, 0.f, 0.f}); v1 = __builtin_elementwise_max(v1, (f32x4){0.f, 0.f, 0.f, 0.f}); v0 = v0 * v0; v1 = v1 * v1;
                    v4u o; o.x = pk2(v0.x, v0.y); o.y = pk2(v0.z, v0.w); o.z = pk2(v1.x, v1.y); o.w = pk2(v1.z, v1.w); *(GAS v4u*)(O + (size_t)row * DFF + c0) = o;
                }
            }
    }
};

__device__ __forceinline__ void rms_row_to_f32(int lane, const float* xrow, const float* g, float* orow) {
    const GAS f32x4* xr = (const GAS f32x4*)xrow + lane; const GAS f32x4* gr = (const GAS f32x4*)g + lane;
    f32x4 v[4]; float s = 0.f;
#pragma unroll
    for (int j = 0; j < 4; ++j) { v[j] = xr[64 * j]; s += (v[j].x * v[j].x + v[j].y * v[j].y) + (v[j].z * v[j].z + v[j].w * v[j].w); }
    const float rstd = 1.0f / sqrtf(wave_sum(s) * (1.f / DM) + NORM_EPS);
    GAS f32x4* o = (GAS f32x4*)orow + lane;
#pragma unroll
    for (int j = 0; j < 4; ++j) { const f32x4 gg = gr[64 * j]; o[64 * j] = v[j] * rstd * gg; }
}
#define PHASE6 { pg8::StaticOrder S; S.init(MT_ROWS, DM, F.G, (int)blockIdx.x); \
    { pg8::Gemm g{(const bf16*)(ws + WS_ATT), (const bf16*)(ws + WS_WT_AB), MT_ROWS, DM, 512}; EpiGate<false> E{sga_p, (const bf16*)(ws + WS_SGS), (bf16*)(ws + WS_MIX)}; \
      pg8::gemm_phase<EpiGate<false>, pg8::StaticOrder, true, true>(F.lds, g, S, E); } \
    { pg8::Gemm g{(const bf16*)(ws + WS_RW), (const bf16*)(ws + WS_WT_AB + MiB), MT_ROWS, DM, 512}; EpiGate<true> E{sgb_p, (const bf16*)(ws + WS_SGS) + (size_t)MS * DM, (bf16*)(ws + WS_MIX)}; \
      pg8::gemm_phase<EpiGate<true>, pg8::StaticOrder, true, true>(F.lds, g, S, E); } }
#define PHASE7 { pg8::StaticOrder S; S.init(MT_ROWS, DM, F.G, (int)blockIdx.x); pg8::Gemm g{(const bf16*)(ws + WS_MIX), (const bf16*)(ws + WS_WT_OUT), MT_ROWS, DM, DM}; \
    EpiResid E{args.in[0], args.in[1], args.out + O_YP, (float*)(ws + WS_X1S)}; pg8::gemm_phase<EpiResid, pg8::StaticOrder, true, true>(F.lds, g, S, E); }
#define PHASE8 { const int gw = F.vcu * NWAVES + F.wave, NGW = F.G * NWAVES; \
    for (int m = gw; m < MT_ROWS; m += NGW) { const float* xr = (m < MP) ? args.out + O_YP + (size_t)m * DM : (const float*)(ws + WS_X1S) + (size_t)(m - MP) * DM; rms_row_to_bf16(F.lane, xr, args.in[24], (bf16*)(ws + WS_H2) + (size_t)m * DM); } }
#define PHASE9 { pg8::StaticOrder S; S.init(MT_ROWS, DFF, F.G, (int)blockIdx.x); pg8::Gemm g{(const bf16*)(ws + WS_H2), (const bf16*)(ws + WS_WT_FF1), MT_ROWS, DFF, DM}; \
    EpiRelu2 E{(bf16*)(ws + WS_HFF)}; pg8::gemm_phase<EpiRelu2, pg8::StaticOrder, true, true>(F.lds, g, S, E); }
#define PHASE10 { pg8::StaticOrder S; S.init(MT_ROWS, DM, F.G, (int)blockIdx.x); pg8::Gemm g{(const bf16*)(ws + WS_HFF), (const bf16*)(ws + WS_WT_FF2), MT_ROWS, DM, DFF}; \
    EpiResid E{args.out + O_YP, (const float*)(ws + WS_X1S), args.out + O_YP, (float*)(ws + WS_X1S)}; pg8::gemm_phase<EpiResid, pg8::StaticOrder, true, true>(F.lds, g, S, E); }
#define PHASE11 { const int gw = F.vcu * NWAVES + F.wave, NGW = F.G * NWAVES; \
    for (int m = gw; m < MT_ROWS; m += NGW) { const float* xr = (m < MP) ? args.out + O_YP + (size_t)m * DM : (const float*)(ws + WS_X1S) + (size_t)(m - MP) * DM; \
        float* yr = (m < MP) ? args.out + O_YP + (size_t)m * DM : args.out + O_YS + (size_t)(m - MP) * DM; rms_row_to_f32(F.lane, xr, args.in[27], yr); } }

__device__ __forceinline__ int t5_bucket(int rel) {
    const int n = rel < 0 ? -rel : rel; int r = rel > 0 ? 16 : 0;
    if (n < 8) return r + n;
    return r + 8 + (n >= 12) + (n >= 16) + (n >= 23) + (n >= 32) + (n >= 46) + (n >= 64) + (n >= 91);
}
__device__ __forceinline__ unsigned ordkey(float f) { const unsigned u = __builtin_bit_cast(unsigned, f); return (u & 0x80000000u) ? ~u : (u | 0x80000000u); }

__device__ __forceinline__ void nv_attn_phase(Frame& F, const Args& a) {
    struct Sh { float qi[512]; float q[512]; float wi[8]; unsigned key[LSP]; unsigned char sel[LSP]; float lg[LSP]; unsigned cnt; float red[256]; float o[4][64]; };
    const int half = F.tid >> 8, tid = F.tid & 255;
    LAS Sh* sh = (LAS Sh*)(F.lds + half * 32768);
    unsigned char* ws = a.ws; const float* relb = a.in[7];
    for (int pr = blockIdx.x; pr < MT_ROWS / 2; pr += F.G) {
        const int m = 2 * pr + half;
        const bool smp = m >= MP; const int b = smp ? (m - MP) >> 4 : m >> 11, t = smp ? (m - MP) & 15 : m & 2047;
        const int qpos = smp ? PAST + t : t; const int n = smp ? LS : 64 * (t / 64 + 1);
        const bf16* Ki = smp ? (const bf16*)(ws + WS_KIS) + (size_t)b * LSP * 64 : (const bf16*)(ws + WS_KIBP) + (size_t)b * SEQ * 64;
        const bf16* Kb = smp ? (const bf16*)(ws + WS_KS) + (size_t)b * LSP * 128 : (const bf16*)(ws + WS_KBP) + (size_t)b * SEQ * 128;
        const bf16* Vb = smp ? (const bf16*)(ws + WS_VS) + (size_t)b * LSP * 128 : (const bf16*)(ws + WS_VBP) + (size_t)b * SEQ * 128;
        __syncthreads();
        for (int i = tid; i < 512; i += 256) { sh->qi[i] = bf2f(((const bf16*)(ws + WS_QIB))[(size_t)m * 512 + i]); sh->q[i] = bf2f(((const bf16*)(ws + WS_QB))[(size_t)m * 512 + i]); }
        if (tid < 8) sh->wi[tid] = ((const float*)(ws + WS_WI))[(size_t)m * 8 + tid];
        __syncthreads();
        for (int s = tid; s < n; s += 256) {
            float kd[64];
#pragma unroll
            for (int d = 0; d < 64; ++d) kd[d] = bf2f(Ki[(size_t)s * 64 + d]);
            float sc = 0.f;
            for (int h = 0; h < 8; ++h) { float dot = 0.f;
#pragma unroll
                for (int d = 0; d < 64; ++d) dot = fmaf(sh->qi[h * 64 + d], kd[d], dot);
                sc = fmaf(sh->wi[h], fmaxf(dot, 0.f), sc); }
            sh->key[s] = ordkey(sc); sh->sel[s] = 1;
        }
        __syncthreads();
        if (n > 256) {
            unsigned prefix = 0u;
            for (int bit = 31; bit >= 0; --bit) {
                const unsigned cand = prefix | (1u << bit);
                if (tid == 0) sh->cnt = 0u;
                __syncthreads();
                unsigned c = 0; for (int s = tid; s < n; s += 256) c += sh->key[s] >= cand;
                atomicAdd((unsigned*)&sh->cnt, c);
                __syncthreads();
                if (sh->cnt >= 256u) prefix = cand;
                __syncthreads();
            }
            if (tid == 0) { int gt = 0; for (int s = 0; s < n; ++s) gt += sh->key[s] > prefix; int need = 256 - gt;
                for (int s = 0; s < n; ++s) { const unsigned k = sh->key[s]; unsigned char v = 0; if (k > prefix) v = 1; else if (k == prefix && need > 0) { v = 1; --need; } sh->sel[s] = v; } }
            __syncthreads();
        }
        for (int h = 0; h < 8; ++h) {
            const int j = h >> 2; float mx = -3.0e38f;
            for (int s = tid; s < n; s += 256) { float lg = -3.0e38f;
                if (sh->sel[s]) { float dot = 0.f;
#pragma unroll 8
                    for (int d = 0; d < 64; ++d) dot = fmaf(sh->q[h * 64 + d], bf2f(Kb[(size_t)s * 128 + j * 64 + d]), dot);
                    lg = dot + relb[t5_bucket(s - qpos) * 8 + h] * 1.4426950408889634f; }
                sh->lg[s] = lg; mx = fmaxf(mx, lg); }
            sh->red[tid] = mx; __syncthreads();
            for (int o = 128; o > 0; o >>= 1) { if (tid < o) sh->red[tid] = fmaxf(sh->red[tid], sh->red[tid + o]); __syncthreads(); }
            mx = sh->red[0]; __syncthreads();
            float sum = 0.f;
            for (int s = tid; s < n; s += 256) { const float p = sh->sel[s] ? exp2f(sh->lg[s] - mx) : 0.f; sh->lg[s] = p; sum += p; }
            sh->red[tid] = sum; __syncthreads();
            for (int o = 128; o > 0; o >>= 1) { if (tid < o) sh->red[tid] += sh->red[tid + o]; __syncthreads(); }
            sum = sh->red[0]; __syncthreads();
            const int d = tid & 63, grp = tid >> 6; float acc = 0.f;
            for (int s = grp; s < n; s += 4) { const float p = sh->lg[s]; if (p != 0.f) acc = fmaf(p, bf2f(Vb[(size_t)s * 128 + j * 64 + d]), acc); }
            sh->o[grp][d] = acc; __syncthreads();
            if (tid < 64) ((bf16*)(ws + WS_ATT))[(size_t)m * 512 + h * 64 + tid] = (bf16)f2bf((sh->o[0][tid] + sh->o[1][tid] + sh->o[2][tid] + sh->o[3][tid]) / sum);
            __syncthreads();
        }
    }
}

struct RwTok { float r, k, v, decay, a, g, kk, kh, b, bonus; };
__device__ __forceinline__ RwTok rw_token_prep(const Args& a, int m, int c, LAS float* xs  , LAS float* red  ) {
    unsigned char* ws = a.ws; const bf16* P = (const bf16*)(ws + WS_P);
    const bool smp = m >= MP; const int b = smp ? (m - MP) >> 4 : m >> 11, t = smp ? (m - MP) & 15 : m & 2047;
    const float* mu = a.in[11];
    __syncthreads();
    for (int col = c; col < RWC; col += 512) { const float p = bf2f(P[(size_t)m * RWC + col]); const float pv = (t > 0) ? bf2f(P[(size_t)(m - 1) * RWC + col]) : (smp ? a.in[6][(size_t)b * RWC + col] : 0.f);
        xs[col] = p + (pv - p) * mu[col]; }
    __syncthreads();
    RwTok o; o.r = xs[c]; o.k = xs[512 + c]; o.v = xs[1024 + c];
    float wl = a.in[12][c], al = a.in[14][c], g = 0.f;
#pragma unroll 2
    for (int mm = 0; mm < 64; ++mm) { wl = fmaf(tanhf(xs[1536 + mm]), a.in[13][mm * 512 + c], wl); al = fmaf(xs[1600 + mm], a.in[15][mm * 512 + c], al); }
#pragma unroll 4
    for (int mm = 0; mm < 128; ++mm) g = fmaf(sigmoidf_(xs[1664 + mm]), a.in[16][mm * 512 + c], g);
    const float sp = (-wl > 20.f) ? -wl : log1pf(__expf(-wl));
    const float w = -sp - 0.5f; o.decay = __expf(-__expf(w)); o.a = sigmoidf_(al); o.g = g;
    const float kkr = o.k * a.in[17][c];
    red[c] = kkr * kkr; __syncthreads();
    float ss = 0.f;
#pragma unroll 8
    for (int j = 0; j < 64; ++j) ss += red[(c & ~63) + j];
    __syncthreads();
    o.kk = kkr / fmaxf(sqrtf(ss), 1e-12f);
    o.kh = o.k * (1.0f + (o.a - 1.0f) * a.in[18][c]); o.b = o.kk * o.a;
    red[c] = o.r * o.kh * a.in[19][c]; __syncthreads();
    float bs = 0.f;
#pragma unroll 8
    for (int j = 0; j < 64; ++j) bs += red[(c & ~63) + j];
    __syncthreads();
    o.bonus = bs * o.v;
    return o;
}
constexpr size_t WS_NR = 124 * MiB, WS_NKH = 141 * MiB, WS_NV = 158 * MiB, WS_NKK = 175 * MiB, WS_NB = 192 * MiB, WS_NDEC = 33 * MiB;
__device__ __forceinline__ void nv_rw_prep_phase(Frame& F, const Args& a) {
    LAS float* xs = (LAS float*)F.lds; LAS float* red = xs + RWC; unsigned char* ws = a.ws; const int c = F.tid;
    for (int m = blockIdx.x; m < MT_ROWS; m += F.G) {
        const RwTok o = rw_token_prep(a, m, c, xs, red); const size_t i = (size_t)m * 512 + c;
        ((bf16*)(ws + WS_NR))[i] = (bf16)f2bf(o.r); ((bf16*)(ws + WS_NKH))[i] = (bf16)f2bf(o.kh); ((bf16*)(ws + WS_NV))[i] = (bf16)f2bf(o.v);
        ((bf16*)(ws + WS_NKK))[i] = (bf16)f2bf(o.kk); ((bf16*)(ws + WS_NB))[i] = (bf16)f2bf(o.b); ((float*)(ws + WS_NDEC))[i] = o.decay;
    }
}
__device__ __forceinline__ void nv_rw_scan_phase(Frame& F, const Args& a) {
    const int chain = (int)blockIdx.x + 256 * F.wave;
    if (F.wave < 2 && chain < 320) {
    LAS float* vec = (LAS float*)F.lds + F.wave * 320;
    unsigned char* ws = a.ws; const int i = F.lane;
    const bool smp = chain >= 64; const int b = smp ? (chain - 64) >> 3 : chain >> 3, h = chain & 7; const int T = smp ? DSEQ : SEQ; const size_t m0 = smp ? MP + (size_t)b * DSEQ : (size_t)b * SEQ;
    float S[64];
    { const float* s0 = a.in[5] + (((unsigned)(smp ? b : 0) * 8 + h) * 64 + i) * 64; const float msk = smp ? 1.f : 0.f;
#pragma unroll
      for (int j = 0; j < 64; j += 4) { const f32x4 x = *(const GAS f32x4*)(s0 + j); S[j] = x.x * msk; S[j + 1] = x.y * msk; S[j + 2] = x.z * msk; S[j + 3] = x.w * msk; } }
    const bf16* pKK = (const bf16*)(ws + WS_NKK); const bf16* pB = (const bf16*)(ws + WS_NB); const bf16* pKH = (const bf16*)(ws + WS_NKH); const bf16* pR = (const bf16*)(ws + WS_NR); const bf16* pV = (const bf16*)(ws + WS_NV);
    const float* pD = (const float*)(ws + WS_NDEC); bf16* pY = (bf16*)(ws + WS_RW);
#pragma unroll 1
    for (int t = 0; t < T; ++t) {
        const unsigned idx = ((unsigned)m0 + (unsigned)t) * 512u + (unsigned)(h * 64 + i);
        vec[0 * 64 + i] = bf2f(pKK[idx]); vec[1 * 64 + i] = pD[idx]; vec[2 * 64 + i] = bf2f(pB[idx]);
        vec[3 * 64 + i] = bf2f(pKH[idx]); vec[4 * 64 + i] = bf2f(pR[idx]);
        const float v = bf2f(pV[idx]);
        LDS_WAIT(); __builtin_amdgcn_wave_barrier();
        float sa = 0.f;
#pragma unroll
        for (int j = 0; j < 64; ++j) { sa = fmaf(S[j], vec[j], sa); if ((j & 7) == 7) __builtin_amdgcn_sched_barrier(0); }
        float y = 0.f;
#pragma unroll
        for (int j = 0; j < 64; ++j) { S[j] = S[j] * vec[64 + j] - sa * vec[128 + j] + v * vec[192 + j]; y = fmaf(S[j], vec[256 + j], y); if ((j & 3) == 3) __builtin_amdgcn_sched_barrier(0); }
        pY[idx] = (bf16)f2bf(y);
        LDS_WAIT(); __builtin_amdgcn_wave_barrier();
    }
    float* o = a.out + (smp ? O_WKVS : O_WKVP) + (((unsigned)b * 8 + h) * 64 + i) * 64;
#pragma unroll
    for (int j = 0; j < 64; j += 4) *(GAS f32x4*)(o + j) = (f32x4){S[j], S[j + 1], S[j + 2], S[j + 3]};
    }
}
__device__ __forceinline__ void nv_rw_post_phase(Frame& F, const Args& a) {
    LAS float* xs = (LAS float*)F.lds; LAS float* red = xs + RWC; const int c = F.tid;
    for (int m = blockIdx.x; m < MT_ROWS; m += F.G) {
        const RwTok o = rw_token_prep(a, m, c, xs, red);
        const float y = bf2f(((const bf16*)(a.ws + WS_RW))[(size_t)m * 512 + c]);
        red[c] = y; __syncthreads();
        float s = 0.f;
#pragma unroll 8
        for (int j = 0; j < 64; ++j) s += red[(c & ~63) + j];
        __syncthreads();
        const float mean = s * (1.f / 64.f), dv = y - mean;
        red[c] = dv * dv; __syncthreads();
        float q = 0.f;
#pragma unroll 8
        for (int j = 0; j < 64; ++j) q += red[(c & ~63) + j];
        const float yn = dv * (1.0f / sqrtf(q * (1.f / 64.f) + 64e-5f)) * a.in[20][c] + a.in[21][c];
        ((bf16*)(a.ws + WS_RW))[(size_t)m * 512 + c] = (bf16)f2bf((yn + o.bonus) * o.g);
    }
}
#define PHASE2 { nv_attn_phase(F, args); }
#define PHASE3 { nv_rw_prep_phase(F, args); }
#define PHASE4 { nv_rw_scan_phase(F, args); }
#define PHASE5 { nv_rw_post_phase(F, args); }
#define HOST_SEQUENCE RUN_PHASES(0, N_PHASES);

constexpr int N_PHASES = 12;
__global__ void __launch_bounds__(NTHREADS, 2) fwd_kernel(Args args) {
    extern __shared__ __attribute__((aligned(16))) unsigned char lds[];
    Frame F;
    F.lds = (LAS unsigned char*)lds;
    F.tid = threadIdx.x; F.lane = F.tid & 63; F.wave = __builtin_amdgcn_readfirstlane(F.tid >> 6);
    F.G = gridDim.x; { const int bx = blockIdx.x; F.vcu = (F.G % 8 == 0) ? (bx % 8) * (F.G / 8) + bx / 8 : bx; }
    unsigned char* ws = args.ws;
    const int lo = args.ph_lo, hi = args.ph_hi;
    volatile LAS unsigned* MISC = (volatile LAS unsigned*)(F.lds + MISC_OFF);
    if (F.tid < 64) MISC[F.tid] = 0u;
    __syncthreads();
    XcdBarrier bar = xcd_barrier_post((unsigned*)(ws + WS_CTL) + CW_BAR, MISC + 8);
#define SEAM(k) do { if (IN(k) && IN((k) + 1)) xcd_barrier(bar); } while (0)
#define IN(k) (lo <= (k) && (k) < hi)
    bf16* sga_p = (bf16*)args.out; bf16* sgb_p = sga_p + (size_t)MP * DM;

    if (IN(0)) { p0_prologue(F, args); } SEAM(0);
    if (IN(1)) {
        pg8::Gemm g{(const bf16*)(ws + WS_H), (const bf16*)(ws + WS_WT_IN), MT_ROWS, NPAD, DM}; pg8::StaticOrder S; S.init(MT_ROWS, NPAD, F.G, (int)blockIdx.x);
        EpiInProj E{ws, args.out, sga_p, sgb_p};
        pg8::gemm_phase<EpiInProj, pg8::StaticOrder, true, true>(F.lds, g, S, E);
    } SEAM(1);
    if (IN(2)) { PHASE2 } SEAM(2);
    if (IN(3)) { PHASE3 } SEAM(3);
    if (IN(4)) { PHASE4 } SEAM(4);
    if (IN(5)) { PHASE5 } SEAM(5);
    if (IN(6)) { PHASE6 } SEAM(6);
    if (IN(7)) { PHASE7 } SEAM(7);
    if (IN(8)) { PHASE8 } SEAM(8);
    if (IN(9)) { PHASE9 } SEAM(9);
    if (IN(10)) { PHASE10 } SEAM(10);
    if (IN(11)) { PHASE11 }
#undef IN
}

extern "C" void kernel_launch(void* const* d_in, const int* in_sizes, int n_in, void* d_out, int out_size, void* d_ws, size_t ws_size, hipStream_t stream) {
    static int grid = 0;
    if (grid == 0) {
        if (n_in != 28 || out_size != (int)O_END || ws_size < WS_END) { fprintf(stderr, "kernel_launch: unexpected shapes: n_in %d out %d ws %zu\n", n_in, out_size, ws_size); grid = -1; return; }
        int dev = 0, cus = 0;
        if (hipGetDevice(&dev) != hipSuccess || hipDeviceGetAttribute(&cus, hipDeviceAttributeMultiprocessorCount, dev) != hipSuccess) { grid = -1; return; }
        if (hipFuncSetAttribute((const void*)fwd_kernel, hipFuncAttributeMaxDynamicSharedMemorySize, LDS_BYTES) != hipSuccess) { fprintf(stderr, "kernel_launch: hipFuncSetAttribute failed\n"); grid = -1; return; }
        int per_cu = 0;
        if (hipOccupancyMaxActiveBlocksPerMultiprocessor(&per_cu, (const void*)fwd_kernel, NTHREADS, LDS_BYTES) != hipSuccess || per_cu < 1) fprintf(stderr, "kernel_launch: occupancy query says %d\n", per_cu);
        (void)hipGetLastError();
        grid = cus;
    }
    if (grid < 0) return;
    (void)hipMemsetAsync((char*)d_ws + WS_CTL, 0, CTL_ZERO_BYTES, stream);
    Args a{};
    for (int i = 0; i < 28; ++i) a.in[i] = (const float*)d_in[i];
    a.out = (float*)d_out; a.ws = (unsigned char*)d_ws;
#define RUN_PHASES(lo_, hi_) do { a.ph_lo = (lo_); a.ph_hi = (hi_); hipLaunchKernelGGL(fwd_kernel, dim3(grid), dim3(NTHREADS), LDS_BYTES, stream, a); } while (0)
    HOST_SEQUENCE
#undef RUN_PHASES
}
```

```cpp
#include <hip/hip_runtime.h>
#include <cstdio>
#include <cstdint>
namespace pg8 {
#define PG8_LAS __attribute__((address_space(3)))
typedef unsigned short bf16_t;
typedef short bf16x8 __attribute__((ext_vector_type(8)));
typedef float f32x4 __attribute__((ext_vector_type(4)));
typedef unsigned u32x4 __attribute__((ext_vector_type(4)));
typedef unsigned u32x2 __attribute__((ext_vector_type(2)));
constexpr int BM = 256, BK = 64, HALF = 128, HTB = HALF * BK * 2  , STAGE_BYTES = 8 * HTB, NXCD = 8, WGM = 8;

__host__ __device__ __forceinline__ int lds_byte(int r, int c) { const int st = (r >> 4) * 2 + (c >> 5), rr = r & 15, cc = c & 31, ob = rr * 64 + cc * 2; return st * 1024 + (ob ^ (((ob >> 9) & 1) << 5)); }
__host__ __device__ __forceinline__ void stage_rc(int b, int& R, int& C) { const int st = b / 1024, sb = b % 1024, swz = sb ^ (((sb >> 9) & 1) << 5); R = (st >> 1) * 16 + swz / 64; C = (st & 1) * 32 + (swz % 64) / 2; }
__host__ __device__ __forceinline__ int perm32(int rho) { const int n = rho >> 4, i = rho & 15; return 8 * (i >> 2) + 4 * n + (i & 3); }

struct Unit { int pm, pn; };
struct Gemm { const bf16_t* A; const bf16_t* Bt; int M, N, K; };

struct StaticOrder {
    int nM, nN, nwg, G, c;
    __host__ __device__ void init(int M, int N, int G_, int c_) { nM = M / BM; nN = N / BM; nwg = nM * nN; G = G_; c = c_; }
    __host__ __device__ bool next(int i, Unit& u) const {
        const long L = (long)i * G + c; if (L >= nwg) return false;
        int wgid = (int)L; { const int q = nwg / NXCD, r = nwg % NXCD, xcd = wgid % NXCD, off = wgid / NXCD; wgid = (xcd < r ? xcd * (q + 1) : r * (q + 1) + (xcd - r) * q) + off; }
        const int nig = WGM * nN, gid = wgid / nig, fm = gid * WGM, gsz = (nM - fm) < WGM ? (nM - fm) : WGM;
        u.pm = fm + ((wgid % nig) % gsz); u.pn = (wgid % nig) / gsz; return true;
    }
    __device__ __forceinline__ void a_ready(const Unit&) const {}
    __device__ __forceinline__ void done(const Unit&) const {}
};
__device__ __forceinline__ unsigned cvt_pk_bf16(float lo, float hi) { unsigned r; asm volatile("v_cvt_pk_bf16_f32 %0, %1, %2" : "=v"(r) : "v"(lo), "v"(hi)); return r; }

template <class Epi, class Sched, bool ALIGN_EPI = false, bool SP2 = false>
__device__ __forceinline__ void gemm_phase(PG8_LAS unsigned char* lds, const Gemm g, const Sched& S, const Epi& E) {
    const int tid = threadIdx.x, wid = __builtin_amdgcn_readfirstlane(tid >> 6), lane = tid & 63, wr = wid >> 2, wc = wid & 3, fr = lane & 15, fq = lane >> 4;
    const int K = g.K, nt = K / BK;
    unsigned voffA[2], voffB[2];
#pragma unroll
    for (int i = 0; i < 2; ++i) { int R, C; stage_rc(tid * 16 + i * 8192, R, C); const int Rb = Epi::PERM ? ((R & ~31) + perm32(R & 31)) : R;
        voffA[i] = (unsigned)(R * K + C) * 2u; voffB[i] = (unsigned)(Rb * K + C) * 2u; }
    const size_t kstep = (size_t)(BK * 2);
    const size_t hstep = (size_t)HALF * K * 2;
    const size_t tstep = 2 * hstep;
    const unsigned ldsw = (unsigned)wid * 1024u;
    const int aoff = lds_byte(wr * 64 + fr, fq * 8), boff = lds_byte(wc * 32 + fr, fq * 8);
#define PG8_SA(b, h) (((b) * 2 + (h)) * HTB)
#define PG8_SB(b, h) ((4 + (b) * 2 + (h)) * HTB)
#define PG8_STAGE(bufoff, gbase, voff) do { _Pragma("unroll") for (int _i = 0; _i < 2; ++_i) \
        __builtin_amdgcn_global_load_lds((const unsigned*)((const char*)(gbase) + (voff)[_i]), (PG8_LAS unsigned*)(lds + (bufoff) + ldsw + _i * 8192), 16, 0, 0); } while (0)
#define PG8_LDA(dst, b, h) do { _Pragma("unroll") for (int m = 0; m < 4; ++m) _Pragma("unroll") for (int k = 0; k < 2; ++k) dst[m][k] = *(const PG8_LAS bf16x8*)(lds + PG8_SA(b, h) + aoff + m * 2048 + k * 1024); } while (0)
#define PG8_LDB(dst, b, h) do { _Pragma("unroll") for (int n = 0; n < 2; ++n) _Pragma("unroll") for (int k = 0; k < 2; ++k) dst[n][k] = *(const PG8_LAS bf16x8*)(lds + PG8_SB(b, h) + boff + n * 2048 + k * 1024); } while (0)
#define PG8_MMA(ai, bj, At, Bt) do { __builtin_amdgcn_s_setprio(1); _Pragma("unroll") for (int m = 0; m < 4; ++m) _Pragma("unroll") for (int n = 0; n < 2; ++n) _Pragma("unroll") for (int k = 0; k < 2; ++k) \
        acc[ai][bj][m][n] = __builtin_amdgcn_mfma_f32_16x16x32_bf16(Bt[n][k], At[m][k], acc[ai][bj][m][n], 0, 0, 0); __builtin_amdgcn_s_setprio(0); } while (0)
#define PG8_WAIT_V(n) asm volatile("s_waitcnt vmcnt(" #n ")" ::: "memory")
#define PG8_WAIT_L(n) asm volatile("s_waitcnt lgkmcnt(" #n ")" ::: "memory")
#define PG8_BAR __builtin_amdgcn_s_barrier()
#define PG8_SCHED __builtin_amdgcn_sched_barrier(0)
    Unit cur, nxt; int ui = 0;
    if (!S.next(0, cur)) return;
    f32x4 acc[2][2][4][2];
#pragma unroll
    for (int a = 0; a < 2; ++a)
#pragma unroll
        for (int b = 0; b < 2; ++b)
#pragma unroll
            for (int m = 0; m < 4; ++m)
#pragma unroll
                for (int n = 0; n < 2; ++n) acc[a][b][m][n] = (f32x4){0.f, 0.f, 0.f, 0.f};
    bf16x8 At[4][2], B0[2][2], B1[2][2];
    const char* cA = (const char*)g.A + (size_t)cur.pm * tstep; const char* cB = (const char*)g.Bt + (size_t)cur.pn * tstep;
    S.a_ready(cur);
    if constexpr (SP2) {
        PG8_STAGE(PG8_SB(0, 0), cB, voffB); PG8_STAGE(PG8_SB(0, 1), cB + hstep, voffB); PG8_STAGE(PG8_SA(0, 0), cA, voffA); PG8_STAGE(PG8_SA(0, 1), cA + hstep, voffA);
        if (wr == 1) PG8_BAR;
        PG8_WAIT_V(2); PG8_BAR;
        PG8_STAGE(PG8_SB(1, 0), cB + kstep, voffB); PG8_STAGE(PG8_SA(1, 0), cA + kstep, voffA); PG8_STAGE(PG8_SB(1, 1), cB + hstep + kstep, voffB);
        PG8_WAIT_V(6); PG8_BAR;
    } else {
        PG8_STAGE(PG8_SB(0, 0), cB, voffB); PG8_STAGE(PG8_SA(0, 0), cA, voffA); PG8_STAGE(PG8_SB(0, 1), cB + hstep, voffB); PG8_STAGE(PG8_SA(0, 1), cA + hstep, voffA);
        if (wr == 1) PG8_BAR;
        PG8_WAIT_V(4); PG8_BAR;
        PG8_STAGE(PG8_SB(1, 0), cB + kstep, voffB); PG8_STAGE(PG8_SA(1, 0), cA + kstep, voffA); PG8_STAGE(PG8_SB(1, 1), cB + hstep + kstep, voffB);
        PG8_WAIT_V(6); PG8_BAR;
    }
    for (;;) {
        const bool has_next = S.next(ui + 1, nxt);
        const char* nA = has_next ? (const char*)g.A + (size_t)nxt.pm * tstep : cA; const char* nB = has_next ? (const char*)g.Bt + (size_t)nxt.pn * tstep : cB;
        for (int t = 0; t < nt; t += 2) {
            const bool last = (t == nt - 2);
            const char* a1 = cA + (size_t)(t + 1) * kstep;
            const char* a2 = last ? nA : cA + (size_t)(t + 2) * kstep; const char* b2 = last ? nB : cB + (size_t)(t + 2) * kstep;
            const char* a3 = a2 + kstep; const char* b3 = b2 + kstep;
            if (last && has_next) S.a_ready(nxt);
            if constexpr (SP2) {
            PG8_LDB(B0, 0, 0); PG8_LDB(B1, 0, 1); PG8_SCHED; PG8_LDA(At, 0, 0); PG8_STAGE(PG8_SA(1, 1), a1 + hstep, voffA);
            PG8_WAIT_V(8); PG8_WAIT_L(0); PG8_BAR; PG8_MMA(0, 0, At, B0); PG8_MMA(0, 1, At, B1); PG8_BAR; PG8_SCHED;
            PG8_LDA(At, 0, 1); PG8_STAGE(PG8_SB(0, 0), b2, voffB); PG8_STAGE(PG8_SB(0, 1), b2 + hstep, voffB); PG8_STAGE(PG8_SA(0, 0), a2, voffA);
            PG8_WAIT_V(8); PG8_WAIT_L(0); PG8_BAR; PG8_MMA(1, 0, At, B0); PG8_MMA(1, 1, At, B1); PG8_BAR; PG8_SCHED;
            PG8_LDB(B0, 1, 0); PG8_LDB(B1, 1, 1); PG8_SCHED; PG8_LDA(At, 1, 0); PG8_STAGE(PG8_SA(0, 1), a2 + hstep, voffA);
            PG8_WAIT_V(8); PG8_WAIT_L(0); PG8_BAR; PG8_MMA(0, 0, At, B0); PG8_MMA(0, 1, At, B1); PG8_BAR; PG8_SCHED;
            PG8_LDA(At, 1, 1); PG8_STAGE(PG8_SB(1, 0), b3, voffB); PG8_STAGE(PG8_SB(1, 1), b3 + hstep, voffB); PG8_STAGE(PG8_SA(1, 0), a3, voffA);
            PG8_WAIT_V(8); PG8_WAIT_L(0); PG8_BAR; PG8_MMA(1, 0, At, B0); PG8_MMA(1, 1, At, B1); PG8_BAR; PG8_SCHED;
            } else {
            PG8_LDB(B0, 0, 0); PG8_SCHED; PG8_LDA(At, 0, 0); PG8_STAGE(PG8_SA(1, 1), a1 + hstep, voffA);
            PG8_WAIT_L(8); PG8_BAR; PG8_WAIT_L(0); PG8_MMA(0, 0, At, B0); PG8_BAR; PG8_SCHED;
            PG8_LDB(B1, 0, 1); PG8_STAGE(PG8_SB(0, 0), b2, voffB);
            PG8_BAR; PG8_WAIT_L(0); PG8_MMA(0, 1, At, B1); PG8_BAR;
            PG8_LDA(At, 0, 1); PG8_STAGE(PG8_SA(0, 0), a2, voffA);
            PG8_BAR; PG8_WAIT_L(0); PG8_MMA(1, 0, At, B0); PG8_BAR; PG8_SCHED;
            PG8_STAGE(PG8_SB(0, 1), b2 + hstep, voffB);
            PG8_WAIT_V(6); PG8_BAR; PG8_MMA(1, 1, At, B1); PG8_BAR;
            PG8_LDB(B0, 1, 0); PG8_SCHED; PG8_LDA(At, 1, 0); PG8_STAGE(PG8_SA(0, 1), a2 + hstep, voffA);
            PG8_WAIT_L(8); PG8_BAR; PG8_WAIT_L(0); PG8_MMA(0, 0, At, B0); PG8_BAR; PG8_SCHED;
            PG8_LDB(B1, 1, 1); PG8_STAGE(PG8_SB(1, 0), b3, voffB);
            PG8_BAR; PG8_WAIT_L(0); PG8_MMA(0, 1, At, B1); PG8_BAR;
            PG8_LDA(At, 1, 1); PG8_STAGE(PG8_SA(1, 0), a3, voffA);
            PG8_BAR; PG8_WAIT_L(0); PG8_MMA(1, 0, At, B0); PG8_BAR; PG8_SCHED;
            PG8_STAGE(PG8_SB(1, 1), b3 + hstep, voffB);
            PG8_WAIT_V(6); PG8_BAR; PG8_MMA(1, 1, At, B1); PG8_BAR;
            }
        }
        if constexpr (ALIGN_EPI) { if (wr == 0) PG8_BAR; }
        if constexpr (!Epi::AFTER_DRAIN) { E(acc, cur, wr, wc, fr, fq); S.done(cur); }
        if (!has_next) break;
#pragma unroll
        for (int a = 0; a < 2; ++a)
#pragma unroll
            for (int b = 0; b < 2; ++b)
#pragma unroll
                for (int m = 0; m < 4; ++m)
#pragma unroll
                    for (int n = 0; n < 2; ++n) acc[a][b][m][n] = (f32x4){0.f, 0.f, 0.f, 0.f};
        cur = nxt; cA = nA; cB = nB; ++ui;
        if constexpr (ALIGN_EPI) { if (wr == 1) PG8_BAR; }
    }
    PG8_WAIT_V(0);
    if constexpr (!ALIGN_EPI) { if (wr == 0) PG8_BAR; }
    PG8_BAR;
    if constexpr (Epi::AFTER_DRAIN) { E.fused(acc, cur, wr, wc, fr, fq, lds, wid, lane); S.done(cur); }
#undef PG8_SA
#undef PG8_SB
#undef PG8_STAGE
#undef PG8_LDA
#undef PG8_LDB
#undef PG8_MMA
#undef PG8_WAIT_V
#undef PG8_WAIT_L
#undef PG8_BAR
#undef PG8_SCHED
}
}

constexpr int DM = 1024, MP = 16384, MS = 512, MT_ROWS = MP + MS;
constexpr int SEQ = 2048, PAST = 2048, DSEQ = 16, NB_P = 8, NB_S = 32, LS = PAST + DSEQ, LSP = 2112;
constexpr int NPAD = 5376, RWC = 1792, DFF = 4096;
constexpr int C_Q = 0, C_K = 512, C_V = 640, C_QI = 768, C_KI = 1280, C_WI = 1344, C_P = 1536, C_GA = 3328, C_GB = 4352;
constexpr size_t O_YP = 0, O_YS = 16777216, O_NKP = 17301504, O_NVP = 19398656, O_NKIP = 21495808, O_WKVP = 22544384, O_SHP = 22806528,
                 O_NKS = 22820864, O_NVS = 22886400, O_NKIS = 22951936, O_WKVS = 22984704, O_SHS = 24033280, O_END = 24090624;
constexpr float QSCALE = 0.125f * 1.4426950408889634f;
constexpr float NORM_EPS = 1e-6f;
constexpr size_t MiB = 1u << 20;
constexpr size_t WS_CTL = 0, CTL_ZERO_BYTES = 1 * MiB;
constexpr size_t WS_WT_IN = 1 * MiB, WS_WT_AB = 12 * MiB, WS_WT_OUT = 14 * MiB, WS_WT_FF1 = 16 * MiB, WS_WT_FF2 = 24 * MiB;
constexpr size_t WS_WT_D = 32 * MiB, WS_WT_A = WS_WT_D + 65536, WS_WT_G = WS_WT_A + 65536;
constexpr size_t WS_H = 33 * MiB;
constexpr size_t WS_P = 66 * MiB;
constexpr size_t WS_QB = 124 * MiB, WS_QIB = 141 * MiB, WS_KBP = 158 * MiB, WS_VBP = 162 * MiB, WS_KIBP = 166 * MiB;
constexpr size_t WS_KS = 168 * MiB, WS_VS = 185 * MiB, WS_KIS = 202 * MiB, WS_WI = 211 * MiB, WS_SGS = 212 * MiB;
constexpr size_t WS_ATT = 214 * MiB, WS_RW = 231 * MiB;
constexpr size_t WS_X1S = 247 * MiB;
constexpr size_t WS_MT = 33 * MiB, WS_NT = 124 * MiB, WS_WY = 142 * MiB, WS_YL = 160 * MiB, WS_G1 = 178 * MiB, WS_E = 195 * MiB, WS_SSN = 66 * MiB;
constexpr size_t WS_MIX = 33 * MiB, WS_H2 = 66 * MiB, WS_HFF = 99 * MiB;
constexpr size_t WS_END = 256 * MiB;
static_assert(WS_HFF + (size_t)MT_ROWS * DFF * 2 <= WS_X1S, "ws map");
constexpr int CW_QUEUE = 64;
constexpr int CW_BAR = 4096;

constexpr int NWAVES = 8, NTHREADS = 512;
constexpr int LDS_BYTES = 163840;
constexpr int MISC_OFF = LDS_BYTES - 1024;

#define GAS __attribute__((address_space(1)))
#define LAS __attribute__((address_space(3)))
typedef unsigned short bf16;
typedef unsigned v4u __attribute__((ext_vector_type(4)));
typedef unsigned v2u __attribute__((ext_vector_type(2)));
typedef float f32x4 __attribute__((ext_vector_type(4)));
typedef float f32x16 __attribute__((ext_vector_type(16)));
typedef short bf16x8 __attribute__((ext_vector_type(8)));
typedef short s16x4 __attribute__((ext_vector_type(4)));
#define LDS_WAIT() asm volatile("s_waitcnt lgkmcnt(0)" ::: "memory")
#define VM_WAIT() asm volatile("s_waitcnt vmcnt(0)" ::: "memory")
__device__ __forceinline__ unsigned f2bf(float f) { unsigned u = __builtin_bit_cast(unsigned, f); return (u + 0x7fffu + ((u >> 16) & 1u)) >> 16; }
__device__ __forceinline__ unsigned pk2(float lo, float hi) { return f2bf(lo) | (f2bf(hi) << 16); }
__device__ __forceinline__ float bf2f(unsigned short h) { return __builtin_bit_cast(float, (unsigned)h << 16); }
__device__ __forceinline__ float bflo(unsigned w) { return __builtin_bit_cast(float, w << 16); }
__device__ __forceinline__ float bfhi(unsigned w) { return __builtin_bit_cast(float, w & 0xffff0000u); }
__device__ __forceinline__ float wave_sum(float v) {
#pragma unroll
    for (int o = 1; o < 64; o <<= 1) v += __shfl_xor(v, o);
    return v;
}
__device__ __forceinline__ float sigmoidf_(float x) { return 1.0f / (1.0f + __expf(-x)); }

struct Args {
    const float* in[28];
    float* out; unsigned char* ws;
    int ph_lo, ph_hi;
};
struct Frame {
    LAS unsigned char* lds;
    int tid, lane, wave, vcu, G;
};

__device__ __forceinline__ void p0_transpose_item(const float* W, int ldw, int src_col0, bf16* WT, int dst_ld, int dst_row0, int dst_k0, int nblk, LAS float* scr, int item, int lane) {
    const int kb = item / nblk, nb = item % nblk, k0 = 64 * kb, n0 = 32 * nb;
#pragma unroll 8
    for (int i = 0; i < 32; ++i) { const int kk = 2 * i + (lane >> 5); scr[kk * 33 + (lane & 31)] = W[(size_t)(k0 + kk) * ldw + src_col0 + n0 + (lane & 31)]; }
    LDS_WAIT(); asm volatile("" ::: "memory");
    const int c = lane & 7;
#pragma unroll
    for (int j = 0; j < 4; ++j) { const int n = (lane >> 3) + 8 * j; const LAS float* s = scr + (8 * c) * 33 + n;
        v4u o; o.x = pk2(s[0 * 33], s[1 * 33]); o.y = pk2(s[2 * 33], s[3 * 33]); o.z = pk2(s[4 * 33], s[5 * 33]); o.w = pk2(s[6 * 33], s[7 * 33]);
        *(GAS v4u*)(WT + (size_t)(dst_row0 + n0 + n) * dst_ld + dst_k0 + k0 + 8 * c) = o; }
    LDS_WAIT(); asm volatile("" ::: "memory");
}
__device__ __forceinline__ void rms_row_to_bf16(int lane, const float* xrow, const float* g, bf16* orow) {
    const GAS f32x4* xr = (const GAS f32x4*)xrow + lane; const GAS f32x4* gr = (const GAS f32x4*)g + lane;
    f32x4 v[4]; float s = 0.f;
#pragma unroll
    for (int j = 0; j < 4; ++j) { v[j] = xr[64 * j]; s += (v[j].x * v[j].x + v[j].y * v[j].y) + (v[j].z * v[j].z + v[j].w * v[j].w); }
    const float rstd = 1.0f / sqrtf(wave_sum(s) * (1.f / DM) + NORM_EPS);
    GAS v2u* o8 = (GAS v2u*)orow + lane;
#pragma unroll
    for (int j = 0; j < 4; ++j) { const f32x4 gg = gr[64 * j]; v2u o; o.x = pk2(v[j].x * rstd * gg.x, v[j].y * rstd * gg.y); o.y = pk2(v[j].z * rstd * gg.z, v[j].w * rstd * gg.w); o8[64 * j] = o; }
}
__device__ __forceinline__ void p0_prologue(Frame& F, const Args& a) {
    unsigned char* ws = a.ws;
    LAS float* scr = (LAS float*)(F.lds + F.wave * 16384);
    const int gw = F.vcu * NWAVES + F.wave, NGW = F.G * NWAVES;
    int base = 0;
#define TRJ(in_idx, ldw, sc0, ncols, K, dst, dld, dr0, dk0) { const int nblk = (ncols) / 32, nit = ((K) / 64) * nblk; int first = (gw - base) % NGW; if (first < 0) first += NGW; \
        for (int it = first; it < nit; it += NGW) p0_transpose_item(a.in[in_idx], ldw, sc0, (bf16*)(ws + (dst)), dld, dr0, dk0, nblk, scr, it, F.lane); base += nit; }
    TRJ(9, 5192, 0, 512, 1024, WS_WT_IN, 1024, C_Q, 0) TRJ(9, 5192, 512, 128, 1024, WS_WT_IN, 1024, C_K, 0) TRJ(9, 5192, 640, 128, 1024, WS_WT_IN, 1024, C_V, 0)
    TRJ(9, 5192, 768, 512, 1024, WS_WT_IN, 1024, C_QI, 0) TRJ(9, 5192, 1280, 64, 1024, WS_WT_IN, 1024, C_KI, 0) TRJ(9, 5192, 1352, 1792, 1024, WS_WT_IN, 1024, C_P, 0)
    TRJ(9, 5192, 3144, 1024, 1024, WS_WT_IN, 1024, C_GA, 0) TRJ(9, 5192, 4168, 1024, 1024, WS_WT_IN, 1024, C_GB, 0)
    TRJ(10, 1024, 0, 1024, 512, WS_WT_AB, 512, 0, 0) TRJ(22, 1024, 0, 1024, 512, WS_WT_AB + MiB, 512, 0, 0)
    TRJ(23, 1024, 0, 1024, 1024, WS_WT_OUT, 1024, 0, 0) TRJ(25, 4096, 0, 4096, 1024, WS_WT_FF1, 1024, 0, 0) TRJ(26, 1024, 0, 1024, 4096, WS_WT_FF2, 4096, 0, 0)
    TRJ(13, 512, 0, 512, 64, WS_WT_D, 64, 0, 0) TRJ(15, 512, 0, 512, 64, WS_WT_A, 64, 0, 0) TRJ(16, 512, 0, 512, 128, WS_WT_G, 128, 0, 0)
#undef TRJ
    if (gw == NGW - 1) {
        const float* W = a.in[9]; bf16* WT = (bf16*)(ws + WS_WT_IN);
        for (int e = F.lane; e < 8 * 1024; e += 64) { const int n = e >> 10, k = e & 1023; WT[(size_t)(C_WI + n) * 1024 + k] = (bf16)f2bf(W[(size_t)k * 5192 + 1344 + n]); }
    }
    bf16* H = (bf16*)(ws + WS_H);
    for (int m = gw; m < MT_ROWS; m += NGW) { const float* xr = (m < MP) ? a.in[0] + (size_t)m * DM : a.in[1] + (size_t)(m - MP) * DM; rms_row_to_bf16(F.lane, xr, a.in[8], H + (size_t)m * DM); }
    const int gt = F.vcu * NTHREADS + F.tid, NGT = F.G * NTHREADS;
    {
        const int nit = NB_S * PAST * 128 / 8;
        for (int it = gt; it < 2 * nit; it += NGT) { const int which = it >= nit, e = (which ? it - nit : it) * 8; const float* src = a.in[2 + which] + e;
            const int b = e / (PAST * 128), rem = e % (PAST * 128); bf16* dst = (bf16*)(ws + (which ? WS_VS : WS_KS)) + (size_t)b * LSP * 128 + rem;
            const f32x4 x0 = *(const GAS f32x4*)src, x1 = *(const GAS f32x4*)(src + 4); v4u o; o.x = pk2(x0.x, x0.y); o.y = pk2(x0.z, x0.w); o.z = pk2(x1.x, x1.y); o.w = pk2(x1.z, x1.w); *(GAS v4u*)dst = o; }
        const int nit2 = NB_S * PAST * 64 / 8;
        for (int it = gt; it < nit2; it += NGT) { const int e = it * 8; const float* src = a.in[4] + e; const int b = e / (PAST * 64), rem = e % (PAST * 64); bf16* dst = (bf16*)(ws + WS_KIS) + (size_t)b * LSP * 64 + rem;
            const f32x4 x0 = *(const GAS f32x4*)src, x1 = *(const GAS f32x4*)(src + 4); v4u o; o.x = pk2(x0.x, x0.y); o.y = pk2(x0.z, x0.w); o.z = pk2(x1.x, x1.y); o.w = pk2(x1.z, x1.w); *(GAS v4u*)dst = o; }
        const int npad = NB_S * (LSP - LS) * 128 / 8;
        for (int it = gt; it < 2 * npad; it += NGT) { const int which = it >= npad, e = (which ? it - npad : it) * 8; const int b = e / ((LSP - LS) * 128), rem = e % ((LSP - LS) * 128);
            *(GAS v4u*)((bf16*)(ws + (which ? WS_VS : WS_KS)) + ((size_t)b * LSP + LS) * 128 + rem) = (v4u){0u, 0u, 0u, 0u}; }
        const int npad2 = NB_S * (LSP - LS) * 64 / 8;
        for (int it = gt; it < npad2; it += NGT) { const int e = it * 8; const int b = e / ((LSP - LS) * 64), rem = e % ((LSP - LS) * 64);
            *(GAS v4u*)((bf16*)(ws + WS_KIS) + ((size_t)b * LSP + LS) * 64 + rem) = (v4u){0u, 0u, 0u, 0u}; }
    }
}
typedef GAS unsigned gu32;
typedef GAS unsigned long long gu64;
#define RLX_AGENT __ATOMIC_RELAXED, __HIP_MEMORY_SCOPE_AGENT
__device__ __forceinline__ unsigned long long rt() { return __builtin_amdgcn_s_memrealtime(); }
#define XB_TMO      128
#define XB_XCNT(j)  (256  + 64 * (j))
#define XB_XSUB(j)  (1280 + 64 * (j))
#define XB_XGEN(j)  (2304 + 64 * (j))
#define XB_TOP      3328
#define XB_TOPGEN   3392
#define XCD_BAR_WORDS 3456
#define XB_SPIN_CAP (1u << 18)

__device__ __forceinline__ unsigned xb_ld(unsigned* p)              { return __hip_atomic_load(p, __ATOMIC_RELAXED, __HIP_MEMORY_SCOPE_AGENT); }
__device__ __forceinline__ unsigned xb_add(unsigned* p, unsigned v) { return __hip_atomic_fetch_add(p, v, __ATOMIC_RELAXED, __HIP_MEMORY_SCOPE_AGENT); }
__device__ __forceinline__ unsigned xb_xcc_id() { return (unsigned)__builtin_amdgcn_s_getreg((3 << 11) | 20) & 0xFu; }
#define XB_SPIN(cond, bar) do { unsigned _sp = 0; while (cond) { __builtin_amdgcn_s_sleep(1); \
    if ((++_sp & 255u) == 0u) { if (xb_ld(&(bar)[XB_TMO])) break; if (_sp > XB_SPIN_CAP) { atomicAdd(&(bar)[XB_TMO], 1u); break; } } } } while (0)

struct XcdBarrier {
    unsigned* bar; unsigned x;
    volatile LAS unsigned* st;
};

__device__ __forceinline__ XcdBarrier xcd_barrier_post(unsigned* bar, volatile LAS unsigned* st) {
    XcdBarrier b; b.bar = bar; b.x = xb_xcc_id(); b.st = st;
    if (threadIdx.x == 0) (void)xb_add(&bar[XB_XCNT(b.x)], 1u);
    return b;
}
__device__ __forceinline__ void xcd_barrier_complete(unsigned* bar, unsigned x, unsigned& nloc, unsigned& nx) {
    const unsigned G = gridDim.x * gridDim.y * gridDim.z;
    unsigned sum, cnt, mine, sp = 0u;
    for (;;) {
        sum = 0u; cnt = 0u; mine = 0u;
#pragma unroll
        for (unsigned j = 0; j < 16; ++j) { const unsigned c = xb_ld(&bar[XB_XCNT(j)]); sum += c; cnt += (c > 0u) ? 1u : 0u; mine = (j == x) ? c : mine; }
        if (sum == G) break;
        __builtin_amdgcn_s_sleep(1);
        if ((++sp & 255u) == 0u) { if (xb_ld(&bar[XB_TMO])) break; if (sp > XB_SPIN_CAP) { atomicAdd(&bar[XB_TMO], 1u); break; } }
    }
    nloc = mine > 0u ? mine : 1u; nx = cnt > 0u ? cnt : 1u;
}

__device__ __forceinline__ void xcd_barrier(const XcdBarrier& b) {
    asm volatile("s_waitcnt vmcnt(0)" ::: "memory");
    __syncthreads();
    if (threadIdx.x == 0) {
        unsigned* bar = b.bar;
        __builtin_amdgcn_s_waitcnt(0);
        unsigned nloc = b.st[0], nx = b.st[1];
        if (nloc == 0u) { xcd_barrier_complete(bar, b.x, nloc, nx); b.st[0] = nloc; b.st[1] = nx; }
        const unsigned old = xb_add(&bar[XB_XSUB(b.x)], 1u);
        const unsigned gen = old / nloc;
        if (old + 1u == (gen + 1u) * nloc) {
            __builtin_amdgcn_fence(__ATOMIC_RELEASE, "agent");
            asm volatile("s_waitcnt vmcnt(0)" ::: "memory");
            const unsigned og = xb_add(&bar[XB_TOP], 1u);
            const unsigned tg = og / nx;
            if (og + 1u == (tg + 1u) * nx) xb_add(&bar[XB_TOPGEN], 1u);
            else XB_SPIN(xb_ld(&bar[XB_TOPGEN]) == tg, bar);
            __builtin_amdgcn_fence(__ATOMIC_ACQUIRE, "agent");
            xb_add(&bar[XB_XGEN(b.x)], 1u);
            asm volatile("s_waitcnt vmcnt(0)" ::: "memory");
        } else {
            XB_SPIN(xb_ld(&bar[XB_XGEN(b.x)]) == gen, bar);
            __builtin_amdgcn_fence(__ATOMIC_ACQUIRE, "agent");
            asm volatile("s_waitcnt vmcnt(0)" ::: "memory");
        }
    }
    __syncthreads();
}

struct EpiInProj {
    static constexpr bool PERM = true, AFTER_DRAIN = false;
    unsigned char* ws; float* out; bf16* sga_p; bf16* sgb_p;
    __device__ __forceinline__ void operator()(const f32x4 (&acc)[2][2][4][2], const pg8::Unit& u, int wr, int wc, int fr, int fq) const {
        const int pn = u.pn;
#pragma unroll
        for (int ai = 0; ai < 2; ++ai)
#pragma unroll
            for (int m = 0; m < 4; ++m) {
                const int row = u.pm * 256 + ai * 128 + wr * 64 + m * 16 + fr;
                const bool smp = row >= MP; const int rs = row - MP, sb = rs >> 4, st = rs & 15;
#pragma unroll
                for (int bj = 0; bj < 2; ++bj) {
                    const int c0 = pn * 256 + bj * 128 + wc * 32 + fq * 8;
                    const f32x4 v0 = acc[ai][bj][m][0], v1 = acc[ai][bj][m][1];
                    if (pn < 2) {
                        v4u o; o.x = pk2(v0.x * QSCALE, v0.y * QSCALE); o.y = pk2(v0.z * QSCALE, v0.w * QSCALE); o.z = pk2(v1.x * QSCALE, v1.y * QSCALE); o.w = pk2(v1.z * QSCALE, v1.w * QSCALE);
                        *(GAS v4u*)((bf16*)(ws + WS_QB) + (size_t)row * 512 + c0) = o;
                    } else if (pn == 2) {
                        const int c = c0 - (bj ? C_V : C_K);
                        float* of = out + (smp ? (bj ? O_NVS : O_NKS) + (size_t)rs * 128 : (bj ? O_NVP : O_NKP) + (size_t)row * 128) + c;
                        *(GAS f32x4*)of = v0; *(GAS f32x4*)(of + 4) = v1;
                        bf16* ob = smp ? (bf16*)(ws + (bj ? WS_VS : WS_KS)) + ((size_t)sb * LSP + PAST + st) * 128 + c : (bf16*)(ws + (bj ? WS_VBP : WS_KBP)) + (size_t)row * 128 + c;
                        v4u o; o.x = pk2(v0.x, v0.y); o.y = pk2(v0.z, v0.w); o.z = pk2(v1.x, v1.y); o.w = pk2(v1.z, v1.w); *(GAS v4u*)ob = o;
                    } else if (pn < 5) {
                        v4u o; o.x = pk2(v0.x * 0.125f, v0.y * 0.125f); o.y = pk2(v0.z * 0.125f, v0.w * 0.125f); o.z = pk2(v1.x * 0.125f, v1.y * 0.125f); o.w = pk2(v1.z * 0.125f, v1.w * 0.125f);
                        *(GAS v4u*)((bf16*)(ws + WS_QIB) + (size_t)row * 512 + (c0 - C_QI)) = o;
                    } else if (pn == 5) {
                        if (c0 < C_WI) {
                            const int c = c0 - C_KI;
                            float* of = out + (smp ? O_NKIS + (size_t)rs * 64 : O_NKIP + (size_t)row * 64) + c;
                            *(GAS f32x4*)of = v0; *(GAS f32x4*)(of + 4) = v1;
                            bf16* ob = smp ? (bf16*)(ws + WS_KIS) + ((size_t)sb * LSP + PAST + st) * 64 + c : (bf16*)(ws + WS_KIBP) + (size_t)row * 64 + c;
                            v4u o; o.x = pk2(v0.x, v0.y); o.y = pk2(v0.z, v0.w); o.z = pk2(v1.x, v1.y); o.w = pk2(v1.z, v1.w); *(GAS v4u*)ob = o;
                        } else if (c0 == C_WI) {
                            const float s = 0.35355339059327373f; float* of = (float*)(ws + WS_WI) + (size_t)row * 8;
                            *(GAS f32x4*)of = v0 * s; *(GAS f32x4*)(of + 4) = v1 * s;
                        }
                    } else if (pn < 13) {
                        const int c = c0 - C_P;
                        v4u o; o.x = pk2(v0.x, v0.y); o.y = pk2(v0.z, v0.w); o.z = pk2(v1.x, v1.y); o.w = pk2(v1.z, v1.w);
                        *(GAS v4u*)((bf16*)(ws + WS_P) + (size_t)row * RWC + c) = o;
                        const bool last = smp ? (st == DSEQ - 1) : ((row & (SEQ - 1)) == SEQ - 1);
                        if (last) { float* of = out + (smp ? O_SHS + (size_t)sb * RWC : O_SHP + (size_t)(row >> 11) * RWC) + c; *(GAS f32x4*)of = v0; *(GAS f32x4*)(of + 4) = v1; }
                    } else {
                        const bool isb = pn >= 17; const int c = c0 - (isb ? C_GB : C_GA);
                        v4u o; o.x = pk2(sigmoidf_(v0.x), sigmoidf_(v0.y)); o.y = pk2(sigmoidf_(v0.z), sigmoidf_(v0.w)); o.z = pk2(sigmoidf_(v1.x), sigmoidf_(v1.y)); o.w = pk2(sigmoidf_(v1.z), sigmoidf_(v1.w));
                        bf16* ob = smp ? (bf16*)(ws + WS_SGS) + (size_t)(isb ? MS : 0) * DM + (size_t)rs * DM + c : (isb ? sgb_p : sga_p) + (size_t)row * DM + c;
                        *(GAS v4u*)ob = o;
                    }
                }
            }
    }
};
template <bool ACCUM> struct EpiGate {
    static constexpr bool PERM = true, AFTER_DRAIN = false;
    const bf16* sg_p; const bf16* sg_s; bf16* mix;
    __device__ __forceinline__ void operator()(const f32x4 (&acc)[2][2][4][2], const pg8::Unit& u, int wr, int wc, int fr, int fq) const {
#pragma unroll
        for (int ai = 0; ai < 2; ++ai)
#pragma unroll
            for (int m = 0; m < 4; ++m) {
                const int row = u.pm * 256 + ai * 128 + wr * 64 + m * 16 + fr; const bool smp = row >= MP;
#pragma unroll
                for (int bj = 0; bj < 2; ++bj) {
                    const int c0 = u.pn * 256 + bj * 128 + wc * 32 + fq * 8;
                    const v4u g = *(const GAS v4u*)((smp ? sg_s + (size_t)(row - MP) * DM : sg_p + (size_t)row * DM) + c0);
                    f32x4 v0 = acc[ai][bj][m][0], v1 = acc[ai][bj][m][1];
                    v0.x *= bflo(g.x); v0.y *= bfhi(g.x); v0.z *= bflo(g.y); v0.w *= bfhi(g.y); v1.x *= bflo(g.z); v1.y *= bfhi(g.z); v1.z *= bflo(g.w); v1.w *= bfhi(g.w);
                    bf16* op = mix + (size_t)row * DM + c0;
                    if (ACCUM) { const v4u p = *(const GAS v4u*)op; v0.x += bflo(p.x); v0.y += bfhi(p.x); v0.z += bflo(p.y); v0.w += bfhi(p.y); v1.x += bflo(p.z); v1.y += bfhi(p.z); v1.z += bflo(p.w); v1.w += bfhi(p.w); }
                    v4u o; o.x = pk2(v0.x, v0.y); o.y = pk2(v0.z, v0.w); o.z = pk2(v1.x, v1.y); o.w = pk2(v1.z, v1.w); *(GAS v4u*)op = o;
                }
            }
    }
};
struct EpiResid {
    static constexpr bool PERM = false, AFTER_DRAIN = false;
    const float* src_p; const float* src_s; float* dst_p; float* dst_s;
    __device__ __forceinline__ void operator()(const f32x4 (&acc)[2][2][4][2], const pg8::Unit& u, int wr, int wc, int fr, int fq) const {
#pragma unroll
        for (int ai = 0; ai < 2; ++ai)
#pragma unroll
            for (int m = 0; m < 4; ++m) {
                const int row = u.pm * 256 + ai * 128 + wr * 64 + m * 16 + fr; const bool smp = row >= MP;
                const float* s = smp ? src_s + (size_t)(row - MP) * DM : src_p + (size_t)row * DM; float* d = smp ? dst_s + (size_t)(row - MP) * DM : dst_p + (size_t)row * DM;
#pragma unroll
                for (int bj = 0; bj < 2; ++bj)
#pragma unroll
                    for (int n = 0; n < 2; ++n) { const int c = u.pn * 256 + bj * 128 + wc * 32 + n * 16 + fq * 4; *(GAS f32x4*)(d + c) = *(const GAS f32x4*)(s + c) + acc[ai][bj][m][n]; }
            }
    }
};
struct EpiRelu2 {
    static constexpr bool PERM = true, AFTER_DRAIN = false;
    bf16* O;
    __device__ __forceinline__ void operator()(const f32x4 (&acc)[2][2][4][2], const pg8::Unit& u, int wr, int wc, int fr, int fq) const {
#pragma unroll
        for (int ai = 0; ai < 2; ++ai)
#pragma unroll
            for (int m = 0; m < 4; ++m) {
                const int row = u.pm * 256 + ai * 128 + wr * 64 + m * 16 + fr;
#pragma unroll
                for (int bj = 0; bj < 2; ++bj) {
                    const int c0 = u.pn * 256 + bj * 128 + wc * 32 + fq * 8;
                    f32x4 v0 = acc[ai][bj][m][0], v1 = acc[ai][bj][m][1];
                    v0 = __builtin_elementwise_max(v0, (f32x4){0.f, 0.f, 0.f, 0.f}); v1 = __builtin_elementwise_max(v1, (f32x4){0.f, 0.f, 0.f, 0.f}); v0 = v0 * v0; v1 = v1 * v1;
                    v4u o; o.x = pk2(v0.x, v0.y); o.y = pk2(v0.z, v0.w); o.z = pk2(v1.x, v1.y); o.w = pk2(v1.z, v1.w); *(GAS v4u*)(O + (size_t)row * DFF + c0) = o;
                }
            }
    }
};

__device__ __forceinline__ void rms_row_to_f32(int lane, const float* xrow, const float* g, float* orow) {
    const GAS f32x4* xr = (const GAS f32x4*)xrow + lane; const GAS f32x4* gr = (const GAS f32x4*)g + lane;
    f32x4 v[4]; float s = 0.f;
#pragma unroll
    for (int j = 0; j < 4; ++j) { v[j] = xr[64 * j]; s += (v[j].x * v[j].x + v[j].y * v[j].y) + (v[j].z * v[j].z + v[j].w * v[j].w); }
    const float rstd = 1.0f / sqrtf(wave_sum(s) * (1.f / DM) + NORM_EPS);
    GAS f32x4* o = (GAS f32x4*)orow + lane;
#pragma unroll
    for (int j = 0; j < 4; ++j) { const f32x4 gg = gr[64 * j]; o[64 * j] = v[j] * rstd * gg; }
}
#define PHASE6 { pg8::StaticOrder S; S.init(MT_ROWS, DM, F.G, (int)blockIdx.x); \
    { pg8::Gemm g{(const bf16*)(ws + WS_ATT), (const bf16*)(ws + WS_WT_AB), MT_ROWS, DM, 512}; EpiGate<false> E{sga_p, (const bf16*)(ws + WS_SGS), (bf16*)(ws + WS_MIX)}; \
      pg8::gemm_phase<EpiGate<false>, pg8::StaticOrder, true, true>(F.lds, g, S, E); } \
    { pg8::Gemm g{(const bf16*)(ws + WS_RW), (const bf16*)(ws + WS_WT_AB + MiB), MT_ROWS, DM, 512}; EpiGate<true> E{sgb_p, (const bf16*)(ws + WS_SGS) + (size_t)MS * DM, (bf16*)(ws + WS_MIX)}; \
      pg8::gemm_phase<EpiGate<true>, pg8::StaticOrder, true, true>(F.lds, g, S, E); } }
#define PHASE7 { pg8::StaticOrder S; S.init(MT_ROWS, DM, F.G, (int)blockIdx.x); pg8::Gemm g{(const bf16*)(ws + WS_MIX), (const bf16*)(ws + WS_WT_OUT), MT_ROWS, DM, DM}; \
    EpiResid E{args.in[0], args.in[1], args.out + O_YP, (float*)(ws + WS_X1S)}; pg8::gemm_phase<EpiResid, pg8::StaticOrder, true, true>(F.lds, g, S, E); }
#define PHASE8 { const int gw = F.vcu * NWAVES + F.wave, NGW = F.G * NWAVES; \
    for (int m = gw; m < MT_ROWS; m += NGW) { const float* xr = (m < MP) ? args.out + O_YP + (size_t)m * DM : (const float*)(ws + WS_X1S) + (size_t)(m - MP) * DM; rms_row_to_bf16(F.lane, xr, args.in[24], (bf16*)(ws + WS_H2) + (size_t)m * DM); } }
#define PHASE9 { pg8::StaticOrder S; S.init(MT_ROWS, DFF, F.G, (int)blockIdx.x); pg8::Gemm g{(const bf16*)(ws + WS_H2), (const bf16*)(ws + WS_WT_FF1), MT_ROWS, DFF, DM}; \
    EpiRelu2 E{(bf16*)(ws + WS_HFF)}; pg8::gemm_phase<EpiRelu2, pg8::StaticOrder, true, true>(F.lds, g, S, E); }
#define PHASE10 { pg8::StaticOrder S; S.init(MT_ROWS, DM, F.G, (int)blockIdx.x); pg8::Gemm g{(const bf16*)(ws + WS_HFF), (const bf16*)(ws + WS_WT_FF2), MT_ROWS, DM, DFF}; \
    EpiResid E{args.out + O_YP, (const float*)(ws + WS_X1S), args.out + O_YP, (float*)(ws + WS_X1S)}; pg8::gemm_phase<EpiResid, pg8::StaticOrder, true, true>(F.lds, g, S, E); }
#define PHASE11 { const int gw = F.vcu * NWAVES + F.wave, NGW = F.G * NWAVES; \
    for (int m = gw; m < MT_ROWS; m += NGW) { const float* xr = (m < MP) ? args.out + O_YP + (size_t)m * DM : (const float*)(ws + WS_X1S) + (size_t)(m - MP) * DM; \
        float* yr = (m < MP) ? args.out + O_YP + (size_t)m * DM : args.out + O_YS + (size_t)(m - MP) * DM; rms_row_to_f32(F.lane, xr, args.in[27], yr); } }

__device__ __forceinline__ int t5_bucket(int rel) {
    const int n = rel < 0 ? -rel : rel; int r = rel > 0 ? 16 : 0;
    if (n < 8) return r + n;
    return r + 8 + (n >= 12) + (n >= 16) + (n >= 23) + (n >= 32) + (n >= 46) + (n >= 64) + (n >= 91);
}
__device__ __forceinline__ unsigned ordkey(float f) { const unsigned u = __builtin_bit_cast(unsigned, f); return (u & 0x80000000u) ? ~u : (u | 0x80000000u); }

__device__ __forceinline__ void nv_attn_phase(Frame& F, const Args& a) {
    struct Sh { float qi[512]; float q[512]; float wi[8]; unsigned key[LSP]; unsigned char sel[LSP]; float lg[LSP]; unsigned cnt; float red[256]; float o[4][64]; };
    const int half = F.tid >> 8, tid = F.tid & 255;
    LAS Sh* sh = (LAS Sh*)(F.lds + half * 32768);
    unsigned char* ws = a.ws; const float* relb = a.in[7];
    for (int pr = blockIdx.x; pr < MT_ROWS / 2; pr += F.G) {
        const int m = 2 * pr + half;
        const bool smp = m >= MP; const int b = smp ? (m - MP) >> 4 : m >> 11, t = smp ? (m - MP) & 15 : m & 2047;
        const int qpos = smp ? PAST + t : t; const int n = smp ? LS : 64 * (t / 64 + 1);
        const bf16* Ki = smp ? (const bf16*)(ws + WS_KIS) + (size_t)b * LSP * 64 : (const bf16*)(ws + WS_KIBP) + (size_t)b * SEQ * 64;
        const bf16* Kb = smp ? (const bf16*)(ws + WS_KS) + (size_t)b * LSP * 128 : (const bf16*)(ws + WS_KBP) + (size_t)b * SEQ * 128;
        const bf16* Vb = smp ? (const bf16*)(ws + WS_VS) + (size_t)b * LSP * 128 : (const bf16*)(ws + WS_VBP) + (size_t)b * SEQ * 128;
        __syncthreads();
        for (int i = tid; i < 512; i += 256) { sh->qi[i] = bf2f(((const bf16*)(ws + WS_QIB))[(size_t)m * 512 + i]); sh->q[i] = bf2f(((const bf16*)(ws + WS_QB))[(size_t)m * 512 + i]); }
        if (tid < 8) sh->wi[tid] = ((const float*)(ws + WS_WI))[(size_t)m * 8 + tid];
        __syncthreads();
        for (int s = tid; s < n; s += 256) {
            float kd[64];
#pragma unroll
            for (int d = 0; d < 64; ++d) kd[d] = bf2f(Ki[(size_t)s * 64 + d]);
            float sc = 0.f;
            for (int h = 0; h < 8; ++h) { float dot = 0.f;
#pragma unroll
                for (int d = 0; d < 64; ++d) dot = fmaf(sh->qi[h * 64 + d], kd[d], dot);
                sc = fmaf(sh->wi[h], fmaxf(dot, 0.f), sc); }
            sh->key[s] = ordkey(sc); sh->sel[s] = 1;
        }
        __syncthreads();
        if (n > 256) {
            unsigned prefix = 0u;
            for (int bit = 31; bit >= 0; --bit) {
                const unsigned cand = prefix | (1u << bit);
                if (tid == 0) sh->cnt = 0u;
                __syncthreads();
                unsigned c = 0; for (int s = tid; s < n; s += 256) c += sh->key[s] >= cand;
                atomicAdd((unsigned*)&sh->cnt, c);
                __syncthreads();
                if (sh->cnt >= 256u) prefix = cand;
                __syncthreads();
            }
            if (tid == 0) { int gt = 0; for (int s = 0; s < n; ++s) gt += sh->key[s] > prefix; int need = 256 - gt;
                for (int s = 0; s < n; ++s) { const unsigned k = sh->key[s]; unsigned char v = 0; if (k > prefix) v = 1; else if (k == prefix && need > 0) { v = 1; --need; } sh->sel[s] = v; } }
            __syncthreads();
        }
        for (int h = 0; h < 8; ++h) {
            const int j = h >> 2; float mx = -3.0e38f;
            for (int s = tid; s < n; s += 256) { float lg = -3.0e38f;
                if (sh->sel[s]) { float dot = 0.f;
#pragma unroll 8
                    for (int d = 0; d < 64; ++d) dot = fmaf(sh->q[h * 64 + d], bf2f(Kb[(size_t)s * 128 + j * 64 + d]), dot);
                    lg = dot + relb[t5_bucket(s - qpos) * 8 + h] * 1.4426950408889634f; }
                sh->lg[s] = lg; mx = fmaxf(mx, lg); }
            sh->red[tid] = mx; __syncthreads();
            for (int o = 128; o > 0; o >>= 1) { if (tid < o) sh->red[tid] = fmaxf(sh->red[tid], sh->red[tid + o]); __syncthreads(); }
            mx = sh->red[0]; __syncthreads();
            float sum = 0.f;
            for (int s = tid; s < n; s += 256) { const float p = sh->sel[s] ? exp2f(sh->lg[s] - mx) : 0.f; sh->lg[s] = p; sum += p; }
            sh->red[tid] = sum; __syncthreads();
            for (int o = 128; o > 0; o >>= 1) { if (tid < o) sh->red[tid] += sh->red[tid + o]; __syncthreads(); }
            sum = sh->red[0]; __syncthreads();
            const int d = tid & 63, grp = tid >> 6; float acc = 0.f;
            for (int s = grp; s < n; s += 4) { const float p = sh->lg[s]; if (p != 0.f) acc = fmaf(p, bf2f(Vb[(size_t)s * 128 + j * 64 + d]), acc); }
            sh->o[grp][d] = acc; __syncthreads();
            if (tid < 64) ((bf16*)(ws + WS_ATT))[(size_t)m * 512 + h * 64 + tid] = (bf16)f2bf((sh->o[0][tid] + sh->o[1][tid] + sh->o[2][tid] + sh->o[3][tid]) / sum);
            __syncthreads();
        }
    }
}

struct RwTok { float r, k, v, decay, a, g, kk, kh, b, bonus; };
__device__ __forceinline__ RwTok rw_token_prep(const Args& a, int m, int c, LAS float* xs  , LAS float* red  ) {
    unsigned char* ws = a.ws; const bf16* P = (const bf16*)(ws + WS_P);
    const bool smp = m >= MP; const int b = smp ? (m - MP) >> 4 : m >> 11, t = smp ? (m - MP) & 15 : m & 2047;
    const float* mu = a.in[11];
    __syncthreads();
    for (int col = c; col < RWC; col += 512) { const float p = bf2f(P[(size_t)m * RWC + col]); const float pv = (t > 0) ? bf2f(P[(size_t)(m - 1) * RWC + col]) : (smp ? a.in[6][(size_t)b * RWC + col] : 0.f);
        xs[col] = p + (pv - p) * mu[col]; }
    __syncthreads();
    RwTok o; o.r = xs[c]; o.k = xs[512 + c]; o.v = xs[1024 + c];
    float wl = a.in[12][c], al = a.in[14][c], g = 0.f;
#pragma unroll 2
    for (int mm = 0; mm < 64; ++mm) { wl = fmaf(tanhf(xs[1536 + mm]), a.in[13][mm * 512 + c], wl); al = fmaf(xs[1600 + mm], a.in[15][mm * 512 + c], al); }
#pragma unroll 4
    for (int mm = 0; mm < 128; ++mm) g = fmaf(sigmoidf_(xs[1664 + mm]), a.in[16][mm * 512 + c], g);
    const float sp = (-wl > 20.f) ? -wl : log1pf(__expf(-wl));
    const float w = -sp - 0.5f; o.decay = __expf(-__expf(w)); o.a = sigmoidf_(al); o.g = g;
    const float kkr = o.k * a.in[17][c];
    red[c] = kkr * kkr; __syncthreads();
    float ss = 0.f;
#pragma unroll 8
    for (int j = 0; j < 64; ++j) ss += red[(c & ~63) + j];
    __syncthreads();
    o.kk = kkr / fmaxf(sqrtf(ss), 1e-12f);
    o.kh = o.k * (1.0f + (o.a - 1.0f) * a.in[18][c]); o.b = o.kk * o.a;
    red[c] = o.r * o.kh * a.in[19][c]; __syncthreads();
    float bs = 0.f;
#pragma unroll 8
    for (int j = 0; j < 64; ++j) bs += red[(c & ~63) + j];
    __syncthreads();
    o.bonus = bs * o.v;
    return o;
}
constexpr size_t WS_NR = 124 * MiB, WS_NKH = 141 * MiB, WS_NV = 158 * MiB, WS_NKK = 175 * MiB, WS_NB = 192 * MiB, WS_NDEC = 33 * MiB;
__device__ __forceinline__ void nv_rw_prep_phase(Frame& F, const Args& a) {
    LAS float* xs = (LAS float*)F.lds; LAS float* red = xs + RWC; unsigned char* ws = a.ws; const int c = F.tid;
    for (int m = blockIdx.x; m < MT_ROWS; m += F.G) {
        const RwTok o = rw_token_prep(a, m, c, xs, red); const size_t i = (size_t)m * 512 + c;
        ((bf16*)(ws + WS_NR))[i] = (bf16)f2bf(o.r); ((bf16*)(ws + WS_NKH))[i] = (bf16)f2bf(o.kh); ((bf16*)(ws + WS_NV))[i] = (bf16)f2bf(o.v);
        ((bf16*)(ws + WS_NKK))[i] = (bf16)f2bf(o.kk); ((bf16*)(ws + WS_NB))[i] = (bf16)f2bf(o.b); ((float*)(ws + WS_NDEC))[i] = o.decay;
    }
}
__device__ __forceinline__ void nv_rw_scan_phase(Frame& F, const Args& a) {
    const int chain = (int)blockIdx.x + 256 * F.wave;
    if (F.wave < 2 && chain < 320) {
    LAS float* vec = (LAS float*)F.lds + F.wave * 320;
    unsigned char* ws = a.ws; const int i = F.lane;
    const bool smp = chain >= 64; const int b = smp ? (chain - 64) >> 3 : chain >> 3, h = chain & 7; const int T = smp ? DSEQ : SEQ; const size_t m0 = smp ? MP + (size_t)b * DSEQ : (size_t)b * SEQ;
    float S[64];
    { const float* s0 = a.in[5] + (((unsigned)(smp ? b : 0) * 8 + h) * 64 + i) * 64; const float msk = smp ? 1.f : 0.f;
#pragma unroll
      for (int j = 0; j < 64; j += 4) { const f32x4 x = *(const GAS f32x4*)(s0 + j); S[j] = x.x * msk; S[j + 1] = x.y * msk; S[j + 2] = x.z * msk; S[j + 3] = x.w * msk; } }
    const bf16* pKK = (const bf16*)(ws + WS_NKK); const bf16* pB = (const bf16*)(ws + WS_NB); const bf16* pKH = (const bf16*)(ws + WS_NKH); const bf16* pR = (const bf16*)(ws + WS_NR); const bf16* pV = (const bf16*)(ws + WS_NV);
    const float* pD = (const float*)(ws + WS_NDEC); bf16* pY = (bf16*)(ws + WS_RW);
#pragma unroll 1
    for (int t = 0; t < T; ++t) {
        const unsigned idx = ((unsigned)m0 + (unsigned)t) * 512u + (unsigned)(h * 64 + i);
        vec[0 * 64 + i] = bf2f(pKK[idx]); vec[1 * 64 + i] = pD[idx]; vec[2 * 64 + i] = bf2f(pB[idx]);
        vec[3 * 64 + i] = bf2f(pKH[idx]); vec[4 * 64 + i] = bf2f(pR[idx]);
        const float v = bf2f(pV[idx]);
        LDS_WAIT(); __builtin_amdgcn_wave_barrier();
        float sa = 0.f;
#pragma unroll
        for (int j = 0; j < 64; ++j) { sa = fmaf(S[j], vec[j], sa); if ((j & 7) == 7) __builtin_amdgcn_sched_barrier(0); }
        float y = 0.f;
#pragma unroll
        for (int j = 0; j < 64; ++j) { S[j] = S[j] * vec[64 + j] - sa * vec[128 + j] + v * vec[192 + j]; y = fmaf(S[j], vec[256 + j], y); if ((j & 3) == 3) __builtin_amdgcn_sched_barrier(0); }
        pY[idx] = (bf16)f2bf(y);
        LDS_WAIT(); __builtin_amdgcn_wave_barrier();
    }
    float* o = a.out + (smp ? O_WKVS : O_WKVP) + (((unsigned)b * 8 + h) * 64 + i) * 64;
#pragma unroll
    for (int j = 0; j < 64; j += 4) *(GAS f32x4*)(o + j) = (f32x4){S[j], S[j + 1], S[j + 2], S[j + 3]};
    }
}
__device__ __forceinline__ void nv_rw_post_phase(Frame& F, const Args& a) {
    LAS float* xs = (LAS float*)F.lds; LAS float* red = xs + RWC; const int c = F.tid;
    for (int m = blockIdx.x; m < MT_ROWS; m += F.G) {
        const RwTok o = rw_token_prep(a, m, c, xs, red);
        const float y = bf2f(((const bf16*)(a.ws + WS_RW))[(size_t)m * 512 + c]);
        red[c] = y; __syncthreads();
        float s = 0.f;
#pragma unroll 8
        for (int j = 0; j < 64; ++j) s += red[(c & ~63) + j];
        __syncthreads();
        const float mean = s * (1.f / 64.f), dv = y - mean;
        red[c] = dv * dv; __syncthreads();
        float q = 0.f;
#pragma unroll 8
        for (int j = 0; j < 64; ++j) q += red[(c & ~63) + j];
        const float yn = dv * (1.0f / sqrtf(q * (1.f / 64.f) + 64e-5f)) * a.in[20][c] + a.in[21][c];
        ((bf16*)(a.ws + WS_RW))[(size_t)m * 512 + c] = (bf16)f2bf((yn + o.bonus) * o.g);
    }
}

namespace att {
constexpr int SC_RS = 2116;
constexpr int L_SC = 0;
constexpr int KROW = 272, KBUF = 64 * KROW, VROW = 320, VBUF = 64 * VROW;
constexpr int L_K = 0, L_V = 2 * KBUF, L_OST = L_V + 2 * VBUF;
constexpr int L_MSK = 135424;
constexpr int L_BIAS = L_MSK + 32 * 33 * 8;
constexpr int L_WS = L_BIAS + 8192;
constexpr int L_Q = L_WS + 2048;
static_assert(L_OST + 8 * 4096 <= L_MSK && L_Q + 16 <= MISC_OFF, "attention LDS map");
constexpr int N_UNITS = 512 + 32;
constexpr float NEGL = -1.0e30f;
constexpr float LOG2E = 1.4426950408889634f;
__device__ __forceinline__ int crow(int r, int hi) { return (r & 3) + 8 * (r >> 2) + 4 * hi; }
typedef short v4i16_t __attribute__((ext_vector_type(4)));
__device__ __forceinline__ s16x4 vtr(LAS const unsigned char* p) { return __builtin_bit_cast(s16x4, __builtin_amdgcn_ds_read_tr16_b64_v4i16((LAS v4i16_t*)p)); }

__device__ __forceinline__ void f1_subblock(Frame& F, const bf16* Qi_rows, const float* wi_rows, const bf16* Ki, int n, int nt, int qslot0) {
    const int lane = F.lane, fr = lane & 15, fq = lane >> 4;
    {
        bf16x8 qb[8][2];
#pragma unroll
        for (int h = 0; h < 8; ++h)
#pragma unroll
            for (int ks = 0; ks < 2; ++ks) qb[h][ks] = *(const GAS bf16x8*)(Qi_rows + fr * 512 + h * 64 + 32 * ks + 8 * fq);
        const f32x4 w0 = *(const GAS f32x4*)(wi_rows + fr * 8), w1 = *(const GAS f32x4*)(wi_rows + fr * 8 + 4);
        const float wv[8] = {w0.x, w0.y, w0.z, w0.w, w1.x, w1.y, w1.z, w1.w};
        const int nkb = (n + 15) >> 4;
        for (int kb = F.wave; kb < nkb; kb += NWAVES) {
            const bf16* kp = Ki + (size_t)(16 * kb + fr) * 64 + 8 * fq;
            const bf16x8 a0 = *(const GAS bf16x8*)kp, a1 = *(const GAS bf16x8*)(kp + 32);
            f32x4 sc = {0.f, 0.f, 0.f, 0.f};
#pragma unroll
            for (int h = 0; h < 8; ++h) {
                f32x4 acc = __builtin_amdgcn_mfma_f32_16x16x32_bf16(a0, qb[h][0], (f32x4){0.f, 0.f, 0.f, 0.f}, 0, 0, 0);
                acc = __builtin_amdgcn_mfma_f32_16x16x32_bf16(a1, qb[h][1], acc, 0, 0, 0);
#pragma unroll
                for (int r = 0; r < 4; ++r) sc[r] = fmaf(wv[h], fmaxf(acc[r], 0.f), sc[r]);
            }
            *(LAS f32x4*)(F.lds + L_SC + (fr * SC_RS + 16 * kb + 4 * fq) * 4) = sc;
        }
    }
    __syncthreads();
#pragma unroll 1
    for (int qq = 0; qq < 2; ++qq) {
        const int q = 2 * F.wave + qq;
        unsigned key[33];
#pragma unroll
        for (int r = 0; r < 33; ++r) { const int s = 64 * r + lane; key[r] = (r < nt && s < n) ? ordkey(*(LAS const float*)(F.lds + L_SC + (q * SC_RS + s) * 4)) : 0u; }
        unsigned prefix = 0u; bool early = false;
#pragma unroll 1
        for (int bit = 31; bit >= 0; --bit) {
            const unsigned cand = prefix | (1u << bit); int cnt = 0;
#pragma unroll
            for (int r = 0; r < 33; ++r) cnt += __popcll(__ballot(key[r] >= cand));
            if (cnt >= 256) prefix = cand;
            if (cnt == 256) { early = true; break; }
        }
        LAS unsigned long long* mrow = (LAS unsigned long long*)(F.lds + L_MSK) + (qslot0 + q) * 33;
        if (early) {
#pragma unroll
            for (int r = 0; r < 33; ++r) { const unsigned long long sel = __ballot(key[r] >= prefix); if (lane == 0) mrow[r] = sel; }
        } else {
            int gt = 0;
#pragma unroll
            for (int r = 0; r < 33; ++r) gt += __popcll(__ballot(key[r] > prefix));
            int need = 256 - gt;
#pragma unroll
            for (int r = 0; r < 33; ++r) {
                const bool iseq = key[r] == prefix; const unsigned long long eq = __ballot(iseq), gtm = __ballot(key[r] > prefix);
                const int rank = __popcll(eq & ((1ull << lane) - 1ull));
                const unsigned long long take = __ballot(iseq && rank < need);
                need -= __popcll(take);
                if (lane == 0) mrow[r] = gtm | take;
            }
        }
    }
}

__device__ __forceinline__ void f2_unit(Frame& F, const float* relb, const bf16* Qrows, int nqmask, const bf16* Kg, const bf16* Vg, int ntiles, int qpos0, int near_from, bool allsel, bf16* Orows, int nq_store) {
    const int lane = F.lane, h = F.wave, jk = h >> 2, qcol = lane & 31, hi = lane >> 5, qi = qcol & nqmask, tid = F.tid;
    bf16x8 qf[4];
#pragma unroll
    for (int ks = 0; ks < 4; ++ks) qf[ks] = *(const GAS bf16x8*)(Qrows + qi * 512 + h * 64 + 16 * ks + 8 * hi);
    const int prow0 = tid >> 4, pseg = tid & 15;
    v4u stK[2], stV[2];
#define ATT_LOAD(kt_) do { _Pragma("unroll") for (int i_ = 0; i_ < 2; ++i_) { const size_t off_ = (size_t)(64 * (kt_) + prow0 + 32 * i_) * 128 + pseg * 8; \
        stK[i_] = *(const GAS v4u*)(Kg + off_); stV[i_] = *(const GAS v4u*)(Vg + off_); } } while (0)
#define ATT_WRITE(buf_) do { _Pragma("unroll") for (int i_ = 0; i_ < 2; ++i_) { const int row_ = prow0 + 32 * i_; \
        *(LAS v4u*)(F.lds + L_K + (buf_) * KBUF + row_ * KROW + pseg * 16) = stK[i_]; *(LAS v4u*)(F.lds + L_V + (buf_) * VBUF + row_ * VROW + pseg * 16) = stV[i_]; } } while (0)
    ATT_LOAD(0); ATT_WRITE(0);
    __syncthreads();
    f32x16 o[2]; o[0] = (f32x16){}; o[1] = (f32x16){};
    float m = NEGL, l = 0.f;
    const float bconst = relb[15 * 8 + h] * LOG2E;
    LAS float* wsf = (LAS float*)(F.lds + L_WS) + F.wave * 64;
    const LAS float* biasl = (const LAS float*)(F.lds + L_BIAS) + h * 256;
    const LAS unsigned long long* mrow = (const LAS unsigned long long*)(F.lds + L_MSK) + qi * 33;
    const int koff = (lane & 31) * KROW + jk * 128 + 16 * hi;
    const int voff = (4 * hi + ((lane & 15) >> 2)) * VROW + jk * 128 + (16 * ((lane >> 4) & 1) + 4 * (lane & 3)) * 2;
#pragma unroll 1
    for (int kt = 0; kt < ntiles; ++kt) {
        const int cur = kt & 1;
        if (kt + 1 < ntiles) ATT_LOAD(kt + 1);
        const bool near = kt >= near_from;
        const float cinit = near ? 0.f : bconst;
        f32x16 p0, p1;
#pragma unroll
        for (int r = 0; r < 16; ++r) { p0[r] = cinit; p1[r] = cinit; }
        const LAS unsigned char* kb_ = F.lds + L_K + cur * KBUF + koff;
#pragma unroll
        for (int ks = 0; ks < 4; ++ks) {
            const bf16x8 a0 = *(const LAS bf16x8*)(kb_ + 32 * ks), a1 = *(const LAS bf16x8*)(kb_ + 32 * KROW + 32 * ks);
            p0 = __builtin_amdgcn_mfma_f32_32x32x16_bf16(a0, qf[ks], p0, 0, 0, 0);
            p1 = __builtin_amdgcn_mfma_f32_32x32x16_bf16(a1, qf[ks], p1, 0, 0, 0);
        }
        if (near) {
            const int rb = 64 * kt - (qpos0 + qi) + 191;
#pragma unroll
            for (int r = 0; r < 16; ++r) { const int k0 = crow(r, hi); p0[r] += biasl[rb + k0]; p1[r] += biasl[rb + k0 + 32]; }
        }
        if (!allsel) {
            const unsigned long long mw = mrow[kt]; const unsigned mlo = (unsigned)mw >> (4 * hi), mhi = (unsigned)(mw >> 32) >> (4 * hi);
#pragma unroll
            for (int r = 0; r < 16; ++r) { const int sh = (r & 3) + 8 * (r >> 2); p0[r] = ((mlo >> sh) & 1u) ? p0[r] : NEGL; p1[r] = ((mhi >> sh) & 1u) ? p1[r] : NEGL; }
        }
        float mx = fmaxf(p0[0], p1[0]);
#pragma unroll
        for (int r = 1; r < 16; ++r) mx = fmaxf(mx, fmaxf(p0[r], p1[r]));
        mx = fmaxf(mx, __shfl_xor(mx, 32));
        const float mnew = fmaxf(m, mx), alpha = __builtin_amdgcn_exp2f(m - mnew); m = mnew;
        float rs = 0.f;
#pragma unroll
        for (int r = 0; r < 16; ++r) { p0[r] = __builtin_amdgcn_exp2f(p0[r] - mnew); p1[r] = __builtin_amdgcn_exp2f(p1[r] - mnew); rs += p0[r] + p1[r]; }
        rs += __shfl_xor(rs, 32);
        l = l * alpha + rs;
        if (hi == 0) wsf[qcol] = alpha;
        LDS_WAIT(); __builtin_amdgcn_wave_barrier();
#pragma unroll
        for (int r = 0; r < 16; ++r) { const float al = wsf[crow(r, hi)]; o[0][r] *= al; o[1][r] *= al; }
        bf16x8 pa[2][2];
#pragma unroll
        for (int s = 0; s < 2; ++s) {
            v4u w0, w1;
            w0.x = pk2(p0[8 * s + 0], p0[8 * s + 1]); w0.y = pk2(p0[8 * s + 2], p0[8 * s + 3]); w0.z = pk2(p0[8 * s + 4], p0[8 * s + 5]); w0.w = pk2(p0[8 * s + 6], p0[8 * s + 7]);
            w1.x = pk2(p1[8 * s + 0], p1[8 * s + 1]); w1.y = pk2(p1[8 * s + 2], p1[8 * s + 3]); w1.z = pk2(p1[8 * s + 4], p1[8 * s + 5]); w1.w = pk2(p1[8 * s + 6], p1[8 * s + 7]);
            pa[0][s] = __builtin_bit_cast(bf16x8, w0); pa[1][s] = __builtin_bit_cast(bf16x8, w1);
        }
        const LAS unsigned char* vb_ = F.lds + L_V + cur * VBUF + voff;
#pragma unroll
        for (int db = 0; db < 2; ++db)
#pragma unroll
            for (int kb = 0; kb < 2; ++kb)
#pragma unroll
                for (int s = 0; s < 2; ++s) {
                    const LAS unsigned char* vp = vb_ + (32 * kb + 16 * s) * VROW + 64 * db;
                    const s16x4 lo = vtr(vp), hh = vtr(vp + 8 * VROW);
                    const bf16x8 vf = (bf16x8){lo[0], lo[1], lo[2], lo[3], hh[0], hh[1], hh[2], hh[3]};
                    o[db] = __builtin_amdgcn_mfma_f32_32x32x16_bf16(pa[kb][s], vf, o[db], 0, 0, 0);
                }
        if (kt + 1 < ntiles) ATT_WRITE(cur ^ 1);
        __syncthreads();
    }
#undef ATT_LOAD
#undef ATT_WRITE
    if (hi == 0) wsf[32 + qcol] = 1.0f / l;
    LDS_WAIT(); __builtin_amdgcn_wave_barrier();
    LAS bf16* stg = (LAS bf16*)(F.lds + L_OST) + F.wave * 2048;
#pragma unroll
    for (int r = 0; r < 16; ++r) { const int orow = crow(r, hi); const float li = wsf[32 + orow];
        stg[orow * 64 + qcol] = (bf16)f2bf(o[0][r] * li); stg[orow * 64 + 32 + qcol] = (bf16)f2bf(o[1][r] * li); }
    LDS_WAIT(); __builtin_amdgcn_wave_barrier();
#pragma unroll
    for (int i = 0; i < 4; ++i) { const int row = i * 8 + (lane >> 3), ch = lane & 7; const v4u v = *(const LAS v4u*)(stg + row * 64 + ch * 8);
        if (row < nq_store) *(GAS v4u*)(Orows + (size_t)row * 512 + h * 64 + ch * 8) = v; }
}

__device__ __forceinline__ void attn_phase(Frame& F, const Args& a) {
    unsigned char* ws = a.ws; const float* relb = a.in[7];
    for (int e = F.tid; e < 8 * 256; e += NTHREADS) { const int h = e >> 8, idx = e & 255; ((LAS float*)(F.lds + L_BIAS))[e] = relb[t5_bucket(idx - 191) * 8 + h] * LOG2E; }
    unsigned* qhead = (unsigned*)(ws + WS_CTL) + CW_QUEUE;
    for (;;) {
        __syncthreads();
        if (F.tid == 0) *(LAS unsigned*)(F.lds + L_Q) = atomicAdd(qhead, 1u);
        __syncthreads();
        const int u = (int)*(LAS volatile unsigned*)(F.lds + L_Q);
        if (u >= N_UNITS) break;
        if (u < 32) {
            const int b = u; const size_t m0 = MP + (size_t)b * DSEQ;
            f1_subblock(F, (const bf16*)(ws + WS_QIB) + m0 * 512, (const float*)(ws + WS_WI) + m0 * 8, (const bf16*)(ws + WS_KIS) + (size_t)b * LSP * 64, LS, 33, 0);
            __syncthreads();
            f2_unit(F, relb, (const bf16*)(ws + WS_QB) + m0 * 512, 15, (const bf16*)(ws + WS_KS) + (size_t)b * LSP * 128, (const bf16*)(ws + WS_VS) + (size_t)b * LSP * 128, 33, PAST, 30, false,
                    (bf16*)(ws + WS_ATT) + m0 * 512, 16);
        } else {
            const int v = u - 32, qc = 31 - (v >> 4), b = (v >> 1) & 7, half = v & 1;
            const int t0 = 64 * qc + 32 * half; const size_t m0 = (size_t)b * SEQ + t0; const int n = 64 * (qc + 1);
            const bool allsel = qc < 4;
            if (!allsel) {
                for (int sb = 0; sb < 2; ++sb) {
                    f1_subblock(F, (const bf16*)(ws + WS_QIB) + (m0 + 16 * sb) * 512, (const float*)(ws + WS_WI) + (m0 + 16 * sb) * 8, (const bf16*)(ws + WS_KIBP) + (size_t)b * SEQ * 64, n, qc + 1, 16 * sb);
                    __syncthreads();
                }
            }
            f2_unit(F, relb, (const bf16*)(ws + WS_QB) + m0 * 512, 31, (const bf16*)(ws + WS_KBP) + (size_t)b * SEQ * 128, (const bf16*)(ws + WS_VBP) + (size_t)b * SEQ * 128, qc + 1, t0, qc - 2, allsel,
                    (bf16*)(ws + WS_ATT) + m0 * 512, 32);
        }
    }
}
}
#define PHASE2 { att::attn_phase(F, args); }
#define PHASE3 { nv_rw_prep_phase(F, args); }
#define PHASE4 { nv_rw_scan_phase(F, args); }
#define PHASE5 { nv_rw_post_phase(F, args); }
#define HOST_SEQUENCE RUN_PHASES(0, N_PHASES);

constexpr int N_PHASES = 12;
__global__ void __launch_bounds__(NTHREADS, 2) fwd_kernel(Args args) {
    extern __shared__ __attribute__((aligned(16))) unsigned char lds[];
    Frame F;
    F.lds = (LAS unsigned char*)lds;
    F.tid = threadIdx.x; F.lane = F.tid & 63; F.wave = __builtin_amdgcn_readfirstlane(F.tid >> 6);
    F.G = gridDim.x; { const int bx = blockIdx.x; F.vcu = (F.G % 8 == 0) ? (bx % 8) * (F.G / 8) + bx / 8 : bx; }
    unsigned char* ws = args.ws;
    const int lo = args.ph_lo, hi = args.ph_hi;
    volatile LAS unsigned* MISC = (volatile LAS unsigned*)(F.lds + MISC_OFF);
    if (F.tid < 64) MISC[F.tid] = 0u;
    __syncthreads();
    XcdBarrier bar = xcd_barrier_post((unsigned*)(ws + WS_CTL) + CW_BAR, MISC + 8);
#define SEAM(k) do { if (IN(k) && IN((k) + 1)) xcd_barrier(bar); } while (0)
#define IN(k) (lo <= (k) && (k) < hi)
    bf16* sga_p = (bf16*)args.out; bf16* sgb_p = sga_p + (size_t)MP * DM;

    if (IN(0)) { p0_prologue(F, args); } SEAM(0);
    if (IN(1)) {
        pg8::Gemm g{(const bf16*)(ws + WS_H), (const bf16*)(ws + WS_WT_IN), MT_ROWS, NPAD, DM}; pg8::StaticOrder S; S.init(MT_ROWS, NPAD, F.G, (int)blockIdx.x);
        EpiInProj E{ws, args.out, sga_p, sgb_p};
        pg8::gemm_phase<EpiInProj, pg8::StaticOrder, true, true>(F.lds, g, S, E);
    } SEAM(1);
    if (IN(2)) { PHASE2 } SEAM(2);
    if (IN(3)) { PHASE3 } SEAM(3);
    if (IN(4)) { PHASE4 } SEAM(4);
    if (IN(5)) { PHASE5 } SEAM(5);
    if (IN(6)) { PHASE6 } SEAM(6);
    if (IN(7)) { PHASE7 } SEAM(7);
    if (IN(8)) { PHASE8 } SEAM(8);
    if (IN(9)) { PHASE9 } SEAM(9);
    if (IN(10)) { PHASE10 } SEAM(10);
    if (IN(11)) { PHASE11 }
#undef IN
}

extern "C" void kernel_launch(void* const* d_in, const int* in_sizes, int n_in, void* d_out, int out_size, void* d_ws, size_t ws_size, hipStream_t stream) {
    static int grid = 0;
    if (grid == 0) {
        if (n_in != 28 || out_size != (int)O_END || ws_size < WS_END) { fprintf(stderr, "kernel_launch: unexpected shapes: n_in %d out %d ws %zu\n", n_in, out_size, ws_size); grid = -1; return; }
        int dev = 0, cus = 0;
        if (hipGetDevice(&dev) != hipSuccess || hipDeviceGetAttribute(&cus, hipDeviceAttributeMultiprocessorCount, dev) != hipSuccess) { grid = -1; return; }
        if (hipFuncSetAttribute((const void*)fwd_kernel, hipFuncAttributeMaxDynamicSharedMemorySize, LDS_BYTES) != hipSuccess) { fprintf(stderr, "kernel_launch: hipFuncSetAttribute failed\n"); grid = -1; return; }
        int per_cu = 0;
        if (hipOccupancyMaxActiveBlocksPerMultiprocessor(&per_cu, (const void*)fwd_kernel, NTHREADS, LDS_BYTES) != hipSuccess || per_cu < 1) fprintf(stderr, "kernel_launch: occupancy query says %d\n", per_cu);
        (void)hipGetLastError();
        grid = cus;
    }
    if (grid < 0) return;
    (void)hipMemsetAsync((char*)d_ws + WS_CTL, 0, CTL_ZERO_BYTES, stream);
    Args a{};
    for (int i = 0; i < 28; ++i) a.in[i] = (const float*)d_in[i];
    a.out = (float*)d_out; a.ws = (unsigned char*)d_ws;
#define RUN_PHASES(lo_, hi_) do { a.ph_lo = (lo_); a.ph_hi = (hi_); hipLaunchKernelGGL(fwd_kernel, dim3(grid), dim3(NTHREADS), LDS_BYTES, stream, a); } while (0)
    HOST_SEQUENCE
#undef RUN_PHASES
}
```

```cpp
#include <hip/hip_runtime.h>
#include <cstdio>
#include <cstdint>
namespace pg8 {
#define PG8_LAS __attribute__((address_space(3)))
typedef unsigned short bf16_t;
typedef short bf16x8 __attribute__((ext_vector_type(8)));
typedef float f32x4 __attribute__((ext_vector_type(4)));
typedef unsigned u32x4 __attribute__((ext_vector_type(4)));
typedef unsigned u32x2 __attribute__((ext_vector_type(2)));
constexpr int BM = 256, BK = 64, HALF = 128, HTB = HALF * BK * 2  , STAGE_BYTES = 8 * HTB, NXCD = 8, WGM = 8;

__host__ __device__ __forceinline__ int lds_byte(int r, int c) { const int st = (r >> 4) * 2 + (c >> 5), rr = r & 15, cc = c & 31, ob = rr * 64 + cc * 2; return st * 1024 + (ob ^ (((ob >> 9) & 1) << 5)); }
__host__ __device__ __forceinline__ void stage_rc(int b, int& R, int& C) { const int st = b / 1024, sb = b % 1024, swz = sb ^ (((sb >> 9) & 1) << 5); R = (st >> 1) * 16 + swz / 64; C = (st & 1) * 32 + (swz % 64) / 2; }
__host__ __device__ __forceinline__ int perm32(int rho) { const int n = rho >> 4, i = rho & 15; return 8 * (i >> 2) + 4 * n + (i & 3); }

struct Unit { int pm, pn; };
struct Gemm { const bf16_t* A; const bf16_t* Bt; int M, N, K; };

struct StaticOrder {
    int nM, nN, nwg, G, c;
    __host__ __device__ void init(int M, int N, int G_, int c_) { nM = M / BM; nN = N / BM; nwg = nM * nN; G = G_; c = c_; }
    __host__ __device__ bool next(int i, Unit& u) const {
        const long L = (long)i * G + c; if (L >= nwg) return false;
        int wgid = (int)L; { const int q = nwg / NXCD, r = nwg % NXCD, xcd = wgid % NXCD, off = wgid / NXCD; wgid = (xcd < r ? xcd * (q + 1) : r * (q + 1) + (xcd - r) * q) + off; }
        const int nig = WGM * nN, gid = wgid / nig, fm = gid * WGM, gsz = (nM - fm) < WGM ? (nM - fm) : WGM;
        u.pm = fm + ((wgid % nig) % gsz); u.pn = (wgid % nig) / gsz; return true;
    }
    __device__ __forceinline__ void a_ready(const Unit&) const {}
    __device__ __forceinline__ void done(const Unit&) const {}
};
__device__ __forceinline__ unsigned cvt_pk_bf16(float lo, float hi) { unsigned r; asm volatile("v_cvt_pk_bf16_f32 %0, %1, %2" : "=v"(r) : "v"(lo), "v"(hi)); return r; }

template <class Epi, class Sched, bool ALIGN_EPI = false, bool SP2 = false>
__device__ __forceinline__ void gemm_phase(PG8_LAS unsigned char* lds, const Gemm g, const Sched& S, const Epi& E) {
    const int tid = threadIdx.x, wid = __builtin_amdgcn_readfirstlane(tid >> 6), lane = tid & 63, wr = wid >> 2, wc = wid & 3, fr = lane & 15, fq = lane >> 4;
    const int K = g.K, nt = K / BK;
    unsigned voffA[2], voffB[2];
#pragma unroll
    for (int i = 0; i < 2; ++i) { int R, C; stage_rc(tid * 16 + i * 8192, R, C); const int Rb = Epi::PERM ? ((R & ~31) + perm32(R & 31)) : R;
        voffA[i] = (unsigned)(R * K + C) * 2u; voffB[i] = (unsigned)(Rb * K + C) * 2u; }
    const size_t kstep = (size_t)(BK * 2);
    const size_t hstep = (size_t)HALF * K * 2;
    const size_t tstep = 2 * hstep;
    const unsigned ldsw = (unsigned)wid * 1024u;
    const int aoff = lds_byte(wr * 64 + fr, fq * 8), boff = lds_byte(wc * 32 + fr, fq * 8);
#define PG8_SA(b, h) (((b) * 2 + (h)) * HTB)
#define PG8_SB(b, h) ((4 + (b) * 2 + (h)) * HTB)
#define PG8_STAGE(bufoff, gbase, voff) do { _Pragma("unroll") for (int _i = 0; _i < 2; ++_i) \
        __builtin_amdgcn_global_load_lds((const unsigned*)((const char*)(gbase) + (voff)[_i]), (PG8_LAS unsigned*)(lds + (bufoff) + ldsw + _i * 8192), 16, 0, 0); } while (0)
#define PG8_LDA(dst, b, h) do { _Pragma("unroll") for (int m = 0; m < 4; ++m) _Pragma("unroll") for (int k = 0; k < 2; ++k) dst[m][k] = *(const PG8_LAS bf16x8*)(lds + PG8_SA(b, h) + aoff + m * 2048 + k * 1024); } while (0)
#define PG8_LDB(dst, b, h) do { _Pragma("unroll") for (int n = 0; n < 2; ++n) _Pragma("unroll") for (int k = 0; k < 2; ++k) dst[n][k] = *(const PG8_LAS bf16x8*)(lds + PG8_SB(b, h) + boff + n * 2048 + k * 1024); } while (0)
#define PG8_MMA(ai, bj, At, Bt) do { __builtin_amdgcn_s_setprio(1); _Pragma("unroll") for (int m = 0; m < 4; ++m) _Pragma("unroll") for (int n = 0; n < 2; ++n) _Pragma("unroll") for (int k = 0; k < 2; ++k) \
        acc[ai][bj][m][n] = __builtin_amdgcn_mfma_f32_16x16x32_bf16(Bt[n][k], At[m][k], acc[ai][bj][m][n], 0, 0, 0); __builtin_amdgcn_s_setprio(0); } while (0)
#define PG8_WAIT_V(n) asm volatile("s_waitcnt vmcnt(" #n ")" ::: "memory")
#define PG8_WAIT_L(n) asm volatile("s_waitcnt lgkmcnt(" #n ")" ::: "memory")
#define PG8_BAR __builtin_amdgcn_s_barrier()
#define PG8_SCHED __builtin_amdgcn_sched_barrier(0)
    Unit cur, nxt; int ui = 0;
    if (!S.next(0, cur)) return;
    f32x4 acc[2][2][4][2];
#pragma unroll
    for (int a = 0; a < 2; ++a)
#pragma unroll
        for (int b = 0; b < 2; ++b)
#pragma unroll
            for (int m = 0; m < 4; ++m)
#pragma unroll
                for (int n = 0; n < 2; ++n) acc[a][b][m][n] = (f32x4){0.f, 0.f, 0.f, 0.f};
    bf16x8 At[4][2], B0[2][2], B1[2][2];
    const char* cA = (const char*)g.A + (size_t)cur.pm * tstep; const char* cB = (const char*)g.Bt + (size_t)cur.pn * tstep;
    S.a_ready(cur);
    if constexpr (SP2) {
        PG8_STAGE(PG8_SB(0, 0), cB, voffB); PG8_STAGE(PG8_SB(0, 1), cB + hstep, voffB); PG8_STAGE(PG8_SA(0, 0), cA, voffA); PG8_STAGE(PG8_SA(0, 1), cA + hstep, voffA);
        if (wr == 1) PG8_BAR;
        PG8_WAIT_V(2); PG8_BAR;
        PG8_STAGE(PG8_SB(1, 0), cB + kstep, voffB); PG8_STAGE(PG8_SA(1, 0), cA + kstep, voffA); PG8_STAGE(PG8_SB(1, 1), cB + hstep + kstep, voffB);
        PG8_WAIT_V(6); PG8_BAR;
    } else {
        PG8_STAGE(PG8_SB(0, 0), cB, voffB); PG8_STAGE(PG8_SA(0, 0), cA, voffA); PG8_STAGE(PG8_SB(0, 1), cB + hstep, voffB); PG8_STAGE(PG8_SA(0, 1), cA + hstep, voffA);
        if (wr == 1) PG8_BAR;
        PG8_WAIT_V(4); PG8_BAR;
        PG8_STAGE(PG8_SB(1, 0), cB + kstep, voffB); PG8_STAGE(PG8_SA(1, 0), cA + kstep, voffA); PG8_STAGE(PG8_SB(1, 1), cB + hstep + kstep, voffB);
        PG8_WAIT_V(6); PG8_BAR;
    }
    for (;;) {
        const bool has_next = S.next(ui + 1, nxt);
        const char* nA = has_next ? (const char*)g.A + (size_t)nxt.pm * tstep : cA; const char* nB = has_next ? (const char*)g.Bt + (size_t)nxt.pn * tstep : cB;
        for (int t = 0; t < nt; t += 2) {
            const bool last = (t == nt - 2);
            const char* a1 = cA + (size_t)(t + 1) * kstep;
            const char* a2 = last ? nA : cA + (size_t)(t + 2) * kstep; const char* b2 = last ? nB : cB + (size_t)(t + 2) * kstep;
            const char* a3 = a2 + kstep; const char* b3 = b2 + kstep;
            if (last && has_next) S.a_ready(nxt);
            if constexpr (SP2) {
            PG8_LDB(B0, 0, 0); PG8_LDB(B1, 0, 1); PG8_SCHED; PG8_LDA(At, 0, 0); PG8_STAGE(PG8_SA(1, 1), a1 + hstep, voffA);
            PG8_WAIT_V(8); PG8_WAIT_L(0); PG8_BAR; PG8_MMA(0, 0, At, B0); PG8_MMA(0, 1, At, B1); PG8_BAR; PG8_SCHED;
            PG8_LDA(At, 0, 1); PG8_STAGE(PG8_SB(0, 0), b2, voffB); PG8_STAGE(PG8_SB(0, 1), b2 + hstep, voffB); PG8_STAGE(PG8_SA(0, 0), a2, voffA);
            PG8_WAIT_V(8); PG8_WAIT_L(0); PG8_BAR; PG8_MMA(1, 0, At, B0); PG8_MMA(1, 1, At, B1); PG8_BAR; PG8_SCHED;
            PG8_LDB(B0, 1, 0); PG8_LDB(B1, 1, 1); PG8_SCHED; PG8_LDA(At, 1, 0); PG8_STAGE(PG8_SA(0, 1), a2 + hstep, voffA);
            PG8_WAIT_V(8); PG8_WAIT_L(0); PG8_BAR; PG8_MMA(0, 0, At, B0); PG8_MMA(0, 1, At, B1); PG8_BAR; PG8_SCHED;
            PG8_LDA(At, 1, 1); PG8_STAGE(PG8_SB(1, 0), b3, voffB); PG8_STAGE(PG8_SB(1, 1), b3 + hstep, voffB); PG8_STAGE(PG8_SA(1, 0), a3, voffA);
            PG8_WAIT_V(8); PG8_WAIT_L(0); PG8_BAR; PG8_MMA(1, 0, At, B0); PG8_MMA(1, 1, At, B1); PG8_BAR; PG8_SCHED;
            } else {
            PG8_LDB(B0, 0, 0); PG8_SCHED; PG8_LDA(At, 0, 0); PG8_STAGE(PG8_SA(1, 1), a1 + hstep, voffA);
            PG8_WAIT_L(8); PG8_BAR; PG8_WAIT_L(0); PG8_MMA(0, 0, At, B0); PG8_BAR; PG8_SCHED;
            PG8_LDB(B1, 0, 1); PG8_STAGE(PG8_SB(0, 0), b2, voffB);
            PG8_BAR; PG8_WAIT_L(0); PG8_MMA(0, 1, At, B1); PG8_BAR;
            PG8_LDA(At, 0, 1); PG8_STAGE(PG8_SA(0, 0), a2, voffA);
            PG8_BAR; PG8_WAIT_L(0); PG8_MMA(1, 0, At, B0); PG8_BAR; PG8_SCHED;
            PG8_STAGE(PG8_SB(0, 1), b2 + hstep, voffB);
            PG8_WAIT_V(6); PG8_BAR; PG8_MMA(1, 1, At, B1); PG8_BAR;
            PG8_LDB(B0, 1, 0); PG8_SCHED; PG8_LDA(At, 1, 0); PG8_STAGE(PG8_SA(0, 1), a2 + hstep, voffA);
            PG8_WAIT_L(8); PG8_BAR; PG8_WAIT_L(0); PG8_MMA(0, 0, At, B0); PG8_BAR; PG8_SCHED;
            PG8_LDB(B1, 1, 1); PG8_STAGE(PG8_SB(1, 0), b3, voffB);
            PG8_BAR; PG8_WAIT_L(0); PG8_MMA(0, 1, At, B1); PG8_BAR;
            PG8_LDA(At, 1, 1); PG8_STAGE(PG8_SA(1, 0), a3, voffA);
            PG8_BAR; PG8_WAIT_L(0); PG8_MMA(1, 0, At, B0); PG8_BAR; PG8_SCHED;
            PG8_STAGE(PG8_SB(1, 1), b3 + hstep, voffB);
            PG8_WAIT_V(6); PG8_BAR; PG8_MMA(1, 1, At, B1); PG8_BAR;
            }
        }
        if constexpr (ALIGN_EPI) { if (wr == 0) PG8_BAR; }
        if constexpr (!Epi::AFTER_DRAIN) { E(acc, cur, wr, wc, fr, fq); S.done(cur); }
        if (!has_next) break;
#pragma unroll
        for (int a = 0; a < 2; ++a)
#pragma unroll
            for (int b = 0; b < 2; ++b)
#pragma unroll
                for (int m = 0; m < 4; ++m)
#pragma unroll
                    for (int n = 0; n < 2; ++n) acc[a][b][m][n] = (f32x4){0.f, 0.f, 0.f, 0.f};
        cur = nxt; cA = nA; cB = nB; ++ui;
        if constexpr (ALIGN_EPI) { if (wr == 1) PG8_BAR; }
    }
    PG8_WAIT_V(0);
    if constexpr (!ALIGN_EPI) { if (wr == 0) PG8_BAR; }
    PG8_BAR;
    if constexpr (Epi::AFTER_DRAIN) { E.fused(acc, cur, wr, wc, fr, fq, lds, wid, lane); S.done(cur); }
#undef PG8_SA
#undef PG8_SB
#undef PG8_STAGE
#undef PG8_LDA
#undef PG8_LDB
#undef PG8_MMA
#undef PG8_WAIT_V
#undef PG8_WAIT_L
#undef PG8_BAR
#undef PG8_SCHED
}
}

constexpr int DM = 1024, MP = 16384, MS = 512, MT_ROWS = MP + MS;
constexpr int SEQ = 2048, PAST = 2048, DSEQ = 16, NB_P = 8, NB_S = 32, LS = PAST + DSEQ, LSP = 2112;
constexpr int NPAD = 5376, RWC = 1792, DFF = 4096;
constexpr int C_Q = 0, C_K = 512, C_V = 640, C_QI = 768, C_KI = 1280, C_WI = 1344, C_P = 1536, C_GA = 3328, C_GB = 4352;
constexpr size_t O_YP = 0, O_YS = 16777216, O_NKP = 17301504, O_NVP = 19398656, O_NKIP = 21495808, O_WKVP = 22544384, O_SHP = 22806528,
                 O_NKS = 22820864, O_NVS = 22886400, O_NKIS = 22951936, O_WKVS = 22984704, O_SHS = 24033280, O_END = 24090624;
constexpr float QSCALE = 0.125f * 1.4426950408889634f;
constexpr float NORM_EPS = 1e-6f;
constexpr size_t MiB = 1u << 20;
constexpr size_t WS_CTL = 0, CTL_ZERO_BYTES = 1 * MiB;
constexpr size_t WS_WT_IN = 1 * MiB, WS_WT_AB = 12 * MiB, WS_WT_OUT = 14 * MiB, WS_WT_FF1 = 16 * MiB, WS_WT_FF2 = 24 * MiB;
constexpr size_t WS_WT_D = 32 * MiB, WS_WT_A = WS_WT_D + 65536, WS_WT_G = WS_WT_A + 65536;
constexpr size_t WS_H = 33 * MiB;
constexpr size_t WS_P = 66 * MiB;
constexpr size_t WS_QB = 124 * MiB, WS_QIB = 141 * MiB, WS_KBP = 158 * MiB, WS_VBP = 162 * MiB, WS_KIBP = 166 * MiB;
constexpr size_t WS_KS = 168 * MiB, WS_VS = 185 * MiB, WS_KIS = 202 * MiB, WS_WI = 211 * MiB, WS_SGS = 212 * MiB;
constexpr size_t WS_ATT = 214 * MiB, WS_RW = 231 * MiB;
constexpr size_t WS_X1S = 247 * MiB;
constexpr size_t WS_MT = 33 * MiB, WS_NT = 124 * MiB, WS_WY = 142 * MiB, WS_YL = 160 * MiB, WS_G1 = 178 * MiB, WS_E = 195 * MiB, WS_SSN = 66 * MiB;
constexpr size_t WS_MIX = 33 * MiB, WS_H2 = 66 * MiB, WS_HFF = 99 * MiB;
constexpr size_t WS_END = 256 * MiB;
static_assert(WS_HFF + (size_t)MT_ROWS * DFF * 2 <= WS_X1S, "ws map");
constexpr int CW_QUEUE = 64;
constexpr int CW_BAR = 4096;

constexpr int NWAVES = 8, NTHREADS = 512;
constexpr int LDS_BYTES = 163840;
constexpr int MISC_OFF = LDS_BYTES - 1024;

#define GAS __attribute__((address_space(1)))
#define LAS __attribute__((address_space(3)))
typedef unsigned short bf16;
typedef unsigned v4u __attribute__((ext_vector_type(4)));
typedef unsigned v2u __attribute__((ext_vector_type(2)));
typedef float f32x4 __attribute__((ext_vector_type(4)));
typedef float f32x16 __attribute__((ext_vector_type(16)));
typedef short bf16x8 __attribute__((ext_vector_type(8)));
typedef short s16x4 __attribute__((ext_vector_type(4)));
#define LDS_WAIT() asm volatile("s_waitcnt lgkmcnt(0)" ::: "memory")
#define VM_WAIT() asm volatile("s_waitcnt vmcnt(0)" ::: "memory")
__device__ __forceinline__ unsigned f2bf(float f) { unsigned u = __builtin_bit_cast(unsigned, f); return (u + 0x7fffu + ((u >> 16) & 1u)) >> 16; }
__device__ __forceinline__ unsigned pk2(float lo, float hi) { return f2bf(lo) | (f2bf(hi) << 16); }
__device__ __forceinline__ float bf2f(unsigned short h) { return __builtin_bit_cast(float, (unsigned)h << 16); }
__device__ __forceinline__ float bflo(unsigned w) { return __builtin_bit_cast(float, w << 16); }
__device__ __forceinline__ float bfhi(unsigned w) { return __builtin_bit_cast(float, w & 0xffff0000u); }
__device__ __forceinline__ float wave_sum(float v) {
#pragma unroll
    for (int o = 1; o < 64; o <<= 1) v += __shfl_xor(v, o);
    return v;
}
__device__ __forceinline__ float sigmoidf_(float x) { return 1.0f / (1.0f + __expf(-x)); }

struct Args {
    const float* in[28];
    float* out; unsigned char* ws;
    int ph_lo, ph_hi;
};
struct Frame {
    LAS unsigned char* lds;
    int tid, lane, wave, vcu, G;
};

__device__ __forceinline__ void p0_transpose_item(const float* W, int ldw, int src_col0, bf16* WT, int dst_ld, int dst_row0, int dst_k0, int nblk, LAS float* scr, int item, int lane) {
    const int kb = item / nblk, nb = item % nblk, k0 = 64 * kb, n0 = 32 * nb;
#pragma unroll 8
    for (int i = 0; i < 32; ++i) { const int kk = 2 * i + (lane >> 5); scr[kk * 33 + (lane & 31)] = W[(size_t)(k0 + kk) * ldw + src_col0 + n0 + (lane & 31)]; }
    LDS_WAIT(); asm volatile("" ::: "memory");
    const int c = lane & 7;
#pragma unroll
    for (int j = 0; j < 4; ++j) { const int n = (lane >> 3) + 8 * j; const LAS float* s = scr + (8 * c) * 33 + n;
        v4u o; o.x = pk2(s[0 * 33], s[1 * 33]); o.y = pk2(s[2 * 33], s[3 * 33]); o.z = pk2(s[4 * 33], s[5 * 33]); o.w = pk2(s[6 * 33], s[7 * 33]);
        *(GAS v4u*)(WT + (size_t)(dst_row0 + n0 + n) * dst_ld + dst_k0 + k0 + 8 * c) = o; }
    LDS_WAIT(); asm volatile("" ::: "memory");
}
__device__ __forceinline__ void rms_row_to_bf16(int lane, const float* xrow, const float* g, bf16* orow) {
    const GAS f32x4* xr = (const GAS f32x4*)xrow + lane; const GAS f32x4* gr = (const GAS f32x4*)g + lane;
    f32x4 v[4]; float s = 0.f;
#pragma unroll
    for (int j = 0; j < 4; ++j) { v[j] = xr[64 * j]; s += (v[j].x * v[j].x + v[j].y * v[j].y) + (v[j].z * v[j].z + v[j].w * v[j].w); }
    const float rstd = 1.0f / sqrtf(wave_sum(s) * (1.f / DM) + NORM_EPS);
    GAS v2u* o8 = (GAS v2u*)orow + lane;
#pragma unroll
    for (int j = 0; j < 4; ++j) { const f32x4 gg = gr[64 * j]; v2u o; o.x = pk2(v[j].x * rstd * gg.x, v[j].y * rstd * gg.y); o.y = pk2(v[j].z * rstd * gg.z, v[j].w * rstd * gg.w); o8[64 * j] = o; }
}
__device__ __forceinline__ void p0_prologue(Frame& F, const Args& a) {
    unsigned char* ws = a.ws;
    LAS float* scr = (LAS float*)(F.lds + F.wave * 16384);
    const int gw = F.vcu * NWAVES + F.wave, NGW = F.G * NWAVES;
    int base = 0;
#define TRJ(in_idx, ldw, sc0, ncols, K, dst, dld, dr0, dk0) { const int nblk = (ncols) / 32, nit = ((K) / 64) * nblk; int first = (gw - base) % NGW; if (first < 0) first += NGW; \
        for (int it = first; it < nit; it += NGW) p0_transpose_item(a.in[in_idx], ldw, sc0, (bf16*)(ws + (dst)), dld, dr0, dk0, nblk, scr, it, F.lane); base += nit; }
    TRJ(9, 5192, 0, 512, 1024, WS_WT_IN, 1024, C_Q, 0) TRJ(9, 5192, 512, 128, 1024, WS_WT_IN, 1024, C_K, 0) TRJ(9, 5192, 640, 128, 1024, WS_WT_IN, 1024, C_V, 0)
    TRJ(9, 5192, 768, 512, 1024, WS_WT_IN, 1024, C_QI, 0) TRJ(9, 5192, 1280, 64, 1024, WS_WT_IN, 1024, C_KI, 0) TRJ(9, 5192, 1352, 1792, 1024, WS_WT_IN, 1024, C_P, 0)
    TRJ(9, 5192, 3144, 1024, 1024, WS_WT_IN, 1024, C_GA, 0) TRJ(9, 5192, 4168, 1024, 1024, WS_WT_IN, 1024, C_GB, 0)
    TRJ(10, 1024, 0, 1024, 512, WS_WT_AB, 512, 0, 0) TRJ(22, 1024, 0, 1024, 512, WS_WT_AB + MiB, 512, 0, 0)
    TRJ(23, 1024, 0, 1024, 1024, WS_WT_OUT, 1024, 0, 0) TRJ(25, 4096, 0, 4096, 1024, WS_WT_FF1, 1024, 0, 0) TRJ(26, 1024, 0, 1024, 4096, WS_WT_FF2, 4096, 0, 0)
    TRJ(13, 512, 0, 512, 64, WS_WT_D, 64, 0, 0) TRJ(15, 512, 0, 512, 64, WS_WT_A, 64, 0, 0) TRJ(16, 512, 0, 512, 128, WS_WT_G, 128, 0, 0)
#undef TRJ
    if (gw == NGW - 1) {
        const float* W = a.in[9]; bf16* WT = (bf16*)(ws + WS_WT_IN);
        for (int e = F.lane; e < 8 * 1024; e += 64) { const int n = e >> 10, k = e & 1023; WT[(size_t)(C_WI + n) * 1024 + k] = (bf16)f2bf(W[(size_t)k * 5192 + 1344 + n]); }
    }
    bf16* H = (bf16*)(ws + WS_H);
    for (int m = gw; m < MT_ROWS; m += NGW) { const float* xr = (m < MP) ? a.in[0] + (size_t)m * DM : a.in[1] + (size_t)(m - MP) * DM; rms_row_to_bf16(F.lane, xr, a.in[8], H + (size_t)m * DM); }
    const int gt = F.vcu * NTHREADS + F.tid, NGT = F.G * NTHREADS;
    {
        const int nit = NB_S * PAST * 128 / 8;
        for (int it = gt; it < 2 * nit; it += NGT) { const int which = it >= nit, e = (which ? it - nit : it) * 8; const float* src = a.in[2 + which] + e;
            const int b = e / (PAST * 128), rem = e % (PAST * 128); bf16* dst = (bf16*)(ws + (which ? WS_VS : WS_KS)) + (size_t)b * LSP * 128 + rem;
            const f32x4 x0 = *(const GAS f32x4*)src, x1 = *(const GAS f32x4*)(src + 4); v4u o; o.x = pk2(x0.x, x0.y); o.y = pk2(x0.z, x0.w); o.z = pk2(x1.x, x1.y); o.w = pk2(x1.z, x1.w); *(GAS v4u*)dst = o; }
        const int nit2 = NB_S * PAST * 64 / 8;
        for (int it = gt; it < nit2; it += NGT) { const int e = it * 8; const float* src = a.in[4] + e; const int b = e / (PAST * 64), rem = e % (PAST * 64); bf16* dst = (bf16*)(ws + WS_KIS) + (size_t)b * LSP * 64 + rem;
            const f32x4 x0 = *(const GAS f32x4*)src, x1 = *(const GAS f32x4*)(src + 4); v4u o; o.x = pk2(x0.x, x0.y); o.y = pk2(x0.z, x0.w); o.z = pk2(x1.x, x1.y); o.w = pk2(x1.z, x1.w); *(GAS v4u*)dst = o; }
        const int npad = NB_S * (LSP - LS) * 128 / 8;
        for (int it = gt; it < 2 * npad; it += NGT) { const int which = it >= npad, e = (which ? it - npad : it) * 8; const int b = e / ((LSP - LS) * 128), rem = e % ((LSP - LS) * 128);
            *(GAS v4u*)((bf16*)(ws + (which ? WS_VS : WS_KS)) + ((size_t)b * LSP + LS) * 128 + rem) = (v4u){0u, 0u, 0u, 0u}; }
        const int npad2 = NB_S * (LSP - LS) * 64 / 8;
        for (int it = gt; it < npad2; it += NGT) { const int e = it * 8; const int b = e / ((LSP - LS) * 64), rem = e % ((LSP - LS) * 64);
            *(GAS v4u*)((bf16*)(ws + WS_KIS) + ((size_t)b * LSP + LS) * 64 + rem) = (v4u){0u, 0u, 0u, 0u}; }
    }
}
typedef GAS unsigned gu32;
typedef GAS unsigned long long gu64;
#define RLX_AGENT __ATOMIC_RELAXED, __HIP_MEMORY_SCOPE_AGENT
__device__ __forceinline__ unsigned long long rt() { return __builtin_amdgcn_s_memrealtime(); }
#define XB_TMO      128
#define XB_XCNT(j)  (256  + 64 * (j))
#define XB_XSUB(j)  (1280 + 64 * (j))
#define XB_XGEN(j)  (2304 + 64 * (j))
#define XB_TOP      3328
#define XB_TOPGEN   3392
#define XCD_BAR_WORDS 3456
#define XB_SPIN_CAP (1u << 18)

__device__ __forceinline__ unsigned xb_ld(unsigned* p)              { return __hip_atomic_load(p, __ATOMIC_RELAXED, __HIP_MEMORY_SCOPE_AGENT); }
__device__ __forceinline__ unsigned xb_add(unsigned* p, unsigned v) { return __hip_atomic_fetch_add(p, v, __ATOMIC_RELAXED, __HIP_MEMORY_SCOPE_AGENT); }
__device__ __forceinline__ unsigned xb_xcc_id() { return (unsigned)__builtin_amdgcn_s_getreg((3 << 11) | 20) & 0xFu; }
#define XB_SPIN(cond, bar) do { unsigned _sp = 0; while (cond) { __builtin_amdgcn_s_sleep(1); \
    if ((++_sp & 255u) == 0u) { if (xb_ld(&(bar)[XB_TMO])) break; if (_sp > XB_SPIN_CAP) { atomicAdd(&(bar)[XB_TMO], 1u); break; } } } } while (0)

struct XcdBarrier {
    unsigned* bar; unsigned x;
    volatile LAS unsigned* st;
};

__device__ __forceinline__ XcdBarrier xcd_barrier_post(unsigned* bar, volatile LAS unsigned* st) {
    XcdBarrier b; b.bar = bar; b.x = xb_xcc_id(); b.st = st;
    if (threadIdx.x == 0) (void)xb_add(&bar[XB_XCNT(b.x)], 1u);
    return b;
}
__device__ __forceinline__ void xcd_barrier_complete(unsigned* bar, unsigned x, unsigned& nloc, unsigned& nx) {
    const unsigned G = gridDim.x * gridDim.y * gridDim.z;
    unsigned sum, cnt, mine, sp = 0u;
    for (;;) {
        sum = 0u; cnt = 0u; mine = 0u;
#pragma unroll
        for (unsigned j = 0; j < 16; ++j) { const unsigned c = xb_ld(&bar[XB_XCNT(j)]); sum += c; cnt += (c > 0u) ? 1u : 0u; mine = (j == x) ? c : mine; }
        if (sum == G) break;
        __builtin_amdgcn_s_sleep(1);
        if ((++sp & 255u) == 0u) { if (xb_ld(&bar[XB_TMO])) break; if (sp > XB_SPIN_CAP) { atomicAdd(&bar[XB_TMO], 1u); break; } }
    }
    nloc = mine > 0u ? mine : 1u; nx = cnt > 0u ? cnt : 1u;
}

__device__ __forceinline__ void xcd_barrier(const XcdBarrier& b) {
    asm volatile("s_waitcnt vmcnt(0)" ::: "memory");
    __syncthreads();
    if (threadIdx.x == 0) {
        unsigned* bar = b.bar;
        __builtin_amdgcn_s_waitcnt(0);
        unsigned nloc = b.st[0], nx = b.st[1];
        if (nloc == 0u) { xcd_barrier_complete(bar, b.x, nloc, nx); b.st[0] = nloc; b.st[1] = nx; }
        const unsigned old = xb_add(&bar[XB_XSUB(b.x)], 1u);
        const unsigned gen = old / nloc;
        if (old + 1u == (gen + 1u) * nloc) {
            __builtin_amdgcn_fence(__ATOMIC_RELEASE, "agent");
            asm volatile("s_waitcnt vmcnt(0)" ::: "memory");
            const unsigned og = xb_add(&bar[XB_TOP], 1u);
            const unsigned tg = og / nx;
            if (og + 1u == (tg + 1u) * nx) xb_add(&bar[XB_TOPGEN], 1u);
            else XB_SPIN(xb_ld(&bar[XB_TOPGEN]) == tg, bar);
            __builtin_amdgcn_fence(__ATOMIC_ACQUIRE, "agent");
            xb_add(&bar[XB_XGEN(b.x)], 1u);
            asm volatile("s_waitcnt vmcnt(0)" ::: "memory");
        } else {
            XB_SPIN(xb_ld(&bar[XB_XGEN(b.x)]) == gen, bar);
            __builtin_amdgcn_fence(__ATOMIC_ACQUIRE, "agent");
            asm volatile("s_waitcnt vmcnt(0)" ::: "memory");
        }
    }
    __syncthreads();
}

struct EpiInProj {
    static constexpr bool PERM = true, AFTER_DRAIN = false;
    unsigned char* ws; float* out; bf16* sga_p; bf16* sgb_p;
    __device__ __forceinline__ void operator()(const f32x4 (&acc)[2][2][4][2], const pg8::Unit& u, int wr, int wc, int fr, int fq) const {
        const int pn = u.pn;
#pragma unroll
        for (int ai = 0; ai < 2; ++ai)
#pragma unroll
            for (int m = 0; m < 4; ++m) {
                const int row = u.pm * 256 + ai * 128 + wr * 64 + m * 16 + fr;
                const bool smp = row >= MP; const int rs = row - MP, sb = rs >> 4, st = rs & 15;
#pragma unroll
                for (int bj = 0; bj < 2; ++bj) {
                    const int c0 = pn * 256 + bj * 128 + wc * 32 + fq * 8;
                    const f32x4 v0 = acc[ai][bj][m][0], v1 = acc[ai][bj][m][1];
                    if (pn < 2) {
                        v4u o; o.x = pk2(v0.x * QSCALE, v0.y * QSCALE); o.y = pk2(v0.z * QSCALE, v0.w * QSCALE); o.z = pk2(v1.x * QSCALE, v1.y * QSCALE); o.w = pk2(v1.z * QSCALE, v1.w * QSCALE);
                        *(GAS v4u*)((bf16*)(ws + WS_QB) + (size_t)row * 512 + c0) = o;
                    } else if (pn == 2) {
                        const int c = c0 - (bj ? C_V : C_K);
                        float* of = out + (smp ? (bj ? O_NVS : O_NKS) + (size_t)rs * 128 : (bj ? O_NVP : O_NKP) + (size_t)row * 128) + c;
                        *(GAS f32x4*)of = v0; *(GAS f32x4*)(of + 4) = v1;
                        bf16* ob = smp ? (bf16*)(ws + (bj ? WS_VS : WS_KS)) + ((size_t)sb * LSP + PAST + st) * 128 + c : (bf16*)(ws + (bj ? WS_VBP : WS_KBP)) + (size_t)row * 128 + c;
                        v4u o; o.x = pk2(v0.x, v0.y); o.y = pk2(v0.z, v0.w); o.z = pk2(v1.x, v1.y); o.w = pk2(v1.z, v1.w); *(GAS v4u*)ob = o;
                    } else if (pn < 5) {
                        v4u o; o.x = pk2(v0.x * 0.125f, v0.y * 0.125f); o.y = pk2(v0.z * 0.125f, v0.w * 0.125f); o.z = pk2(v1.x * 0.125f, v1.y * 0.125f); o.w = pk2(v1.z * 0.125f, v1.w * 0.125f);
                        *(GAS v4u*)((bf16*)(ws + WS_QIB) + (size_t)row * 512 + (c0 - C_QI)) = o;
                    } else if (pn == 5) {
                        if (c0 < C_WI) {
                            const int c = c0 - C_KI;
                            float* of = out + (smp ? O_NKIS + (size_t)rs * 64 : O_NKIP + (size_t)row * 64) + c;
                            *(GAS f32x4*)of = v0; *(GAS f32x4*)(of + 4) = v1;
                            bf16* ob = smp ? (bf16*)(ws + WS_KIS) + ((size_t)sb * LSP + PAST + st) * 64 + c : (bf16*)(ws + WS_KIBP) + (size_t)row * 64 + c;
                            v4u o; o.x = pk2(v0.x, v0.y); o.y = pk2(v0.z, v0.w); o.z = pk2(v1.x, v1.y); o.w = pk2(v1.z, v1.w); *(GAS v4u*)ob = o;
                        } else if (c0 == C_WI) {
                            const float s = 0.35355339059327373f; float* of = (float*)(ws + WS_WI) + (size_t)row * 8;
                            *(GAS f32x4*)of = v0 * s; *(GAS f32x4*)(of + 4) = v1 * s;
                        }
                    } else if (pn < 13) {
                        const int c = c0 - C_P;
                        v4u o; o.x = pk2(v0.x, v0.y); o.y = pk2(v0.z, v0.w); o.z = pk2(v1.x, v1.y); o.w = pk2(v1.z, v1.w);
                        *(GAS v4u*)((bf16*)(ws + WS_P) + (size_t)row * RWC + c) = o;
                        const bool last = smp ? (st == DSEQ - 1) : ((row & (SEQ - 1)) == SEQ - 1);
                        if (last) { float* of = out + (smp ? O_SHS + (size_t)sb * RWC : O_SHP + (size_t)(row >> 11) * RWC) + c; *(GAS f32x4*)of = v0; *(GAS f32x4*)(of + 4) = v1; }
                    } else {
                        const bool isb = pn >= 17; const int c = c0 - (isb ? C_GB : C_GA);
                        v4u o; o.x = pk2(sigmoidf_(v0.x), sigmoidf_(v0.y)); o.y = pk2(sigmoidf_(v0.z), sigmoidf_(v0.w)); o.z = pk2(sigmoidf_(v1.x), sigmoidf_(v1.y)); o.w = pk2(sigmoidf_(v1.z), sigmoidf_(v1.w));
                        bf16* ob = smp ? (bf16*)(ws + WS_SGS) + (size_t)(isb ? MS : 0) * DM + (size_t)rs * DM + c : (isb ? sgb_p : sga_p) + (size_t)row * DM + c;
                        *(GAS v4u*)ob = o;
                    }
                }
            }
    }
};
template <bool ACCUM> struct EpiGate {
    static constexpr bool PERM = true, AFTER_DRAIN = false;
    const bf16* sg_p; const bf16* sg_s; bf16* mix;
    __device__ __forceinline__ void operator()(const f32x4 (&acc)[2][2][4][2], const pg8::Unit& u, int wr, int wc, int fr, int fq) const {
#pragma unroll
        for (int ai = 0; ai < 2; ++ai)
#pragma unroll
            for (int m = 0; m < 4; ++m) {
                const int row = u.pm * 256 + ai * 128 + wr * 64 + m * 16 + fr; const bool smp = row >= MP;
#pragma unroll
                for (int bj = 0; bj < 2; ++bj) {
                    const int c0 = u.pn * 256 + bj * 128 + wc * 32 + fq * 8;
                    const v4u g = *(const GAS v4u*)((smp ? sg_s + (size_t)(row - MP) * DM : sg_p + (size_t)row * DM) + c0);
                    f32x4 v0 = acc[ai][bj][m][0], v1 = acc[ai][bj][m][1];
                    v0.x *= bflo(g.x); v0.y *= bfhi(g.x); v0.z *= bflo(g.y); v0.w *= bfhi(g.y); v1.x *= bflo(g.z); v1.y *= bfhi(g.z); v1.z *= bflo(g.w); v1.w *= bfhi(g.w);
                    bf16* op = mix + (size_t)row * DM + c0;
                    if (ACCUM) { const v4u p = *(const GAS v4u*)op; v0.x += bflo(p.x); v0.y += bfhi(p.x); v0.z += bflo(p.y); v0.w += bfhi(p.y); v1.x += bflo(p.z); v1.y += bfhi(p.z); v1.z += bflo(p.w); v1.w += bfhi(p.w); }
                    v4u o; o.x = pk2(v0.x, v0.y); o.y = pk2(v0.z, v0.w); o.z = pk2(v1.x, v1.y); o.w = pk2(v1.z, v1.w); *(GAS v4u*)op = o;
                }
            }
    }
};
struct EpiResid {
    static constexpr bool PERM = false, AFTER_DRAIN = false;
    const float* src_p; const float* src_s; float* dst_p; float* dst_s;
    __device__ __forceinline__ void operator()(const f32x4 (&acc)[2][2][4][2], const pg8::Unit& u, int wr, int wc, int fr, int fq) const {
#pragma unroll
        for (int ai = 0; ai < 2; ++ai)
#pragma unroll
            for (int m = 0; m < 4; ++m) {
                const int row = u.pm * 256 + ai * 128 + wr * 64 + m * 16 + fr; const bool smp = row >= MP;
                const float* s = smp ? src_s + (size_t)(row - MP) * DM : src_p + (size_t)row * DM; float* d = smp ? dst_s + (size_t)(row - MP) * DM : dst_p + (size_t)row * DM;
#pragma unroll
                for (int bj = 0; bj < 2; ++bj)
#pragma unroll
                    for (int n = 0; n < 2; ++n) { const int c = u.pn * 256 + bj * 128 + wc * 32 + n * 16 + fq * 4; *(GAS f32x4*)(d + c) = *(const GAS f32x4*)(s + c) + acc[ai][bj][m][n]; }
            }
    }
};
struct EpiRelu2 {
    static constexpr bool PERM = true, AFTER_DRAIN = false;
    bf16* O;
    __device__ __forceinline__ void operator()(const f32x4 (&acc)[2][2][4][2], const pg8::Unit& u, int wr, int wc, int fr, int fq) const {
#pragma unroll
        for (int ai = 0; ai < 2; ++ai)
#pragma unroll
            for (int m = 0; m < 4; ++m) {
                const int row = u.pm * 256 + ai * 128 + wr * 64 + m * 16 + fr;
#pragma unroll
                for (int bj = 0; bj < 2; ++bj) {
                    const int c0 = u.pn * 256 + bj * 128 + wc * 32 + fq * 8;
                    f32x4 v0 = acc[ai][bj][m][0], v1 = acc[ai][bj][m][1];
                    v0 = __builtin_elementwise_max(v0, (f32x4){0.f, 0.f, 0.f, 0.f}); v1 = __builtin_elementwise_max(v1, (f32x4){0.f, 0.f, 0.f, 0.f}); v0 = v0 * v0; v1 = v1 * v1;
                    v4u o; o.x = pk2(v0.x, v0.y); o.y = pk2(v0.z, v0.w); o.z = pk2(v1.x, v1.y); o.w = pk2(v1.z, v1.w); *(GAS v4u*)(O + (size_t)row * DFF + c0) = o;
                }
            }
    }
};

__device__ __forceinline__ void rms_row_to_f32(int lane, const float* xrow, const float* g, float* orow) {
    const GAS f32x4* xr = (const GAS f32x4*)xrow + lane; const GAS f32x4* gr = (const GAS f32x4*)g + lane;
    f32x4 v[4]; float s = 0.f;
#pragma unroll
    for (int j = 0; j < 4; ++j) { v[j] = xr[64 * j]; s += (v[j].x * v[j].x + v[j].y * v[j].y) + (v[j].z * v[j].z + v[j].w * v[j].w); }
    const float rstd = 1.0f / sqrtf(wave_sum(s) * (1.f / DM) + NORM_EPS);
    GAS f32x4* o = (GAS f32x4*)orow + lane;
#pragma unroll
    for (int j = 0; j < 4; ++j) { const f32x4 gg = gr[64 * j]; o[64 * j] = v[j] * rstd * gg; }
}
#define PHASE6 { pg8::StaticOrder S; S.init(MT_ROWS, DM, F.G, (int)blockIdx.x); \
    { pg8::Gemm g{(const bf16*)(ws + WS_ATT), (const bf16*)(ws + WS_WT_AB), MT_ROWS, DM, 512}; EpiGate<false> E{sga_p, (const bf16*)(ws + WS_SGS), (bf16*)(ws + WS_MIX)}; \
      pg8::gemm_phase<EpiGate<false>, pg8::StaticOrder, true, true>(F.lds, g, S, E); } \
    { pg8::Gemm g{(const bf16*)(ws + WS_RW), (const bf16*)(ws + WS_WT_AB + MiB), MT_ROWS, DM, 512}; EpiGate<true> E{sgb_p, (const bf16*)(ws + WS_SGS) + (size_t)MS * DM, (bf16*)(ws + WS_MIX)}; \
      pg8::gemm_phase<EpiGate<true>, pg8::StaticOrder, true, true>(F.lds, g, S, E); } }
#define PHASE7 { pg8::StaticOrder S; S.init(MT_ROWS, DM, F.G, (int)blockIdx.x); pg8::Gemm g{(const bf16*)(ws + WS_MIX), (const bf16*)(ws + WS_WT_OUT), MT_ROWS, DM, DM}; \
    EpiResid E{args.in[0], args.in[1], args.out + O_YP, (float*)(ws + WS_X1S)}; pg8::gemm_phase<EpiResid, pg8::StaticOrder, true, true>(F.lds, g, S, E); }
#define PHASE8 { const int gw = F.vcu * NWAVES + F.wave, NGW = F.G * NWAVES; \
    for (int m = gw; m < MT_ROWS; m += NGW) { const float* xr = (m < MP) ? args.out + O_YP + (size_t)m * DM : (const float*)(ws + WS_X1S) + (size_t)(m - MP) * DM; rms_row_to_bf16(F.lane, xr, args.in[24], (bf16*)(ws + WS_H2) + (size_t)m * DM); } }
#define PHASE9 { pg8::StaticOrder S; S.init(MT_ROWS, DFF, F.G, (int)blockIdx.x); pg8::Gemm g{(const bf16*)(ws + WS_H2), (const bf16*)(ws + WS_WT_FF1), MT_ROWS, DFF, DM}; \
    EpiRelu2 E{(bf16*)(ws + WS_HFF)}; pg8::gemm_phase<EpiRelu2, pg8::StaticOrder, true, true>(F.lds, g, S, E); }
#define PHASE10 { pg8::StaticOrder S; S.init(MT_ROWS, DM, F.G, (int)blockIdx.x); pg8::Gemm g{(const bf16*)(ws + WS_HFF), (const bf16*)(ws + WS_WT_FF2), MT_ROWS, DM, DFF}; \
    EpiResid E{args.out + O_YP, (const float*)(ws + WS_X1S), args.out + O_YP, (float*)(ws + WS_X1S)}; pg8::gemm_phase<EpiResid, pg8::StaticOrder, true, true>(F.lds, g, S, E); }
#define PHASE11 { const int gw = F.vcu * NWAVES + F.wave, NGW = F.G * NWAVES; \
    for (int m = gw; m < MT_ROWS; m += NGW) { const float* xr = (m < MP) ? args.out + O_YP + (size_t)m * DM : (const float*)(ws + WS_X1S) + (size_t)(m - MP) * DM; \
        float* yr = (m < MP) ? args.out + O_YP + (size_t)m * DM : args.out + O_YS + (size_t)(m - MP) * DM; rms_row_to_f32(F.lane, xr, args.in[27], yr); } }

__device__ __forceinline__ int t5_bucket(int rel) {
    const int n = rel < 0 ? -rel : rel; int r = rel > 0 ? 16 : 0;
    if (n < 8) return r + n;
    return r + 8 + (n >= 12) + (n >= 16) + (n >= 23) + (n >= 32) + (n >= 46) + (n >= 64) + (n >= 91);
}
__device__ __forceinline__ unsigned ordkey(float f) { const unsigned u = __builtin_bit_cast(unsigned, f); return (u & 0x80000000u) ? ~u : (u | 0x80000000u); }

__device__ __forceinline__ void nv_attn_phase(Frame& F, const Args& a) {
    struct Sh { float qi[512]; float q[512]; float wi[8]; unsigned key[LSP]; unsigned char sel[LSP]; float lg[LSP]; unsigned cnt; float red[256]; float o[4][64]; };
    const int half = F.tid >> 8, tid = F.tid & 255;
    LAS Sh* sh = (LAS Sh*)(F.lds + half * 32768);
    unsigned char* ws = a.ws; const float* relb = a.in[7];
    for (int pr = blockIdx.x; pr < MT_ROWS / 2; pr += F.G) {
        const int m = 2 * pr + half;
        const bool smp = m >= MP; const int b = smp ? (m - MP) >> 4 : m >> 11, t = smp ? (m - MP) & 15 : m & 2047;
        const int qpos = smp ? PAST + t : t; const int n = smp ? LS : 64 * (t / 64 + 1);
        const bf16* Ki = smp ? (const bf16*)(ws + WS_KIS) + (size_t)b * LSP * 64 : (const bf16*)(ws + WS_KIBP) + (size_t)b * SEQ * 64;
        const bf16* Kb = smp ? (const bf16*)(ws + WS_KS) + (size_t)b * LSP * 128 : (const bf16*)(ws + WS_KBP) + (size_t)b * SEQ * 128;
        const bf16* Vb = smp ? (const bf16*)(ws + WS_VS) + (size_t)b * LSP * 128 : (const bf16*)(ws + WS_VBP) + (size_t)b * SEQ * 128;
        __syncthreads();
        for (int i = tid; i < 512; i += 256) { sh->qi[i] = bf2f(((const bf16*)(ws + WS_QIB))[(size_t)m * 512 + i]); sh->q[i] = bf2f(((const bf16*)(ws + WS_QB))[(size_t)m * 512 + i]); }
        if (tid < 8) sh->wi[tid] = ((const float*)(ws + WS_WI))[(size_t)m * 8 + tid];
        __syncthreads();
        for (int s = tid; s < n; s += 256) {
            float kd[64];
#pragma unroll
            for (int d = 0; d < 64; ++d) kd[d] = bf2f(Ki[(size_t)s * 64 + d]);
            float sc = 0.f;
            for (int h = 0; h < 8; ++h) { float dot = 0.f;
#pragma unroll
                for (int d = 0; d < 64; ++d) dot = fmaf(sh->qi[h * 64 + d], kd[d], dot);
                sc = fmaf(sh->wi[h], fmaxf(dot, 0.f), sc); }
            sh->key[s] = ordkey(sc); sh->sel[s] = 1;
        }
        __syncthreads();
        if (n > 256) {
            unsigned prefix = 0u;
            for (int bit = 31; bit >= 0; --bit) {
                const unsigned cand = prefix | (1u << bit);
                if (tid == 0) sh->cnt = 0u;
                __syncthreads();
                unsigned c = 0; for (int s = tid; s < n; s += 256) c += sh->key[s] >= cand;
                atomicAdd((unsigned*)&sh->cnt, c);
                __syncthreads();
                if (sh->cnt >= 256u) prefix = cand;
                __syncthreads();
            }
            if (tid == 0) { int gt = 0; for (int s = 0; s < n; ++s) gt += sh->key[s] > prefix; int need = 256 - gt;
                for (int s = 0; s < n; ++s) { const unsigned k = sh->key[s]; unsigned char v = 0; if (k > prefix) v = 1; else if (k == prefix && need > 0) { v = 1; --need; } sh->sel[s] = v; } }
            __syncthreads();
        }
        for (int h = 0; h < 8; ++h) {
            const int j = h >> 2; float mx = -3.0e38f;
            for (int s = tid; s < n; s += 256) { float lg = -3.0e38f;
                if (sh->sel[s]) { float dot = 0.f;
#pragma unroll 8
                    for (int d = 0; d < 64; ++d) dot = fmaf(sh->q[h * 64 + d], bf2f(Kb[(size_t)s * 128 + j * 64 + d]), dot);
                    lg = dot + relb[t5_bucket(s - qpos) * 8 + h] * 1.4426950408889634f; }
                sh->lg[s] = lg; mx = fmaxf(mx, lg); }
            sh->red[tid] = mx; __syncthreads();
            for (int o = 128; o > 0; o >>= 1) { if (tid < o) sh->red[tid] = fmaxf(sh->red[tid], sh->red[tid + o]); __syncthreads(); }
            mx = sh->red[0]; __syncthreads();
            float sum = 0.f;
            for (int s = tid; s < n; s += 256) { const float p = sh->sel[s] ? exp2f(sh->lg[s] - mx) : 0.f; sh->lg[s] = p; sum += p; }
            sh->red[tid] = sum; __syncthreads();
            for (int o = 128; o > 0; o >>= 1) { if (tid < o) sh->red[tid] += sh->red[tid + o]; __syncthreads(); }
            sum = sh->red[0]; __syncthreads();
            const int d = tid & 63, grp = tid >> 6; float acc = 0.f;
            for (int s = grp; s < n; s += 4) { const float p = sh->lg[s]; if (p != 0.f) acc = fmaf(p, bf2f(Vb[(size_t)s * 128 + j * 64 + d]), acc); }
            sh->o[grp][d] = acc; __syncthreads();
            if (tid < 64) ((bf16*)(ws + WS_ATT))[(size_t)m * 512 + h * 64 + tid] = (bf16)f2bf((sh->o[0][tid] + sh->o[1][tid] + sh->o[2][tid] + sh->o[3][tid]) / sum);
            __syncthreads();
        }
    }
}

struct RwTok { float r, k, v, decay, a, g, kk, kh, b, bonus; };
__device__ __forceinline__ RwTok rw_token_prep(const Args& a, int m, int c, LAS float* xs  , LAS float* red  ) {
    unsigned char* ws = a.ws; const bf16* P = (const bf16*)(ws + WS_P);
    const bool smp = m >= MP; const int b = smp ? (m - MP) >> 4 : m >> 11, t = smp ? (m - MP) & 15 : m & 2047;
    const float* mu = a.in[11];
    __syncthreads();
    for (int col = c; col < RWC; col += 512) { const float p = bf2f(P[(size_t)m * RWC + col]); const float pv = (t > 0) ? bf2f(P[(size_t)(m - 1) * RWC + col]) : (smp ? a.in[6][(size_t)b * RWC + col] : 0.f);
        xs[col] = p + (pv - p) * mu[col]; }
    __syncthreads();
    RwTok o; o.r = xs[c]; o.k = xs[512 + c]; o.v = xs[1024 + c];
    float wl = a.in[12][c], al = a.in[14][c], g = 0.f;
#pragma unroll 2
    for (int mm = 0; mm < 64; ++mm) { wl = fmaf(tanhf(xs[1536 + mm]), a.in[13][mm * 512 + c], wl); al = fmaf(xs[1600 + mm], a.in[15][mm * 512 + c], al); }
#pragma unroll 4
    for (int mm = 0; mm < 128; ++mm) g = fmaf(sigmoidf_(xs[1664 + mm]), a.in[16][mm * 512 + c], g);
    const float sp = (-wl > 20.f) ? -wl : log1pf(__expf(-wl));
    const float w = -sp - 0.5f; o.decay = __expf(-__expf(w)); o.a = sigmoidf_(al); o.g = g;
    const float kkr = o.k * a.in[17][c];
    red[c] = kkr * kkr; __syncthreads();
    float ss = 0.f;
#pragma unroll 8
    for (int j = 0; j < 64; ++j) ss += red[(c & ~63) + j];
    __syncthreads();
    o.kk = kkr / fmaxf(sqrtf(ss), 1e-12f);
    o.kh = o.k * (1.0f + (o.a - 1.0f) * a.in[18][c]); o.b = o.kk * o.a;
    red[c] = o.r * o.kh * a.in[19][c]; __syncthreads();
    float bs = 0.f;
#pragma unroll 8
    for (int j = 0; j < 64; ++j) bs += red[(c & ~63) + j];
    __syncthreads();
    o.bonus = bs * o.v;
    return o;
}
constexpr size_t WS_NR = 124 * MiB, WS_NKH = 141 * MiB, WS_NV = 158 * MiB, WS_NKK = 175 * MiB, WS_NB = 192 * MiB, WS_NDEC = 33 * MiB;
__device__ __forceinline__ void nv_rw_prep_phase(Frame& F, const Args& a) {
    LAS float* xs = (LAS float*)F.lds; LAS float* red = xs + RWC; unsigned char* ws = a.ws; const int c = F.tid;
    for (int m = blockIdx.x; m < MT_ROWS; m += F.G) {
        const RwTok o = rw_token_prep(a, m, c, xs, red); const size_t i = (size_t)m * 512 + c;
        ((bf16*)(ws + WS_NR))[i] = (bf16)f2bf(o.r); ((bf16*)(ws + WS_NKH))[i] = (bf16)f2bf(o.kh); ((bf16*)(ws + WS_NV))[i] = (bf16)f2bf(o.v);
        ((bf16*)(ws + WS_NKK))[i] = (bf16)f2bf(o.kk); ((bf16*)(ws + WS_NB))[i] = (bf16)f2bf(o.b); ((float*)(ws + WS_NDEC))[i] = o.decay;
    }
}
__device__ __forceinline__ void nv_rw_scan_phase(Frame& F, const Args& a) {
    const int chain = (int)blockIdx.x + 256 * F.wave;
    if (F.wave < 2 && chain < 320) {
    LAS float* vec = (LAS float*)F.lds + F.wave * 320;
    unsigned char* ws = a.ws; const int i = F.lane;
    const bool smp = chain >= 64; const int b = smp ? (chain - 64) >> 3 : chain >> 3, h = chain & 7; const int T = smp ? DSEQ : SEQ; const size_t m0 = smp ? MP + (size_t)b * DSEQ : (size_t)b * SEQ;
    float S[64];
    { const float* s0 = a.in[5] + (((unsigned)(smp ? b : 0) * 8 + h) * 64 + i) * 64; const float msk = smp ? 1.f : 0.f;
#pragma unroll
      for (int j = 0; j < 64; j += 4) { const f32x4 x = *(const GAS f32x4*)(s0 + j); S[j] = x.x * msk; S[j + 1] = x.y * msk; S[j + 2] = x.z * msk; S[j + 3] = x.w * msk; } }
    const bf16* pKK = (const bf16*)(ws + WS_NKK); const bf16* pB = (const bf16*)(ws + WS_NB); const bf16* pKH = (const bf16*)(ws + WS_NKH); const bf16* pR = (const bf16*)(ws + WS_NR); const bf16* pV = (const bf16*)(ws + WS_NV);
    const float* pD = (const float*)(ws + WS_NDEC); bf16* pY = (bf16*)(ws + WS_RW);
#pragma unroll 1
    for (int t = 0; t < T; ++t) {
        const unsigned idx = ((unsigned)m0 + (unsigned)t) * 512u + (unsigned)(h * 64 + i);
        vec[0 * 64 + i] = bf2f(pKK[idx]); vec[1 * 64 + i] = pD[idx]; vec[2 * 64 + i] = bf2f(pB[idx]);
        vec[3 * 64 + i] = bf2f(pKH[idx]); vec[4 * 64 + i] = bf2f(pR[idx]);
        const float v = bf2f(pV[idx]);
        LDS_WAIT(); __builtin_amdgcn_wave_barrier();
        float sa = 0.f;
#pragma unroll
        for (int j = 0; j < 64; ++j) { sa = fmaf(S[j], vec[j], sa); if ((j & 7) == 7) __builtin_amdgcn_sched_barrier(0); }
        float y = 0.f;
#pragma unroll
        for (int j = 0; j < 64; ++j) { S[j] = S[j] * vec[64 + j] - sa * vec[128 + j] + v * vec[192 + j]; y = fmaf(S[j], vec[256 + j], y); if ((j & 3) == 3) __builtin_amdgcn_sched_barrier(0); }
        pY[idx] = (bf16)f2bf(y);
        LDS_WAIT(); __builtin_amdgcn_wave_barrier();
    }
    float* o = a.out + (smp ? O_WKVS : O_WKVP) + (((unsigned)b * 8 + h) * 64 + i) * 64;
#pragma unroll
    for (int j = 0; j < 64; j += 4) *(GAS f32x4*)(o + j) = (f32x4){S[j], S[j + 1], S[j + 2], S[j + 3]};
    }
}
__device__ __forceinline__ void nv_rw_post_phase(Frame& F, const Args& a) {
    LAS float* xs = (LAS float*)F.lds; LAS float* red = xs + RWC; const int c = F.tid;
    for (int m = blockIdx.x; m < MT_ROWS; m += F.G) {
        const RwTok o = rw_token_prep(a, m, c, xs, red);
        const float y = bf2f(((const bf16*)(a.ws + WS_RW))[(size_t)m * 512 + c]);
        red[c] = y; __syncthreads();
        float s = 0.f;
#pragma unroll 8
        for (int j = 0; j < 64; ++j) s += red[(c & ~63) + j];
        __syncthreads();
        const float mean = s * (1.f / 64.f), dv = y - mean;
        red[c] = dv * dv; __syncthreads();
        float q = 0.f;
#pragma unroll 8
        for (int j = 0; j < 64; ++j) q += red[(c & ~63) + j];
        const float yn = dv * (1.0f / sqrtf(q * (1.f / 64.f) + 64e-5f)) * a.in[20][c] + a.in[21][c];
        ((bf16*)(a.ws + WS_RW))[(size_t)m * 512 + c] = (bf16)f2bf((yn + o.bonus) * o.g);
    }
}

namespace att {
constexpr int SC_RS = 2116;
constexpr int L_SC = 0;
constexpr int KROW = 272, KBUF = 64 * KROW, VROW = 320, VBUF = 64 * VROW;
constexpr int L_K = 0, L_V = 2 * KBUF, L_OST = L_V + 2 * VBUF;
constexpr int L_MSK = 135424;
constexpr int L_BIAS = L_MSK + 32 * 33 * 8;
constexpr int L_WS = L_BIAS + 8192;
constexpr int L_Q = L_WS + 2048;
static_assert(L_OST + 8 * 4096 <= L_MSK && L_Q + 16 <= MISC_OFF, "attention LDS map");
constexpr int N_UNITS = 512 + 32;
constexpr float NEGL = -1.0e30f;
constexpr float LOG2E = 1.4426950408889634f;
__device__ __forceinline__ int crow(int r, int hi) { return (r & 3) + 8 * (r >> 2) + 4 * hi; }
typedef short v4i16_t __attribute__((ext_vector_type(4)));
__device__ __forceinline__ s16x4 vtr(LAS const unsigned char* p) { return __builtin_bit_cast(s16x4, __builtin_amdgcn_ds_read_tr16_b64_v4i16((LAS v4i16_t*)p)); }

__device__ __forceinline__ void f1_subblock(Frame& F, const bf16* Qi_rows, const float* wi_rows, const bf16* Ki, int n, int nt, int qslot0) {
    const int lane = F.lane, fr = lane & 15, fq = lane >> 4;
    {
        bf16x8 qb[8][2];
#pragma unroll
        for (int h = 0; h < 8; ++h)
#pragma unroll
            for (int ks = 0; ks < 2; ++ks) qb[h][ks] = *(const GAS bf16x8*)(Qi_rows + fr * 512 + h * 64 + 32 * ks + 8 * fq);
        const f32x4 w0 = *(const GAS f32x4*)(wi_rows + fr * 8), w1 = *(const GAS f32x4*)(wi_rows + fr * 8 + 4);
        const float wv[8] = {w0.x, w0.y, w0.z, w0.w, w1.x, w1.y, w1.z, w1.w};
        const int nkb = (n + 15) >> 4;
        for (int kb = F.wave; kb < nkb; kb += NWAVES) {
            const bf16* kp = Ki + (size_t)(16 * kb + fr) * 64 + 8 * fq;
            const bf16x8 a0 = *(const GAS bf16x8*)kp, a1 = *(const GAS bf16x8*)(kp + 32);
            f32x4 sc = {0.f, 0.f, 0.f, 0.f};
#pragma unroll
            for (int h = 0; h < 8; ++h) {
                f32x4 acc = __builtin_amdgcn_mfma_f32_16x16x32_bf16(a0, qb[h][0], (f32x4){0.f, 0.f, 0.f, 0.f}, 0, 0, 0);
                acc = __builtin_amdgcn_mfma_f32_16x16x32_bf16(a1, qb[h][1], acc, 0, 0, 0);
#pragma unroll
                for (int r = 0; r < 4; ++r) sc[r] = fmaf(wv[h], fmaxf(acc[r], 0.f), sc[r]);
            }
            *(LAS f32x4*)(F.lds + L_SC + (fr * SC_RS + 16 * kb + 4 * fq) * 4) = sc;
        }
    }
    __syncthreads();
#pragma unroll 1
    for (int qq = 0; qq < 2; ++qq) {
        const int q = 2 * F.wave + qq;
        unsigned key[33];
#pragma unroll
        for (int r = 0; r < 33; ++r) { const int s = 64 * r + lane; key[r] = (r < nt && s < n) ? ordkey(*(LAS const float*)(F.lds + L_SC + (q * SC_RS + s) * 4)) : 0u; }
        unsigned prefix = 0u; bool early = false;
#pragma unroll 1
        for (int bit = 31; bit >= 0; --bit) {
            const unsigned cand = prefix | (1u << bit); int cnt = 0;
#pragma unroll
            for (int r = 0; r < 33; ++r) cnt += __popcll(__ballot(key[r] >= cand));
            if (cnt >= 256) prefix = cand;
            if (cnt == 256) { early = true; break; }
        }
        LAS unsigned long long* mrow = (LAS unsigned long long*)(F.lds + L_MSK) + (qslot0 + q) * 33;
        if (early) {
#pragma unroll
            for (int r = 0; r < 33; ++r) { const unsigned long long sel = __ballot(key[r] >= prefix); if (lane == 0) mrow[r] = sel; }
        } else {
            int gt = 0;
#pragma unroll
            for (int r = 0; r < 33; ++r) gt += __popcll(__ballot(key[r] > prefix));
            int need = 256 - gt;
#pragma unroll
            for (int r = 0; r < 33; ++r) {
                const bool iseq = key[r] == prefix; const unsigned long long eq = __ballot(iseq), gtm = __ballot(key[r] > prefix);
                const int rank = __popcll(eq & ((1ull << lane) - 1ull));
                const unsigned long long take = __ballot(iseq && rank < need);
                need -= __popcll(take);
                if (lane == 0) mrow[r] = gtm | take;
            }
        }
    }
}

__device__ __forceinline__ void f2_unit(Frame& F, const float* relb, const bf16* Qrows, int nqmask, const bf16* Kg, const bf16* Vg, int ntiles, int qpos0, int near_from, bool allsel, bf16* Orows, int nq_store) {
    const int lane = F.lane, h = F.wave, jk = h >> 2, qcol = lane & 31, hi = lane >> 5, qi = qcol & nqmask, tid = F.tid;
    bf16x8 qf[4];
#pragma unroll
    for (int ks = 0; ks < 4; ++ks) qf[ks] = *(const GAS bf16x8*)(Qrows + qi * 512 + h * 64 + 16 * ks + 8 * hi);
    const int prow0 = tid >> 4, pseg = tid & 15;
    v4u stK[2], stV[2];
#define ATT_LOAD(kt_) do { _Pragma("unroll") for (int i_ = 0; i_ < 2; ++i_) { const size_t off_ = (size_t)(64 * (kt_) + prow0 + 32 * i_) * 128 + pseg * 8; \
        stK[i_] = *(const GAS v4u*)(Kg + off_); stV[i_] = *(const GAS v4u*)(Vg + off_); } } while (0)
#define ATT_WRITE(buf_) do { _Pragma("unroll") for (int i_ = 0; i_ < 2; ++i_) { const int row_ = prow0 + 32 * i_; \
        *(LAS v4u*)(F.lds + L_K + (buf_) * KBUF + row_ * KROW + pseg * 16) = stK[i_]; *(LAS v4u*)(F.lds + L_V + (buf_) * VBUF + row_ * VROW + pseg * 16) = stV[i_]; } } while (0)
    ATT_LOAD(0); ATT_WRITE(0);
    __syncthreads();
    f32x16 o[2]; o[0] = (f32x16){}; o[1] = (f32x16){};
    float m = NEGL, l = 0.f;
    const float bconst = relb[15 * 8 + h] * LOG2E;
    LAS float* wsf = (LAS float*)(F.lds + L_WS) + F.wave * 64;
    const LAS float* biasl = (const LAS float*)(F.lds + L_BIAS) + h * 256;
    const LAS unsigned long long* mrow = (const LAS unsigned long long*)(F.lds + L_MSK) + qi * 33;
    const int koff = (lane & 31) * KROW + jk * 128 + 16 * hi;
    const int voff = (4 * hi + ((lane & 15) >> 2)) * VROW + jk * 128 + (16 * ((lane >> 4) & 1) + 4 * (lane & 3)) * 2;
#pragma unroll 1
    for (int kt = 0; kt < ntiles; ++kt) {
        const int cur = kt & 1;
        if (kt + 1 < ntiles) ATT_LOAD(kt + 1);
        const bool near = kt >= near_from;
        const float cinit = near ? 0.f : bconst;
        f32x16 p0, p1;
#pragma unroll
        for (int r = 0; r < 16; ++r) { p0[r] = cinit; p1[r] = cinit; }
        const LAS unsigned char* kb_ = F.lds + L_K + cur * KBUF + koff;
#pragma unroll
        for (int ks = 0; ks < 4; ++ks) {
            const bf16x8 a0 = *(const LAS bf16x8*)(kb_ + 32 * ks), a1 = *(const LAS bf16x8*)(kb_ + 32 * KROW + 32 * ks);
            p0 = __builtin_amdgcn_mfma_f32_32x32x16_bf16(a0, qf[ks], p0, 0, 0, 0);
            p1 = __builtin_amdgcn_mfma_f32_32x32x16_bf16(a1, qf[ks], p1, 0, 0, 0);
        }
        if (near) {
            const int rb = 64 * kt - (qpos0 + qi) + 191;
#pragma unroll
            for (int r = 0; r < 16; ++r) { const int k0 = crow(r, hi); p0[r] += biasl[rb + k0]; p1[r] += biasl[rb + k0 + 32]; }
        }
        if (!allsel) {
            const unsigned long long mw = mrow[kt]; const unsigned mlo = (unsigned)mw >> (4 * hi), mhi = (unsigned)(mw >> 32) >> (4 * hi);
#pragma unroll
            for (int r = 0; r < 16; ++r) { const int sh = (r & 3) + 8 * (r >> 2); p0[r] = ((mlo >> sh) & 1u) ? p0[r] : NEGL; p1[r] = ((mhi >> sh) & 1u) ? p1[r] : NEGL; }
        }
        float mx = fmaxf(p0[0], p1[0]);
#pragma unroll
        for (int r = 1; r < 16; ++r) mx = fmaxf(mx, fmaxf(p0[r], p1[r]));
        mx = fmaxf(mx, __shfl_xor(mx, 32));
        const float mnew = fmaxf(m, mx), alpha = __builtin_amdgcn_exp2f(m - mnew); m = mnew;
        float rs = 0.f;
#pragma unroll
        for (int r = 0; r < 16; ++r) { p0[r] = __builtin_amdgcn_exp2f(p0[r] - mnew); p1[r] = __builtin_amdgcn_exp2f(p1[r] - mnew); rs += p0[r] + p1[r]; }
        rs += __shfl_xor(rs, 32);
        l = l * alpha + rs;
        if (hi == 0) wsf[qcol] = alpha;
        LDS_WAIT(); __builtin_amdgcn_wave_barrier();
#pragma unroll
        for (int r = 0; r < 16; ++r) { const float al = wsf[crow(r, hi)]; o[0][r] *= al; o[1][r] *= al; }
        bf16x8 pa[2][2];
#pragma unroll
        for (int s = 0; s < 2; ++s) {
            v4u w0, w1;
            w0.x = pk2(p0[8 * s + 0], p0[8 * s + 1]); w0.y = pk2(p0[8 * s + 2], p0[8 * s + 3]); w0.z = pk2(p0[8 * s + 4], p0[8 * s + 5]); w0.w = pk2(p0[8 * s + 6], p0[8 * s + 7]);
            w1.x = pk2(p1[8 * s + 0], p1[8 * s + 1]); w1.y = pk2(p1[8 * s + 2], p1[8 * s + 3]); w1.z = pk2(p1[8 * s + 4], p1[8 * s + 5]); w1.w = pk2(p1[8 * s + 6], p1[8 * s + 7]);
            pa[0][s] = __builtin_bit_cast(bf16x8, w0); pa[1][s] = __builtin_bit_cast(bf16x8, w1);
        }
        const LAS unsigned char* vb_ = F.lds + L_V + cur * VBUF + voff;
#pragma unroll
        for (int db = 0; db < 2; ++db)
#pragma unroll
            for (int kb = 0; kb < 2; ++kb)
#pragma unroll
                for (int s = 0; s < 2; ++s) {
                    const LAS unsigned char* vp = vb_ + (32 * kb + 16 * s) * VROW + 64 * db;
                    const s16x4 lo = vtr(vp), hh = vtr(vp + 8 * VROW);
                    const bf16x8 vf = (bf16x8){lo[0], lo[1], lo[2], lo[3], hh[0], hh[1], hh[2], hh[3]};
                    o[db] = __builtin_amdgcn_mfma_f32_32x32x16_bf16(pa[kb][s], vf, o[db], 0, 0, 0);
                }
        if (kt + 1 < ntiles) ATT_WRITE(cur ^ 1);
        __syncthreads();
    }
#undef ATT_LOAD
#undef ATT_WRITE
    if (hi == 0) wsf[32 + qcol] = 1.0f / l;
    LDS_WAIT(); __builtin_amdgcn_wave_barrier();
    LAS bf16* stg = (LAS bf16*)(F.lds + L_OST) + F.wave * 2048;
#pragma unroll
    for (int r = 0; r < 16; ++r) { const int orow = crow(r, hi); const float li = wsf[32 + orow];
        stg[orow * 64 + qcol] = (bf16)f2bf(o[0][r] * li); stg[orow * 64 + 32 + qcol] = (bf16)f2bf(o[1][r] * li); }
    LDS_WAIT(); __builtin_amdgcn_wave_barrier();
#pragma unroll
    for (int i = 0; i < 4; ++i) { const int row = i * 8 + (lane >> 3), ch = lane & 7; const v4u v = *(const LAS v4u*)(stg + row * 64 + ch * 8);
        if (row < nq_store) *(GAS v4u*)(Orows + (size_t)row * 512 + h * 64 + ch * 8) = v; }
}

__device__ __forceinline__ void attn_phase(Frame& F, const Args& a) {
    unsigned char* ws = a.ws; const float* relb = a.in[7];
    for (int e = F.tid; e < 8 * 256; e += NTHREADS) { const int h = e >> 8, idx = e & 255; ((LAS float*)(F.lds + L_BIAS))[e] = relb[t5_bucket(idx - 191) * 8 + h] * LOG2E; }
    unsigned* qhead = (unsigned*)(ws + WS_CTL) + CW_QUEUE;
    for (;;) {
        __syncthreads();
        if (F.tid == 0) *(LAS unsigned*)(F.lds + L_Q) = atomicAdd(qhead, 1u);
        __syncthreads();
        const int u = (int)*(LAS volatile unsigned*)(F.lds + L_Q);
        if (u >= N_UNITS) break;
        if (u < 32) {
            const int b = u; const size_t m0 = MP + (size_t)b * DSEQ;
            f1_subblock(F, (const bf16*)(ws + WS_QIB) + m0 * 512, (const float*)(ws + WS_WI) + m0 * 8, (const bf16*)(ws + WS_KIS) + (size_t)b * LSP * 64, LS, 33, 0);
            __syncthreads();
            f2_unit(F, relb, (const bf16*)(ws + WS_QB) + m0 * 512, 15, (const bf16*)(ws + WS_KS) + (size_t)b * LSP * 128, (const bf16*)(ws + WS_VS) + (size_t)b * LSP * 128, 33, PAST, 30, false,
                    (bf16*)(ws + WS_ATT) + m0 * 512, 16);
        } else {
            const int v = u - 32, qc = 31 - (v >> 4), b = (v >> 1) & 7, half = v & 1;
            const int t0 = 64 * qc + 32 * half; const size_t m0 = (size_t)b * SEQ + t0; const int n = 64 * (qc + 1);
            const bool allsel = qc < 4;
            if (!allsel) {
                for (int sb = 0; sb < 2; ++sb) {
                    f1_subblock(F, (const bf16*)(ws + WS_QIB) + (m0 + 16 * sb) * 512, (const float*)(ws + WS_WI) + (m0 + 16 * sb) * 8, (const bf16*)(ws + WS_KIBP) + (size_t)b * SEQ * 64, n, qc + 1, 16 * sb);
                    __syncthreads();
                }
            }
            f2_unit(F, relb, (const bf16*)(ws + WS_QB) + m0 * 512, 31, (const bf16*)(ws + WS_KBP) + (size_t)b * SEQ * 128, (const bf16*)(ws + WS_VBP) + (size_t)b * SEQ * 128, qc + 1, t0, qc - 2, allsel,
                    (bf16*)(ws + WS_ATT) + m0 * 512, 32);
        }
    }
}
}

namespace rw {
constexpr int NCH = 2304;
constexpr int RS = 72;
constexpr int L_KKG = 0, L_BI = 9216, L_KI = 18432, L_RG = 27648, L_BGT = 36864, L_KGT = 46080, L_VT = 55296, L_GC = 64512;
constexpr int L_WL = 64768, L_AL = 82176, L_GG = 99584;
constexpr int L_LM = 64768, L_AKK = 73984, L_BRB = 83200, L_BRK = 92416, L_ADG = 101632;
constexpr int L_TW = 116992, L_AO = 126208, L_SG = 135424;
constexpr int L_LC = 116992;
static_assert(L_SG + 64 * 136 * 2 <= MISC_OFF, "rwkv LDS map");
typedef float f32x2 __attribute__((ext_vector_type(2)));

__device__ __forceinline__ f32x4 mfma16(bf16x8 a, bf16x8 b, f32x4 c) { return __builtin_amdgcn_mfma_f32_16x16x32_bf16(a, b, c, 0, 0, 0); }
__device__ __forceinline__ bf16x8 ldsfrag(const LAS unsigned char* base, int row, int rs_elems, int col) { return *(const LAS bf16x8*)(base + (row * rs_elems + col) * 2); }
__device__ __forceinline__ bf16x8 ldsfrag2(const LAS unsigned char* base, int row, int c0, int c1) {
    const v2u lo = *(const LAS v2u*)(base + (row * RS + c0) * 2); v2u hi = {0u, 0u}; if (c1 >= 0) hi = *(const LAS v2u*)(base + (row * RS + c1) * 2);
    return __builtin_bit_cast(bf16x8, (v4u){lo.x, lo.y, hi.x, hi.y});
}
__device__ __forceinline__ bf16x8 accfrag(f32x4 lo, f32x4 hi) { return __builtin_bit_cast(bf16x8, (v4u){pk2(lo.x, lo.y), pk2(lo.z, lo.w), pk2(hi.x, hi.y), pk2(hi.z, hi.w)}); }
__device__ __forceinline__ void st8bf(LAS unsigned char* p, const float (&x)[8]) { *(LAS v4u*)p = (v4u){pk2(x[0], x[1]), pk2(x[2], x[3]), pk2(x[4], x[5]), pk2(x[6], x[7])}; }
__device__ __forceinline__ void ld8f(const float* p, float (&x)[8]) { const f32x4 a = *(const GAS f32x4*)p, b = *(const GAS f32x4*)(p + 4); x[0] = a.x; x[1] = a.y; x[2] = a.z; x[3] = a.w; x[4] = b.x; x[5] = b.y; x[6] = b.z; x[7] = b.w; }
__device__ __forceinline__ void ld8bf(const bf16* p, float (&x)[8]) { const v4u w = *(const GAS v4u*)p; x[0] = bflo(w.x); x[1] = bfhi(w.x); x[2] = bflo(w.y); x[3] = bfhi(w.y); x[4] = bflo(w.z); x[5] = bfhi(w.z); x[6] = bflo(w.w); x[7] = bfhi(w.w); }

__device__ __forceinline__ void xs8(const Args& a, const bf16* P, size_t m, int prevkind  , int sb, int col0, float (&x)[8]) {
    float p[8], pv[8], mu[8];
    ld8bf(P + m * RWC + col0, p); ld8f(a.in[11] + col0, mu);
    if (prevkind == 0) ld8bf(P + (m - 1) * RWC + col0, pv);
    else if (prevkind == 2) ld8f(a.in[6] + (size_t)sb * RWC + col0, pv);
    else {
#pragma unroll
        for (int i = 0; i < 8; ++i) pv[i] = 0.f; }
#pragma unroll
    for (int i = 0; i < 8; ++i) x[i] = p[i] + (pv[i] - p[i]) * mu[i];
}

__device__ __forceinline__ void r1_unit(Frame& F, const Args& a, int ch) {
    unsigned char* ws = a.ws; LAS unsigned char* lds = F.lds;
    int tid_ = F.tid; asm volatile("" : "+v"(tid_));
    const int tid = tid_, lane = tid & 63, w = __builtin_amdgcn_readfirstlane(tid >> 6), fr = lane & 15, fq = lane >> 4;
    const bool smp = ch >= 2048; const int h = ch & 7; const int sb = (ch - 2048) >> 3;
    const int pb = ch >> 8, pc = (ch >> 3) & 31;
    const size_t mbase = smp ? (size_t)MP + (size_t)sb * DSEQ : (size_t)pb * SEQ + (size_t)pc * 64;
    const bf16* P = (const bf16*)(ws + WS_P);
    const int t = tid >> 3, s8 = tid & 7, j0 = 8 * s8;
    const bool valid = !smp || t < DSEQ;
    const size_t m = mbase + (valid ? t : 0);
    const int prevkind = (t > 0 || (!smp && pc > 0)) ? 0 : (smp ? 2 : 1);
    float xr[8], xk[8], xv[8];
    {
        float x[8];
        xs8(a, P, m, prevkind, sb, h * 64 + j0, xr); xs8(a, P, m, prevkind, sb, 512 + h * 64 + j0, xk); xs8(a, P, m, prevkind, sb, 1024 + h * 64 + j0, xv);
        xs8(a, P, m, prevkind, sb, 1536 + j0, x);
#pragma unroll
        for (int i = 0; i < 8; ++i) x[i] = tanhf(x[i]);
        st8bf(lds + L_TW + (t * RS + j0) * 2, x);
        xs8(a, P, m, prevkind, sb, 1600 + j0, x); st8bf(lds + L_AO + (t * RS + j0) * 2, x);
        xs8(a, P, m, prevkind, sb, 1664 + j0, x);
#pragma unroll
        for (int i = 0; i < 8; ++i) x[i] = sigmoidf_(x[i]);
        st8bf(lds + L_SG + (t * 136 + j0) * 2, x);
        xs8(a, P, m, prevkind, sb, 1728 + j0, x);
#pragma unroll
        for (int i = 0; i < 8; ++i) x[i] = sigmoidf_(x[i]);
        st8bf(lds + L_SG + (t * 136 + 64 + j0) * 2, x);
    }
    __syncthreads();
    {
        const int mb = w >> 1;
        const bf16* WdT = (const bf16*)(ws + WS_WT_D); const bf16* WaT = (const bf16*)(ws + WS_WT_A); const bf16* WgT = (const bf16*)(ws + WS_WT_G);
#pragma unroll
        for (int q = 0; q < 2; ++q) {
            const int nb = 2 * (w & 1) + q; const int nrow = h * 64 + 16 * nb + fr;
            f32x4 cw = {0.f, 0.f, 0.f, 0.f}, ca = cw, cg = cw;
#pragma unroll
            for (int ks = 0; ks < 2; ++ks) {
                cw = mfma16(ldsfrag(lds + L_TW, 16 * mb + fr, RS, 32 * ks + 8 * fq), *(const GAS bf16x8*)(WdT + (size_t)nrow * 64 + 32 * ks + 8 * fq), cw);
                ca = mfma16(ldsfrag(lds + L_AO, 16 * mb + fr, RS, 32 * ks + 8 * fq), *(const GAS bf16x8*)(WaT + (size_t)nrow * 64 + 32 * ks + 8 * fq), ca);
            }
#pragma unroll
            for (int ks = 0; ks < 4; ++ks) cg = mfma16(ldsfrag(lds + L_SG, 16 * mb + fr, 136, 32 * ks + 8 * fq), *(const GAS bf16x8*)(WgT + (size_t)nrow * 128 + 32 * ks + 8 * fq), cg);
#pragma unroll
            for (int r = 0; r < 4; ++r) { const int o = ((16 * mb + 4 * fq + r) * 68 + 16 * nb + fr) * 4;
                *(LAS float*)(lds + L_WL + o) = cw[r]; *(LAS float*)(lds + L_AL + o) = ca[r]; *(LAS float*)(lds + L_GG + o) = cg[r]; }
        }
    }
    __syncthreads();
    float kk[8], kh[8], bb[8], lw[8];
    {
        float w0[8], a0[8], kkp[8], kap[8], rkp[8], lnw[8], lnb[8], wl[8], al[8], gg[8];
        const int cb = h * 64 + j0;
        ld8f(a.in[12] + cb, w0); ld8f(a.in[14] + cb, a0); ld8f(a.in[17] + cb, kkp); ld8f(a.in[18] + cb, kap); ld8f(a.in[19] + cb, rkp); ld8f(a.in[20] + cb, lnw); ld8f(a.in[21] + cb, lnb);
#pragma unroll
        for (int i = 0; i < 8; ++i) { const int o = (t * 68 + j0 + i) * 4; wl[i] = *(const LAS float*)(lds + L_WL + o); al[i] = *(const LAS float*)(lds + L_AL + o); gg[i] = *(const LAS float*)(lds + L_GG + o); }
        float ss = 0.f, bs = 0.f, av[8];
#pragma unroll
        for (int i = 0; i < 8; ++i) {
            const float z = -(w0[i] + wl[i]); const float sp = (z > 20.f) ? z : log1pf(__expf(z)); const float wv = -sp - 0.5f;
            lw[i] = valid ? -__expf(wv) : 0.f;
            av[i] = sigmoidf_(a0[i] + al[i]);
            kk[i] = xk[i] * kkp[i]; ss += kk[i] * kk[i];
            kh[i] = xk[i] * (1.0f + (av[i] - 1.0f) * kap[i]);
            bs += xr[i] * kh[i] * rkp[i];
        }
        ss += __shfl_xor(ss, 1); ss += __shfl_xor(ss, 2); ss += __shfl_xor(ss, 4);
        bs += __shfl_xor(bs, 1); bs += __shfl_xor(bs, 2); bs += __shfl_xor(bs, 4);
        const float inv = 1.0f / fmaxf(sqrtf(ss), 1e-12f);
        float g1[8], e1[8];
#pragma unroll
        for (int i = 0; i < 8; ++i) {
            kk[i] *= inv; bb[i] = kk[i] * av[i];
            g1[i] = lnw[i] * gg[i]; e1[i] = (lnb[i] + bs * xv[i]) * gg[i];
            if (!valid) { kk[i] = 0.f; bb[i] = 0.f; kh[i] = 0.f; xv[i] = 0.f; xr[i] = 0.f; }
        }
        if (valid) {
            *(GAS v4u*)((bf16*)(ws + WS_G1) + m * 512 + cb) = (v4u){pk2(g1[0], g1[1]), pk2(g1[2], g1[3]), pk2(g1[4], g1[5]), pk2(g1[6], g1[7])};
            *(GAS v4u*)((bf16*)(ws + WS_E) + m * 512 + cb) = (v4u){pk2(e1[0], e1[1]), pk2(e1[2], e1[3]), pk2(e1[4], e1[5]), pk2(e1[6], e1[7])};
        }
    }
    __syncthreads();
#pragma unroll
    for (int i = 0; i < 8; ++i) *(LAS float*)(lds + L_LC + (t * 65 + j0 + i) * 4) = lw[i];
    __syncthreads();
    if (tid < 64) { float acc = 0.f;
#pragma unroll 8
        for (int tt = 0; tt < 64; ++tt) { LAS float* p = (LAS float*)(lds + L_LC + (tt * 65 + tid) * 4); acc += *p; *p = acc; } }
    __syncthreads();
    {
        float kkg[8], bi[8], ki[8], rg[8];
#pragma unroll
        for (int i = 0; i < 8; ++i) {
            const int j = j0 + i;
            const float Lt = *(const LAS float*)(lds + L_LC + (t * 65 + j) * 4), Lp = (t > 0) ? *(const LAS float*)(lds + L_LC + ((t - 1) * 65 + j) * 4) : 0.f, LN = *(const LAS float*)(lds + L_LC + (63 * 65 + j) * 4);
            const float eI = __expf(-Lt), eT = __expf(Lt), eP = __expf(Lp), eC = __expf(LN - Lt);
            kkg[i] = kk[i] * eP; bi[i] = bb[i] * eI; ki[i] = kh[i] * eI; rg[i] = xr[i] * eT;
            *(LAS bf16*)(lds + L_BGT + (j * RS + t) * 2) = (bf16)f2bf(bb[i] * eC);
            *(LAS bf16*)(lds + L_KGT + (j * RS + t) * 2) = (bf16)f2bf(kh[i] * eC);
            *(LAS bf16*)(lds + L_VT + (j * RS + t) * 2) = (bf16)f2bf(xv[i]);
            if (t == 0) *(LAS float*)(lds + L_GC + j * 4) = __expf(LN);
        }
        st8bf(lds + L_KKG + (t * RS + j0) * 2, kkg); st8bf(lds + L_BI + (t * RS + j0) * 2, bi); st8bf(lds + L_KI + (t * RS + j0) * 2, ki); st8bf(lds + L_RG + (t * RS + j0) * 2, rg);
    }
    __syncthreads();
    {
        const int mb = w >> 1;
        const bf16x8 ak0 = ldsfrag(lds + L_KKG, 16 * mb + fr, RS, 8 * fq), ak1 = ldsfrag(lds + L_KKG, 16 * mb + fr, RS, 32 + 8 * fq);
        const bf16x8 ar0 = ldsfrag(lds + L_RG, 16 * mb + fr, RS, 8 * fq), ar1 = ldsfrag(lds + L_RG, 16 * mb + fr, RS, 32 + 8 * fq);
#pragma unroll
        for (int q = 0; q < 2; ++q) {
            const int nb = 2 * (w & 1) + q;
            f32x4 abk = {0.f, 0.f, 0.f, 0.f}, akk = abk, brb = abk, brk = abk;
            if (nb <= mb) {
                const bf16x8 bb0 = ldsfrag(lds + L_BI, 16 * nb + fr, RS, 8 * fq), bb1 = ldsfrag(lds + L_BI, 16 * nb + fr, RS, 32 + 8 * fq);
                const bf16x8 bk0 = ldsfrag(lds + L_KI, 16 * nb + fr, RS, 8 * fq), bk1 = ldsfrag(lds + L_KI, 16 * nb + fr, RS, 32 + 8 * fq);
                abk = mfma16(ak0, bb0, abk); abk = mfma16(ak1, bb1, abk); akk = mfma16(ak0, bk0, akk); akk = mfma16(ak1, bk1, akk);
                brb = mfma16(ar0, bb0, brb); brb = mfma16(ar1, bb1, brb); brk = mfma16(ar0, bk0, brk); brk = mfma16(ar1, bk1, brk);
            }
#pragma unroll
            for (int r = 0; r < 4; ++r) {
                const int tt = 16 * mb + 4 * fq + r, tau = 16 * nb + fr; const bool st = tau < tt, inc = tau <= tt;
                const float vabk = st ? abk[r] : 0.f;
                if (nb == mb) *(LAS float*)(lds + L_ADG + ((mb * 16 + 4 * fq + r) * 17 + fr) * 4) = vabk;
                else *(LAS bf16*)(lds + L_LM + (tt * RS + tau) * 2) = (bf16)f2bf(-vabk);
                *(LAS bf16*)(lds + L_AKK + (tt * RS + tau) * 2) = (bf16)f2bf(st ? akk[r] : 0.f);
                *(LAS bf16*)(lds + L_BRB + (tt * RS + tau) * 2) = (bf16)f2bf(inc ? brb[r] : 0.f);
                *(LAS bf16*)(lds + L_BRK + (tt * RS + tau) * 2) = (bf16)f2bf(inc ? brk[r] : 0.f);
            }
        }
    }
    __syncthreads();
    f32x4 rhs[4];
    if (w == 0) {
        const int I = lane >> 4, c = lane & 15; float x[16];
#pragma unroll
        for (int tt = 0; tt < 16; ++tt) { float s = (tt == c) ? 1.f : 0.f;
#pragma unroll
            for (int tau = 0; tau < tt; ++tau) s -= *(const LAS float*)(lds + L_ADG + ((I * 16 + tt) * 17 + tau) * 4) * x[tau];
            x[tt] = s; *(LAS bf16*)(lds + L_LM + ((16 * I + tt) * RS + 16 * I + c) * 2) = (bf16)f2bf(s); }
    }
    if (w >= 4) {
        const int ib = w - 4;
        const bf16x8 v0 = ldsfrag(lds + L_VT, 16 * ib + fr, RS, 8 * fq), v1 = ldsfrag(lds + L_VT, 16 * ib + fr, RS, 32 + 8 * fq);
#pragma unroll
        for (int mb = 0; mb < 4; ++mb) { f32x4 c = {0.f, 0.f, 0.f, 0.f};
            c = mfma16(ldsfrag(lds + L_AKK, 16 * mb + fr, RS, 8 * fq), v0, c); c = mfma16(ldsfrag(lds + L_AKK, 16 * mb + fr, RS, 32 + 8 * fq), v1, c); rhs[mb] = c; }
    } else {
#pragma unroll
        for (int mb = 0; mb < 4; ++mb)
#pragma unroll
            for (int r = 0; r < 4; ++r) rhs[mb][r] = bf2f(*(const LAS bf16*)(lds + L_KKG + ((16 * mb + 4 * fq + r) * RS + 16 * w + fr) * 2));
    }
    __syncthreads();
    const f32x4 z4 = {0.f, 0.f, 0.f, 0.f};
    f32x4 X0, X1, X2, X3;
    {
        const LAS unsigned char* LM = lds + L_LM;
        X0 = mfma16(ldsfrag2(LM, fr, 4 * fq, -1), accfrag(rhs[0], z4), z4);
        f32x4 t1 = mfma16(ldsfrag2(LM, 16 + fr, 4 * fq, -1), accfrag(X0, z4), rhs[1]);
        X1 = mfma16(ldsfrag2(LM, 16 + fr, 16 + 4 * fq, -1), accfrag(t1, z4), z4);
        f32x4 t2 = mfma16(ldsfrag2(LM, 32 + fr, 4 * fq, 16 + 4 * fq), accfrag(X0, X1), rhs[2]);
        X2 = mfma16(ldsfrag2(LM, 32 + fr, 32 + 4 * fq, -1), accfrag(t2, z4), z4);
        f32x4 t3 = mfma16(ldsfrag2(LM, 48 + fr, 4 * fq, 16 + 4 * fq), accfrag(X0, X1), rhs[3]);
        t3 = mfma16(ldsfrag2(LM, 48 + fr, 32 + 4 * fq, -1), accfrag(X2, z4), t3);
        X3 = mfma16(ldsfrag2(LM, 48 + fr, 48 + 4 * fq, -1), accfrag(t3, z4), z4);
    }
    if (w < 4) {
        const bf16x8 xb0 = accfrag(X0, X1), xb1 = accfrag(X2, X3);
        bf16* MTg = (bf16*)(ws + WS_MT) + (size_t)ch * 4096; bf16* WYg = (bf16*)(ws + WS_WY) + (size_t)ch * 4096;
#pragma unroll
        for (int mb = 0; mb < 4; ++mb) {
            f32x4 c = mfma16(ldsfrag2(lds + L_BGT, 16 * mb + fr, 4 * fq, 16 + 4 * fq), xb0, z4); c = mfma16(ldsfrag2(lds + L_BGT, 16 * mb + fr, 32 + 4 * fq, 48 + 4 * fq), xb1, c);
            f32x4 d = mfma16(ldsfrag2(lds + L_BRB, 16 * mb + fr, 4 * fq, 16 + 4 * fq), xb0, z4); d = mfma16(ldsfrag2(lds + L_BRB, 16 * mb + fr, 32 + 4 * fq, 48 + 4 * fq), xb1, d);
#pragma unroll
            for (int r = 0; r < 4; ++r) { const int row = 16 * mb + 4 * fq + r, col = 16 * w + fr;
                const float mv = ((row == col) ? *(const LAS float*)(lds + L_GC + row * 4) : 0.f) - c[r];
                MTg[row * 64 + col] = (bf16)f2bf(mv);
                WYg[row * 64 + col] = (bf16)f2bf(bf2f(*(const LAS bf16*)(lds + L_RG + (row * RS + col) * 2)) - d[r]); }
        }
    } else {
        const int ib = w - 4;
        const f32x4 n0 = -X0, n1 = -X1, n2 = -X2, n3 = -X3;
        const bf16x8 xb0 = accfrag(n0, n1), xb1 = accfrag(n2, n3);
        const bf16x8 v0 = ldsfrag(lds + L_VT, 16 * ib + fr, RS, 8 * fq), v1 = ldsfrag(lds + L_VT, 16 * ib + fr, RS, 32 + 8 * fq);
        v2u* NTg = (v2u*)(ws + WS_NT) + ((size_t)ch * 16 + ib * 4) * 64 + lane; v2u* YLg = (v2u*)(ws + WS_YL) + ((size_t)ch * 16 + ib * 4) * 64 + lane;
#pragma unroll
        for (int mb = 0; mb < 4; ++mb) {
            f32x4 c = mfma16(ldsfrag(lds + L_KGT, 16 * mb + fr, RS, 8 * fq), v0, z4); c = mfma16(ldsfrag(lds + L_KGT, 16 * mb + fr, RS, 32 + 8 * fq), v1, c);
            c = mfma16(ldsfrag2(lds + L_BGT, 16 * mb + fr, 4 * fq, 16 + 4 * fq), xb0, c); c = mfma16(ldsfrag2(lds + L_BGT, 16 * mb + fr, 32 + 4 * fq, 48 + 4 * fq), xb1, c);
            f32x4 d = mfma16(ldsfrag(lds + L_BRK, 16 * mb + fr, RS, 8 * fq), v0, z4); d = mfma16(ldsfrag(lds + L_BRK, 16 * mb + fr, RS, 32 + 8 * fq), v1, d);
            d = mfma16(ldsfrag2(lds + L_BRB, 16 * mb + fr, 4 * fq, 16 + 4 * fq), xb0, d); d = mfma16(ldsfrag2(lds + L_BRB, 16 * mb + fr, 32 + 4 * fq, 48 + 4 * fq), xb1, d);
            *(GAS v2u*)(NTg + mb * 64) = (v2u){pk2(c[0], c[1]), pk2(c[2], c[3])};
            *(GAS v2u*)(YLg + mb * 64) = (v2u){pk2(d[0], d[1]), pk2(d[2], d[3])};
        }
    }
    __syncthreads();
}
__device__ __forceinline__ void r1_phase(Frame& F, const Args& a) {
    for (int u = blockIdx.x; u < NCH; u += F.G) r1_unit(F, a, u);
}

__device__ __forceinline__ void r2_task(Frame& F, const Args& a, int chain, int ib) {
    unsigned char* ws = a.ws; const int lane = F.lane, fr = lane & 15, fq = lane >> 4;
    const bool smp = chain >= 64; const int b = smp ? (chain - 64) >> 3 : chain >> 3, h = chain & 7; const int nchunks = smp ? 1 : 32;
    f32x4 S[4];
    if (smp) { const float* s0 = a.in[5] + (((size_t)b * 8 + h) * 64 + 16 * ib + fr) * 64;
#pragma unroll
        for (int mb = 0; mb < 4; ++mb) S[mb] = *(const GAS f32x4*)(s0 + 16 * mb + 4 * fq); }
    else {
#pragma unroll
        for (int mb = 0; mb < 4; ++mb) S[mb] = (f32x4){0.f, 0.f, 0.f, 0.f}; }
#pragma unroll 1
    for (int c = 0; c < nchunks; ++c) {
        const int ch = smp ? 2048 + b * 8 + h : (b * 32 + c) * 8 + h;
        const bf16* MTg = (const bf16*)(ws + WS_MT) + (size_t)ch * 4096; const v2u* NTg = (const v2u*)(ws + WS_NT) + ((size_t)ch * 16 + ib * 4) * 64 + lane;
        bf16* SN = (bf16*)(ws + WS_SSN) + (size_t)ch * 4096 + (16 * ib + fr) * 64;
#pragma unroll
        for (int mb = 0; mb < 4; ++mb) *(GAS v2u*)(SN + 16 * mb + 4 * fq) = (v2u){pk2(S[mb].x, S[mb].y), pk2(S[mb].z, S[mb].w)};
        const bf16x8 sb0 = accfrag(S[0], S[1]), sb1 = accfrag(S[2], S[3]);
        f32x4 Sn[4];
#pragma unroll
        for (int mb = 0; mb < 4; ++mb) {
            const bf16* row = MTg + (16 * mb + fr) * 64;
            const v2u a00 = *(const GAS v2u*)(row + 4 * fq), a01 = *(const GAS v2u*)(row + 16 + 4 * fq), a10 = *(const GAS v2u*)(row + 32 + 4 * fq), a11 = *(const GAS v2u*)(row + 48 + 4 * fq);
            const v2u nt = *(const GAS v2u*)(NTg + mb * 64);
            f32x4 c = {bflo(nt.x), bfhi(nt.x), bflo(nt.y), bfhi(nt.y)};
            c = mfma16(__builtin_bit_cast(bf16x8, (v4u){a00.x, a00.y, a01.x, a01.y}), sb0, c);
            c = mfma16(__builtin_bit_cast(bf16x8, (v4u){a10.x, a10.y, a11.x, a11.y}), sb1, c);
            Sn[mb] = c;
        }
#pragma unroll
        for (int mb = 0; mb < 4; ++mb) S[mb] = Sn[mb];
    }
    float* o = a.out + (smp ? O_WKVS : O_WKVP) + (((size_t)b * 8 + h) * 64 + 16 * ib + fr) * 64;
#pragma unroll
    for (int mb = 0; mb < 4; ++mb) *(GAS f32x4*)(o + 16 * mb + 4 * fq) = S[mb];
}
__device__ __forceinline__ void r2_phase(Frame& F, const Args& a) {
    const int bx = blockIdx.x;
    if (F.wave == 0) { if (bx < 256) r2_task(F, a, bx >> 2, bx & 3); }
    else if (F.wave <= 4) { const int tsk = bx * 4 + (F.wave - 1); if (tsk < 1024) r2_task(F, a, 64 + (tsk >> 2), tsk & 3); }
}

__device__ __forceinline__ void r3_phase(Frame& F, const Args& a) {
    unsigned char* ws = a.ws; const int lane = F.lane, fr = lane & 15, fq = lane >> 4, mb = F.wave & 3, sub = F.wave >> 2;
    for (int u2 = blockIdx.x; u2 < NCH / 2; u2 += F.G) {
        const int ch = 2 * u2 + sub; const bool smp = ch >= 2048; const int h = ch & 7;
        if (smp && mb > 0) continue;
        const size_t mbase = smp ? (size_t)MP + (size_t)((ch - 2048) >> 3) * DSEQ : (size_t)(ch >> 8) * SEQ + (size_t)((ch >> 3) & 31) * 64;
        const bf16* WYg = (const bf16*)(ws + WS_WY) + (size_t)ch * 4096 + (16 * mb + fr) * 64; const bf16* SN = (const bf16*)(ws + WS_SSN) + (size_t)ch * 4096;
        const bf16x8 a0 = *(const GAS bf16x8*)(WYg + 8 * fq), a1 = *(const GAS bf16x8*)(WYg + 32 + 8 * fq);
        f32x4 y[4];
#pragma unroll
        for (int nb = 0; nb < 4; ++nb) {
            const v2u yl = *(const GAS v2u*)((const v2u*)(ws + WS_YL) + ((size_t)ch * 16 + nb * 4 + mb) * 64 + lane);
            f32x4 c = {bflo(yl.x), bfhi(yl.x), bflo(yl.y), bfhi(yl.y)};
            const bf16* srow = SN + (16 * nb + fr) * 64;
            c = mfma16(a0, *(const GAS bf16x8*)(srow + 8 * fq), c); c = mfma16(a1, *(const GAS bf16x8*)(srow + 32 + 8 * fq), c);
            y[nb] = c;
        }
#pragma unroll
        for (int r = 0; r < 4; ++r) {
            float s = (y[0][r] + y[1][r]) + (y[2][r] + y[3][r]);
            s += __shfl_xor(s, 1); s += __shfl_xor(s, 2); s += __shfl_xor(s, 4); s += __shfl_xor(s, 8);
            const float mean = s * (1.f / 64.f);
            float q = 0.f;
#pragma unroll
            for (int nb = 0; nb < 4; ++nb) { const float d = y[nb][r] - mean; q += d * d; }
            q += __shfl_xor(q, 1); q += __shfl_xor(q, 2); q += __shfl_xor(q, 4); q += __shfl_xor(q, 8);
            const float rstd = 1.0f / sqrtf(q * (1.f / 64.f) + 64e-5f);
            const int tt = 16 * mb + 4 * fq + r;
            if (!smp || tt < DSEQ) {
                const size_t mrow = (mbase + tt) * 512 + h * 64;
#pragma unroll
                for (int nb = 0; nb < 4; ++nb) { const int i = 16 * nb + fr;
                    const float g1 = bf2f(((const bf16*)(ws + WS_G1))[mrow + i]), e1 = bf2f(((const bf16*)(ws + WS_E))[mrow + i]);
                    ((bf16*)(ws + WS_RW))[mrow + i] = (bf16)f2bf((y[nb][r] - mean) * rstd * g1 + e1); }
            }
        }
    }
}
}
#define PHASE2 { att::attn_phase(F, args); }
#define PHASE3 { rw::r1_phase(F, args); }
#define PHASE4 { rw::r2_phase(F, args); }
#define PHASE5 { rw::r3_phase(F, args); }
#define HOST_SEQUENCE RUN_PHASES(0, N_PHASES);

constexpr int N_PHASES = 12;
__global__ void __launch_bounds__(NTHREADS, 2) fwd_kernel(Args args) {
    extern __shared__ __attribute__((aligned(16))) unsigned char lds[];
    Frame F;
    F.lds = (LAS unsigned char*)lds;
    F.tid = threadIdx.x; F.lane = F.tid & 63; F.wave = __builtin_amdgcn_readfirstlane(F.tid >> 6);
    F.G = gridDim.x; { const int bx = blockIdx.x; F.vcu = (F.G % 8 == 0) ? (bx % 8) * (F.G / 8) + bx / 8 : bx; }
    unsigned char* ws = args.ws;
    const int lo = args.ph_lo, hi = args.ph_hi;
    volatile LAS unsigned* MISC = (volatile LAS unsigned*)(F.lds + MISC_OFF);
    if (F.tid < 64) MISC[F.tid] = 0u;
    __syncthreads();
    XcdBarrier bar = xcd_barrier_post((unsigned*)(ws + WS_CTL) + CW_BAR, MISC + 8);
#define SEAM(k) do { if (IN(k) && IN((k) + 1)) xcd_barrier(bar); } while (0)
#define IN(k) (lo <= (k) && (k) < hi)
    bf16* sga_p = (bf16*)args.out; bf16* sgb_p = sga_p + (size_t)MP * DM;

    if (IN(0)) { p0_prologue(F, args); } SEAM(0);
    if (IN(1)) {
        pg8::Gemm g{(const bf16*)(ws + WS_H), (const bf16*)(ws + WS_WT_IN), MT_ROWS, NPAD, DM}; pg8::StaticOrder S; S.init(MT_ROWS, NPAD, F.G, (int)blockIdx.x);
        EpiInProj E{ws, args.out, sga_p, sgb_p};
        pg8::gemm_phase<EpiInProj, pg8::StaticOrder, true, true>(F.lds, g, S, E);
    } SEAM(1);
    if (IN(2)) { PHASE2 } SEAM(2);
    if (IN(3)) { PHASE3 } SEAM(3);
    if (IN(4)) { PHASE4 } SEAM(4);
    if (IN(5)) { PHASE5 } SEAM(5);
    if (IN(6)) { PHASE6 } SEAM(6);
    if (IN(7)) { PHASE7 } SEAM(7);
    if (IN(8)) { PHASE8 } SEAM(8);
    if (IN(9)) { PHASE9 } SEAM(9);
    if (IN(10)) { PHASE10 } SEAM(10);
    if (IN(11)) { PHASE11 }
#undef IN
}

extern "C" void kernel_launch(void* const* d_in, const int* in_sizes, int n_in, void* d_out, int out_size, void* d_ws, size_t ws_size, hipStream_t stream) {
    static int grid = 0;
    if (grid == 0) {
        if (n_in != 28 || out_size != (int)O_END || ws_size < WS_END) { fprintf(stderr, "kernel_launch: unexpected shapes: n_in %d out %d ws %zu\n", n_in, out_size, ws_size); grid = -1; return; }
        int dev = 0, cus = 0;
        if (hipGetDevice(&dev) != hipSuccess || hipDeviceGetAttribute(&cus, hipDeviceAttributeMultiprocessorCount, dev) != hipSuccess) { grid = -1; return; }
        if (hipFuncSetAttribute((const void*)fwd_kernel, hipFuncAttributeMaxDynamicSharedMemorySize, LDS_BYTES) != hipSuccess) { fprintf(stderr, "kernel_launch: hipFuncSetAttribute failed\n"); grid = -1; return; }
        int per_cu = 0;
        if (hipOccupancyMaxActiveBlocksPerMultiprocessor(&per_cu, (const void*)fwd_kernel, NTHREADS, LDS_BYTES) != hipSuccess || per_cu < 1) fprintf(stderr, "kernel_launch: occupancy query says %d\n", per_cu);
        (void)hipGetLastError();
        grid = cus;
    }
    if (grid < 0) return;
    (void)hipMemsetAsync((char*)d_ws + WS_CTL, 0, CTL_ZERO_BYTES, stream);
    Args a{};
    for (int i = 0; i < 28; ++i) a.in[i] = (const float*)d_in[i];
    a.out = (float*)d_out; a.ws = (unsigned char*)d_ws;
#define RUN_PHASES(lo_, hi_) do { a.ph_lo = (lo_); a.ph_hi = (hi_); hipLaunchKernelGGL(fwd_kernel, dim3(grid), dim3(NTHREADS), LDS_BYTES, stream, a); } while (0)
    HOST_SEQUENCE
#undef RUN_PHASES
}
```

```cpp
#include <hip/hip_runtime.h>
#include <cstdio>
#include <cstdint>
namespace pg8 {
#define PG8_LAS __attribute__((address_space(3)))
typedef unsigned short bf16_t;
typedef short bf16x8 __attribute__((ext_vector_type(8)));
typedef float f32x4 __attribute__((ext_vector_type(4)));
typedef unsigned u32x4 __attribute__((ext_vector_type(4)));
typedef unsigned u32x2 __attribute__((ext_vector_type(2)));
constexpr int BM = 256, BK = 64, HALF = 128, HTB = HALF * BK * 2  , STAGE_BYTES = 8 * HTB, NXCD = 8, WGM = 8;

__host__ __device__ __forceinline__ int lds_byte(int r, int c) { const int st = (r >> 4) * 2 + (c >> 5), rr = r & 15, cc = c & 31, ob = rr * 64 + cc * 2; return st * 1024 + (ob ^ (((ob >> 9) & 1) << 5)); }
__host__ __device__ __forceinline__ void stage_rc(int b, int& R, int& C) { const int st = b / 1024, sb = b % 1024, swz = sb ^ (((sb >> 9) & 1) << 5); R = (st >> 1) * 16 + swz / 64; C = (st & 1) * 32 + (swz % 64) / 2; }
__host__ __device__ __forceinline__ int perm32(int rho) { const int n = rho >> 4, i = rho & 15; return 8 * (i >> 2) + 4 * n + (i & 3); }

struct Unit { int pm, pn; };
struct Gemm { const bf16_t* A; const bf16_t* Bt; int M, N, K; };

struct StaticOrder {
    int nM, nN, nwg, G, c;
    __host__ __device__ void init(int M, int N, int G_, int c_) { nM = M / BM; nN = N / BM; nwg = nM * nN; G = G_; c = c_; }
    __host__ __device__ bool next(int i, Unit& u) const {
        const long L = (long)i * G + c; if (L >= nwg) return false;
        int wgid = (int)L; { const int q = nwg / NXCD, r = nwg % NXCD, xcd = wgid % NXCD, off = wgid / NXCD; wgid = (xcd < r ? xcd * (q + 1) : r * (q + 1) + (xcd - r) * q) + off; }
        const int nig = WGM * nN, gid = wgid / nig, fm = gid * WGM, gsz = (nM - fm) < WGM ? (nM - fm) : WGM;
        u.pm = fm + ((wgid % nig) % gsz); u.pn = (wgid % nig) / gsz; return true;
    }
    __device__ __forceinline__ void a_ready(const Unit&) const {}
    __device__ __forceinline__ void done(const Unit&) const {}
};
__device__ __forceinline__ unsigned cvt_pk_bf16(float lo, float hi) { unsigned r; asm volatile("v_cvt_pk_bf16_f32 %0, %1, %2" : "=v"(r) : "v"(lo), "v"(hi)); return r; }

template <class Epi, class Sched, bool ALIGN_EPI = false, bool SP2 = false>
__device__ __forceinline__ void gemm_phase(PG8_LAS unsigned char* lds, const Gemm g, const Sched& S, const Epi& E) {
    const int tid = threadIdx.x, wid = __builtin_amdgcn_readfirstlane(tid >> 6), lane = tid & 63, wr = wid >> 2, wc = wid & 3, fr = lane & 15, fq = lane >> 4;
    const int K = g.K, nt = K / BK;
    unsigned voffA[2], voffB[2];
#pragma unroll
    for (int i = 0; i < 2; ++i) { int R, C; stage_rc(tid * 16 + i * 8192, R, C); const int Rb = Epi::PERM ? ((R & ~31) + perm32(R & 31)) : R;
        voffA[i] = (unsigned)(R * K + C) * 2u; voffB[i] = (unsigned)(Rb * K + C) * 2u; }
    const size_t kstep = (size_t)(BK * 2);
    const size_t hstep = (size_t)HALF * K * 2;
    const size_t tstep = 2 * hstep;
    const unsigned ldsw = (unsigned)wid * 1024u;
    const int aoff = lds_byte(wr * 64 + fr, fq * 8), boff = lds_byte(wc * 32 + fr, fq * 8);
#define PG8_SA(b, h) (((b) * 2 + (h)) * HTB)
#define PG8_SB(b, h) ((4 + (b) * 2 + (h)) * HTB)
#define PG8_STAGE(bufoff, gbase, voff) do { _Pragma("unroll") for (int _i = 0; _i < 2; ++_i) \
        __builtin_amdgcn_global_load_lds((const unsigned*)((const char*)(gbase) + (voff)[_i]), (PG8_LAS unsigned*)(lds + (bufoff) + ldsw + _i * 8192), 16, 0, 0); } while (0)
#define PG8_LDA(dst, b, h) do { _Pragma("unroll") for (int m = 0; m < 4; ++m) _Pragma("unroll") for (int k = 0; k < 2; ++k) dst[m][k] = *(const PG8_LAS bf16x8*)(lds + PG8_SA(b, h) + aoff + m * 2048 + k * 1024); } while (0)
#define PG8_LDB(dst, b, h) do { _Pragma("unroll") for (int n = 0; n < 2; ++n) _Pragma("unroll") for (int k = 0; k < 2; ++k) dst[n][k] = *(const PG8_LAS bf16x8*)(lds + PG8_SB(b, h) + boff + n * 2048 + k * 1024); } while (0)
#define PG8_MMA(ai, bj, At, Bt) do { __builtin_amdgcn_s_setprio(1); _Pragma("unroll") for (int m = 0; m < 4; ++m) _Pragma("unroll") for (int n = 0; n < 2; ++n) _Pragma("unroll") for (int k = 0; k < 2; ++k) \
        acc[ai][bj][m][n] = __builtin_amdgcn_mfma_f32_16x16x32_bf16(Bt[n][k], At[m][k], acc[ai][bj][m][n], 0, 0, 0); __builtin_amdgcn_s_setprio(0); } while (0)
#define PG8_WAIT_V(n) asm volatile("s_waitcnt vmcnt(" #n ")" ::: "memory")
#define PG8_WAIT_L(n) asm volatile("s_waitcnt lgkmcnt(" #n ")" ::: "memory")
#define PG8_BAR __builtin_amdgcn_s_barrier()
#define PG8_SCHED __builtin_amdgcn_sched_barrier(0)
    Unit cur, nxt; int ui = 0;
    if (!S.next(0, cur)) return;
    f32x4 acc[2][2][4][2];
#pragma unroll
    for (int a = 0; a < 2; ++a)
#pragma unroll
        for (int b = 0; b < 2; ++b)
#pragma unroll
            for (int m = 0; m < 4; ++m)
#pragma unroll
                for (int n = 0; n < 2; ++n) acc[a][b][m][n] = (f32x4){0.f, 0.f, 0.f, 0.f};
    bf16x8 At[4][2], B0[2][2], B1[2][2];
    const char* cA = (const char*)g.A + (size_t)cur.pm * tstep; const char* cB = (const char*)g.Bt + (size_t)cur.pn * tstep;
    S.a_ready(cur);
    if constexpr (SP2) {
        PG8_STAGE(PG8_SB(0, 0), cB, voffB); PG8_STAGE(PG8_SB(0, 1), cB + hstep, voffB); PG8_STAGE(PG8_SA(0, 0), cA, voffA); PG8_STAGE(PG8_SA(0, 1), cA + hstep, voffA);
        if (wr == 1) PG8_BAR;
        PG8_WAIT_V(2); PG8_BAR;
        PG8_STAGE(PG8_SB(1, 0), cB + kstep, voffB); PG8_STAGE(PG8_SA(1, 0), cA + kstep, voffA); PG8_STAGE(PG8_SB(1, 1), cB + hstep + kstep, voffB);
        PG8_WAIT_V(6); PG8_BAR;
    } else {
        PG8_STAGE(PG8_SB(0, 0), cB, voffB); PG8_STAGE(PG8_SA(0, 0), cA, voffA); PG8_STAGE(PG8_SB(0, 1), cB + hstep, voffB); PG8_STAGE(PG8_SA(0, 1), cA + hstep, voffA);
        if (wr == 1) PG8_BAR;
        PG8_WAIT_V(4); PG8_BAR;
        PG8_STAGE(PG8_SB(1, 0), cB + kstep, voffB); PG8_STAGE(PG8_SA(1, 0), cA + kstep, voffA); PG8_STAGE(PG8_SB(1, 1), cB + hstep + kstep, voffB);
        PG8_WAIT_V(6); PG8_BAR;
    }
    for (;;) {
        const bool has_next = S.next(ui + 1, nxt);
        const char* nA = has_next ? (const char*)g.A + (size_t)nxt.pm * tstep : cA; const char* nB = has_next ? (const char*)g.Bt + (size_t)nxt.pn * tstep : cB;
        for (int t = 0; t < nt; t += 2) {
            const bool last = (t == nt - 2);
            const char* a1 = cA + (size_t)(t + 1) * kstep;
            const char* a2 = last ? nA : cA + (size_t)(t + 2) * kstep; const char* b2 = last ? nB : cB + (size_t)(t + 2) * kstep;
            const char* a3 = a2 + kstep; const char* b3 = b2 + kstep;
            if (last && has_next) S.a_ready(nxt);
            if constexpr (SP2) {
            PG8_LDB(B0, 0, 0); PG8_LDB(B1, 0, 1); PG8_SCHED; PG8_LDA(At, 0, 0); PG8_STAGE(PG8_SA(1, 1), a1 + hstep, voffA);
            PG8_WAIT_V(8); PG8_WAIT_L(0); PG8_BAR; PG8_MMA(0, 0, At, B0); PG8_MMA(0, 1, At, B1); PG8_BAR; PG8_SCHED;
            PG8_LDA(At, 0, 1); PG8_STAGE(PG8_SB(0, 0), b2, voffB); PG8_STAGE(PG8_SB(0, 1), b2 + hstep, voffB); PG8_STAGE(PG8_SA(0, 0), a2, voffA);
            PG8_WAIT_V(8); PG8_WAIT_L(0); PG8_BAR; PG8_MMA(1, 0, At, B0); PG8_MMA(1, 1, At, B1); PG8_BAR; PG8_SCHED;
            PG8_LDB(B0, 1, 0); PG8_LDB(B1, 1, 1); PG8_SCHED; PG8_LDA(At, 1, 0); PG8_STAGE(PG8_SA(0, 1), a2 + hstep, voffA);
            PG8_WAIT_V(8); PG8_WAIT_L(0); PG8_BAR; PG8_MMA(0, 0, At, B0); PG8_MMA(0, 1, At, B1); PG8_BAR; PG8_SCHED;
            PG8_LDA(At, 1, 1); PG8_STAGE(PG8_SB(1, 0), b3, voffB); PG8_STAGE(PG8_SB(1, 1), b3 + hstep, voffB); PG8_STAGE(PG8_SA(1, 0), a3, voffA);
            PG8_WAIT_V(8); PG8_WAIT_L(0); PG8_BAR; PG8_MMA(1, 0, At, B0); PG8_MMA(1, 1, At, B1); PG8_BAR; PG8_SCHED;
            } else {
            PG8_LDB(B0, 0, 0); PG8_SCHED; PG8_LDA(At, 0, 0); PG8_STAGE(PG8_SA(1, 1), a1 + hstep, voffA);
            PG8_WAIT_L(8); PG8_BAR; PG8_WAIT_L(0); PG8_MMA(0, 0, At, B0); PG8_BAR; PG8_SCHED;
            PG8_LDB(B1, 0, 1); PG8_STAGE(PG8_SB(0, 0), b2, voffB);
            PG8_BAR; PG8_WAIT_L(0); PG8_MMA(0, 1, At, B1); PG8_BAR;
            PG8_LDA(At, 0, 1); PG8_STAGE(PG8_SA(0, 0), a2, voffA);
            PG8_BAR; PG8_WAIT_L(0); PG8_MMA(1, 0, At, B0); PG8_BAR; PG8_SCHED;
            PG8_STAGE(PG8_SB(0, 1), b2 + hstep, voffB);
            PG8_WAIT_V(6); PG8_BAR; PG8_MMA(1, 1, At, B1); PG8_BAR;
            PG8_LDB(B0, 1, 0); PG8_SCHED; PG8_LDA(At, 1, 0); PG8_STAGE(PG8_SA(0, 1), a2 + hstep, voffA);
            PG8_WAIT_L(8); PG8_BAR; PG8_WAIT_L(0); PG8_MMA(0, 0, At, B0); PG8_BAR; PG8_SCHED;
            PG8_LDB(B1, 1, 1); PG8_STAGE(PG8_SB(1, 0), b3, voffB);
            PG8_BAR; PG8_WAIT_L(0); PG8_MMA(0, 1, At, B1); PG8_BAR;
            PG8_LDA(At, 1, 1); PG8_STAGE(PG8_SA(1, 0), a3, voffA);
            PG8_BAR; PG8_WAIT_L(0); PG8_MMA(1, 0, At, B0); PG8_BAR; PG8_SCHED;
            PG8_STAGE(PG8_SB(1, 1), b3 + hstep, voffB);
            PG8_WAIT_V(6); PG8_BAR; PG8_MMA(1, 1, At, B1); PG8_BAR;
            }
        }
        if constexpr (ALIGN_EPI) { if (wr == 0) PG8_BAR; }
        if constexpr (!Epi::AFTER_DRAIN) { E(acc, cur, wr, wc, fr, fq); S.done(cur); }
        if (!has_next) break;
#pragma unroll
        for (int a = 0; a < 2; ++a)
#pragma unroll
            for (int b = 0; b < 2; ++b)
#pragma unroll
                for (int m = 0; m < 4; ++m)
#pragma unroll
                    for (int n = 0; n < 2; ++n) acc[a][b][m][n] = (f32x4){0.f, 0.f, 0.f, 0.f};
        cur = nxt; cA = nA; cB = nB; ++ui;
        if constexpr (ALIGN_EPI) { if (wr == 1) PG8_BAR; }
    }
    PG8_WAIT_V(0);
    if constexpr (!ALIGN_EPI) { if (wr == 0) PG8_BAR; }
    PG8_BAR;
    if constexpr (Epi::AFTER_DRAIN) { E.fused(acc, cur, wr, wc, fr, fq, lds, wid, lane); S.done(cur); }
#undef PG8_SA
#undef PG8_SB
#undef PG8_STAGE
#undef PG8_LDA
#undef PG8_LDB
#undef PG8_MMA
#undef PG8_WAIT_V
#undef PG8_WAIT_L
#undef PG8_BAR
#undef PG8_SCHED
}
}

constexpr int DM = 1024, MP = 16384, MS = 512, MT_ROWS = MP + MS;
constexpr int SEQ = 2048, PAST = 2048, DSEQ = 16, NB_P = 8, NB_S = 32, LS = PAST + DSEQ, LSP = 2112;
constexpr int NPAD = 5376, RWC = 1792, DFF = 4096;
constexpr int C_Q = 0, C_K = 512, C_V = 640, C_QI = 768, C_KI = 1280, C_WI = 1344, C_P = 1536, C_GA = 3328, C_GB = 4352;
constexpr size_t O_YP = 0, O_YS = 16777216, O_NKP = 17301504, O_NVP = 19398656, O_NKIP = 21495808, O_WKVP = 22544384, O_SHP = 22806528,
                 O_NKS = 22820864, O_NVS = 22886400, O_NKIS = 22951936, O_WKVS = 22984704, O_SHS = 24033280, O_END = 24090624;
constexpr float QSCALE = 0.125f * 1.4426950408889634f;
constexpr float NORM_EPS = 1e-6f;
constexpr size_t MiB = 1u << 20;
constexpr size_t WS_CTL = 0, CTL_ZERO_BYTES = 1 * MiB;
constexpr size_t WS_WT_IN = 1 * MiB, WS_WT_AB = 12 * MiB, WS_WT_OUT = 14 * MiB, WS_WT_FF1 = 16 * MiB, WS_WT_FF2 = 24 * MiB;
constexpr size_t WS_WT_D = 32 * MiB, WS_WT_A = WS_WT_D + 65536, WS_WT_G = WS_WT_A + 65536;
constexpr size_t WS_H = 33 * MiB;
constexpr size_t WS_P = 66 * MiB;
constexpr size_t WS_QB = 124 * MiB, WS_QIB = 141 * MiB, WS_KBP = 158 * MiB, WS_VBP = 162 * MiB, WS_KIBP = 166 * MiB;
constexpr size_t WS_KS = 168 * MiB, WS_VS = 185 * MiB, WS_KIS = 202 * MiB, WS_WI = 211 * MiB, WS_SGS = 212 * MiB;
constexpr size_t WS_ATT = 214 * MiB, WS_RW = 231 * MiB;
constexpr size_t WS_SSQ = 250 * MiB;
constexpr size_t WS_X1S = 247 * MiB;
constexpr size_t WS_MT = 33 * MiB, WS_NT = 124 * MiB, WS_WY = 142 * MiB, WS_YL = 160 * MiB, WS_G1 = 178 * MiB, WS_E = 195 * MiB, WS_SSN = 66 * MiB;
constexpr size_t WS_MIX = 33 * MiB, WS_H2 = 66 * MiB, WS_HFF = 99 * MiB;
constexpr size_t WS_END = 256 * MiB;
static_assert(WS_HFF + (size_t)MT_ROWS * DFF * 2 <= WS_X1S, "ws map");
constexpr int CW_QUEUE = 64;
constexpr int CW_BAR = 4096;

constexpr int NWAVES = 8, NTHREADS = 512;
constexpr int LDS_BYTES = 163840;
constexpr int MISC_OFF = LDS_BYTES - 1024;

#define GAS __attribute__((address_space(1)))
#define LAS __attribute__((address_space(3)))
typedef unsigned short bf16;
typedef unsigned v4u __attribute__((ext_vector_type(4)));
typedef unsigned v2u __attribute__((ext_vector_type(2)));
typedef float f32x4 __attribute__((ext_vector_type(4)));
typedef float f32x16 __attribute__((ext_vector_type(16)));
typedef short bf16x8 __attribute__((ext_vector_type(8)));
typedef short s16x4 __attribute__((ext_vector_type(4)));
#define LDS_WAIT() asm volatile("s_waitcnt lgkmcnt(0)" ::: "memory")
#define VM_WAIT() asm volatile("s_waitcnt vmcnt(0)" ::: "memory")
typedef float f32x2_c __attribute__((ext_vector_type(2))); typedef __bf16 bf16x2_c __attribute__((ext_vector_type(2)));
__device__ __forceinline__ unsigned pk2(float lo, float hi) { f32x2_c v = {lo, hi}; bf16x2_c b = __builtin_convertvector(v, bf16x2_c); return __builtin_bit_cast(unsigned, b); }
__device__ __forceinline__ unsigned f2bf(float f) { return pk2(f, 0.f) & 0xffffu; }
__device__ __forceinline__ float bf2f(unsigned short h) { return __builtin_bit_cast(float, (unsigned)h << 16); }
__device__ __forceinline__ float bflo(unsigned w) { return __builtin_bit_cast(float, w << 16); }
__device__ __forceinline__ float bfhi(unsigned w) { return __builtin_bit_cast(float, w & 0xffff0000u); }
__device__ __forceinline__ float wave_sum(float v) {
#pragma unroll
    for (int o = 1; o < 64; o <<= 1) v += __shfl_xor(v, o);
    return v;
}
__device__ __forceinline__ float fexp2(float x) { return __builtin_amdgcn_exp2f(x); }
__device__ __forceinline__ float fexp(float x) { return __builtin_amdgcn_exp2f(x * 1.4426950408889634f); }
__device__ __forceinline__ float sigmoidf_(float x) { return __builtin_amdgcn_rcpf(1.0f + fexp(-x)); }
__device__ __forceinline__ float ftanh(float x) { return 2.0f * __builtin_amdgcn_rcpf(1.0f + fexp(-2.0f * x)) - 1.0f; }
__device__ __forceinline__ float fsoftplus(float z) { const float e = fexp(z); const float mid = 0.6931471805599453f * __builtin_amdgcn_logf(1.0f + e); return z > 20.f ? z : (z < -15.f ? e : mid); }

struct Args {
    const float* in[28];
    float* out; unsigned char* ws;
    int ph_lo, ph_hi;
};
typedef const __attribute__((address_space(4))) Args* CArgsP;
struct Frame {
    LAS unsigned char* lds;
    int tid, lane, wave, vcu, G;
};

__device__ __forceinline__ void p0_transpose_item(const float* W, int ldw, int src_col0, bf16* WT, int dst_ld, int dst_row0, int dst_k0, int nblk, LAS float* scr, int item, int lane) {
    const int kb = item / nblk, nb = item % nblk, k0 = 64 * kb, n0 = 32 * nb;
#pragma unroll 8
    for (int i = 0; i < 32; ++i) { const int kk = 2 * i + (lane >> 5); scr[kk * 33 + (lane & 31)] = W[(size_t)(k0 + kk) * ldw + src_col0 + n0 + (lane & 31)]; }
    LDS_WAIT(); asm volatile("" ::: "memory");
    const int c = lane & 7;
#pragma unroll
    for (int j = 0; j < 4; ++j) { const int n = (lane >> 3) + 8 * j; const LAS float* s = scr + (8 * c) * 33 + n;
        v4u o; o.x = pk2(s[0 * 33], s[1 * 33]); o.y = pk2(s[2 * 33], s[3 * 33]); o.z = pk2(s[4 * 33], s[5 * 33]); o.w = pk2(s[6 * 33], s[7 * 33]);
        *(GAS v4u*)(WT + (size_t)(dst_row0 + n0 + n) * dst_ld + dst_k0 + k0 + 8 * c) = o; }
    LDS_WAIT(); asm volatile("" ::: "memory");
}
__device__ __forceinline__ void rms_row_to_bf16(int lane, const float* xrow, const float* g, bf16* orow) {
    const GAS f32x4* xr = (const GAS f32x4*)xrow + lane; const GAS f32x4* gr = (const GAS f32x4*)g + lane;
    f32x4 v[4]; float s = 0.f;
#pragma unroll
    for (int j = 0; j < 4; ++j) { v[j] = xr[64 * j]; s += (v[j].x * v[j].x + v[j].y * v[j].y) + (v[j].z * v[j].z + v[j].w * v[j].w); }
    const float rstd = 1.0f / sqrtf(wave_sum(s) * (1.f / DM) + NORM_EPS);
    GAS v2u* o8 = (GAS v2u*)orow + lane;
#pragma unroll
    for (int j = 0; j < 4; ++j) { const f32x4 gg = gr[64 * j]; v2u o; o.x = pk2(v[j].x * rstd * gg.x, v[j].y * rstd * gg.y); o.y = pk2(v[j].z * rstd * gg.z, v[j].w * rstd * gg.w); o8[64 * j] = o; }
}
template <int P0V = 0> __device__ __forceinline__ void p0_prologue(Frame& F, CArgsP a) {
    unsigned char* ws = a->ws;
    LAS float* scr = (LAS float*)(F.lds + F.wave * 16384);
    const int gw = F.vcu * NWAVES + F.wave, NGW = F.G * NWAVES;
    int base = 0;
    if (P0V == 0 || P0V == 1) {
#define TRJ(in_idx, ldw, sc0, ncols, K, dst, dld, dr0, dk0) { const int nblk = (ncols) / 32, nit = ((K) / 64) * nblk; int first = (gw - base) % NGW; if (first < 0) first += NGW; \
        for (int it = first; it < nit; it += NGW) p0_transpose_item(a->in[in_idx], ldw, sc0, (bf16*)(ws + (dst)), dld, dr0, dk0, nblk, scr, it, F.lane); base += nit; }
    TRJ(9, 5192, 0, 512, 1024, WS_WT_IN, 1024, C_Q, 0) TRJ(9, 5192, 512, 128, 1024, WS_WT_IN, 1024, C_K, 0) TRJ(9, 5192, 640, 128, 1024, WS_WT_IN, 1024, C_V, 0)
    TRJ(9, 5192, 768, 512, 1024, WS_WT_IN, 1024, C_QI, 0) TRJ(9, 5192, 1280, 64, 1024, WS_WT_IN, 1024, C_KI, 0) TRJ(9, 5192, 1352, 1792, 1024, WS_WT_IN, 1024, C_P, 0)
    TRJ(9, 5192, 3144, 1024, 1024, WS_WT_IN, 1024, C_GA, 0) TRJ(9, 5192, 4168, 1024, 1024, WS_WT_IN, 1024, C_GB, 0)
    TRJ(10, 1024, 0, 1024, 512, WS_WT_AB, 512, 0, 0) TRJ(22, 1024, 0, 1024, 512, WS_WT_AB + MiB, 512, 0, 0)
    TRJ(23, 1024, 0, 1024, 1024, WS_WT_OUT, 1024, 0, 0) TRJ(25, 4096, 0, 4096, 1024, WS_WT_FF1, 1024, 0, 0) TRJ(26, 1024, 0, 1024, 4096, WS_WT_FF2, 4096, 0, 0)
    TRJ(13, 512, 0, 512, 64, WS_WT_D, 64, 0, 0) TRJ(15, 512, 0, 512, 64, WS_WT_A, 64, 0, 0) TRJ(16, 512, 0, 512, 128, WS_WT_G, 128, 0, 0)
#undef TRJ
    }
    if (gw == NGW - 1) {
        const float* W = a->in[9]; bf16* WT = (bf16*)(ws + WS_WT_IN);
        for (int e = F.lane; e < 8 * 1024; e += 64) { const int n = e >> 10, k = e & 1023; WT[(size_t)(C_WI + n) * 1024 + k] = (bf16)f2bf(W[(size_t)k * 5192 + 1344 + n]); }
    }
    if (P0V == 0 || P0V == 2) {
    bf16* H = (bf16*)(ws + WS_H);
#pragma unroll 2
    for (int m = gw; m < MT_ROWS; m += NGW) { const float* xr = (m < MP) ? a->in[0] + (size_t)m * DM : a->in[1] + (size_t)(m - MP) * DM; rms_row_to_bf16(F.lane, xr, a->in[8], H + (size_t)m * DM); }
    }
    const int gt = F.vcu * NTHREADS + F.tid, NGT = F.G * NTHREADS;
    if (P0V == 0 || P0V == 3) {
        const int nit = NB_S * PAST * 128 / 8;
#pragma unroll 4
        for (int it = gt; it < 2 * nit; it += NGT) { const int which = it >= nit, e = (which ? it - nit : it) * 8; const float* src = a->in[2 + which] + e;
            const int b = e / (PAST * 128), rem = e % (PAST * 128); bf16* dst = (bf16*)(ws + (which ? WS_VS : WS_KS)) + (size_t)b * LSP * 128 + rem;
            const f32x4 x0 = *(const GAS f32x4*)src, x1 = *(const GAS f32x4*)(src + 4); v4u o; o.x = pk2(x0.x, x0.y); o.y = pk2(x0.z, x0.w); o.z = pk2(x1.x, x1.y); o.w = pk2(x1.z, x1.w); *(GAS v4u*)dst = o; }
        const int nit2 = NB_S * PAST * 64 / 8;
#pragma unroll 4
        for (int it = gt; it < nit2; it += NGT) { const int e = it * 8; const float* src = a->in[4] + e; const int b = e / (PAST * 64), rem = e % (PAST * 64); bf16* dst = (bf16*)(ws + WS_KIS) + (size_t)b * LSP * 64 + rem;
            const f32x4 x0 = *(const GAS f32x4*)src, x1 = *(const GAS f32x4*)(src + 4); v4u o; o.x = pk2(x0.x, x0.y); o.y = pk2(x0.z, x0.w); o.z = pk2(x1.x, x1.y); o.w = pk2(x1.z, x1.w); *(GAS v4u*)dst = o; }
        const int npad = NB_S * (LSP - LS) * 128 / 8;
        for (int it = gt; it < 2 * npad; it += NGT) { const int which = it >= npad, e = (which ? it - npad : it) * 8; const int b = e / ((LSP - LS) * 128), rem = e % ((LSP - LS) * 128);
            *(GAS v4u*)((bf16*)(ws + (which ? WS_VS : WS_KS)) + ((size_t)b * LSP + LS) * 128 + rem) = (v4u){0u, 0u, 0u, 0u}; }
        const int npad2 = NB_S * (LSP - LS) * 64 / 8;
        for (int it = gt; it < npad2; it += NGT) { const int e = it * 8; const int b = e / ((LSP - LS) * 64), rem = e % ((LSP - LS) * 64);
            *(GAS v4u*)((bf16*)(ws + WS_KIS) + ((size_t)b * LSP + LS) * 64 + rem) = (v4u){0u, 0u, 0u, 0u}; }
    }
}
typedef GAS unsigned gu32;
typedef GAS unsigned long long gu64;
#define RLX_AGENT __ATOMIC_RELAXED, __HIP_MEMORY_SCOPE_AGENT
__device__ __forceinline__ unsigned long long rt() { return __builtin_amdgcn_s_memrealtime(); }
#define XB_TMO      128
#define XB_XCNT(j)  (256  + 64 * (j))
#define XB_XSUB(j)  (1280 + 64 * (j))
#define XB_XGEN(j)  (2304 + 64 * (j))
#define XB_TOP      3328
#define XB_TOPGEN   3392
#define XCD_BAR_WORDS 3456
#define XB_SPIN_CAP (1u << 18)

__device__ __forceinline__ unsigned xb_ld(unsigned* p)              { return __hip_atomic_load(p, __ATOMIC_RELAXED, __HIP_MEMORY_SCOPE_AGENT); }
__device__ __forceinline__ unsigned xb_add(unsigned* p, unsigned v) { return __hip_atomic_fetch_add(p, v, __ATOMIC_RELAXED, __HIP_MEMORY_SCOPE_AGENT); }
__device__ __forceinline__ unsigned xb_xcc_id() { return (unsigned)__builtin_amdgcn_s_getreg((3 << 11) | 20) & 0xFu; }
#define XB_SPIN(cond, bar) do { unsigned _sp = 0; while (cond) { __builtin_amdgcn_s_sleep(1); \
    if ((++_sp & 255u) == 0u) { if (xb_ld(&(bar)[XB_TMO])) break; if (_sp > XB_SPIN_CAP) { atomicAdd(&(bar)[XB_TMO], 1u); break; } } } } while (0)

struct XcdBarrier {
    unsigned* bar; unsigned x;
    volatile LAS unsigned* st;
};

__device__ __forceinline__ XcdBarrier xcd_barrier_post(unsigned* bar, volatile LAS unsigned* st) {
    XcdBarrier b; b.bar = bar; b.x = xb_xcc_id(); b.st = st;
    if (threadIdx.x == 0) (void)xb_add(&bar[XB_XCNT(b.x)], 1u);
    return b;
}
__device__ __forceinline__ void xcd_barrier_complete(unsigned* bar, unsigned x, unsigned& nloc, unsigned& nx) {
    const unsigned G = gridDim.x * gridDim.y * gridDim.z;
    unsigned sum, cnt, mine, sp = 0u;
    for (;;) {
        sum = 0u; cnt = 0u; mine = 0u;
#pragma unroll
        for (unsigned j = 0; j < 16; ++j) { const unsigned c = xb_ld(&bar[XB_XCNT(j)]); sum += c; cnt += (c > 0u) ? 1u : 0u; mine = (j == x) ? c : mine; }
        if (sum == G) break;
        __builtin_amdgcn_s_sleep(1);
        if ((++sp & 255u) == 0u) { if (xb_ld(&bar[XB_TMO])) break; if (sp > XB_SPIN_CAP) { atomicAdd(&bar[XB_TMO], 1u); break; } }
    }
    nloc = mine > 0u ? mine : 1u; nx = cnt > 0u ? cnt : 1u;
}

__device__ __forceinline__ void xcd_barrier(const XcdBarrier& b) {
    asm volatile("s_waitcnt vmcnt(0)" ::: "memory");
    __syncthreads();
    if (threadIdx.x == 0) {
        unsigned* bar = b.bar;
        __builtin_amdgcn_s_waitcnt(0);
        unsigned nloc = b.st[0], nx = b.st[1];
        if (nloc == 0u) { xcd_barrier_complete(bar, b.x, nloc, nx); b.st[0] = nloc; b.st[1] = nx; }
        const unsigned old = xb_add(&bar[XB_XSUB(b.x)], 1u);
        const unsigned gen = old / nloc;
        if (old + 1u == (gen + 1u) * nloc) {
            __builtin_amdgcn_fence(__ATOMIC_RELEASE, "agent");
            asm volatile("s_waitcnt vmcnt(0)" ::: "memory");
            const unsigned og = xb_add(&bar[XB_TOP], 1u);
            const unsigned tg = og / nx;
            if (og + 1u == (tg + 1u) * nx) xb_add(&bar[XB_TOPGEN], 1u);
            else XB_SPIN(xb_ld(&bar[XB_TOPGEN]) == tg, bar);
            __builtin_amdgcn_fence(__ATOMIC_ACQUIRE, "agent");
            xb_add(&bar[XB_XGEN(b.x)], 1u);
            asm volatile("s_waitcnt vmcnt(0)" ::: "memory");
        } else {
            XB_SPIN(xb_ld(&bar[XB_XGEN(b.x)]) == gen, bar);
            __builtin_amdgcn_fence(__ATOMIC_ACQUIRE, "agent");
            asm volatile("s_waitcnt vmcnt(0)" ::: "memory");
        }
    }
    __syncthreads();
}

struct EpiInProj {
    static constexpr bool PERM = true, AFTER_DRAIN = false;
    unsigned char* ws; float* out; bf16* sga_p; bf16* sgb_p;
    __device__ __forceinline__ void operator()(const f32x4 (&acc)[2][2][4][2], const pg8::Unit& u, int wr, int wc, int fr, int fq) const {
        const int pn = u.pn;
#pragma unroll
        for (int ai = 0; ai < 2; ++ai)
#pragma unroll
            for (int m = 0; m < 4; ++m) {
                const int row = u.pm * 256 + ai * 128 + wr * 64 + m * 16 + fr;
                const bool smp = row >= MP; const int rs = row - MP, sb = rs >> 4, st = rs & 15;
#pragma unroll
                for (int bj = 0; bj < 2; ++bj) {
                    const int c0 = pn * 256 + bj * 128 + wc * 32 + fq * 8;
                    const f32x4 v0 = acc[ai][bj][m][0], v1 = acc[ai][bj][m][1];
                    if (pn < 2) {
                        v4u o; o.x = pk2(v0.x * QSCALE, v0.y * QSCALE); o.y = pk2(v0.z * QSCALE, v0.w * QSCALE); o.z = pk2(v1.x * QSCALE, v1.y * QSCALE); o.w = pk2(v1.z * QSCALE, v1.w * QSCALE);
                        *(GAS v4u*)((bf16*)(ws + WS_QB) + (size_t)row * 512 + c0) = o;
                    } else if (pn == 2) {
                        const int c = c0 - (bj ? C_V : C_K);
                        float* of = out + (smp ? (bj ? O_NVS : O_NKS) + (size_t)rs * 128 : (bj ? O_NVP : O_NKP) + (size_t)row * 128) + c;
                        *(GAS f32x4*)of = v0; *(GAS f32x4*)(of + 4) = v1;
                        bf16* ob = smp ? (bf16*)(ws + (bj ? WS_VS : WS_KS)) + ((size_t)sb * LSP + PAST + st) * 128 + c : (bf16*)(ws + (bj ? WS_VBP : WS_KBP)) + (size_t)row * 128 + c;
                        v4u o; o.x = pk2(v0.x, v0.y); o.y = pk2(v0.z, v0.w); o.z = pk2(v1.x, v1.y); o.w = pk2(v1.z, v1.w); *(GAS v4u*)ob = o;
                    } else if (pn < 5) {
                        v4u o; o.x = pk2(v0.x * 0.125f, v0.y * 0.125f); o.y = pk2(v0.z * 0.125f, v0.w * 0.125f); o.z = pk2(v1.x * 0.125f, v1.y * 0.125f); o.w = pk2(v1.z * 0.125f, v1.w * 0.125f);
                        *(GAS v4u*)((bf16*)(ws + WS_QIB) + (size_t)row * 512 + (c0 - C_QI)) = o;
                    } else if (pn == 5) {
                        if (c0 < C_WI) {
                            const int c = c0 - C_KI;
                            float* of = out + (smp ? O_NKIS + (size_t)rs * 64 : O_NKIP + (size_t)row * 64) + c;
                            *(GAS f32x4*)of = v0; *(GAS f32x4*)(of + 4) = v1;
                            bf16* ob = smp ? (bf16*)(ws + WS_KIS) + ((size_t)sb * LSP + PAST + st) * 64 + c : (bf16*)(ws + WS_KIBP) + (size_t)row * 64 + c;
                            v4u o; o.x = pk2(v0.x, v0.y); o.y = pk2(v0.z, v0.w); o.z = pk2(v1.x, v1.y); o.w = pk2(v1.z, v1.w); *(GAS v4u*)ob = o;
                        } else if (c0 == C_WI) {
                            const float s = 0.35355339059327373f; float* of = (float*)(ws + WS_WI) + (size_t)row * 8;
                            *(GAS f32x4*)of = v0 * s; *(GAS f32x4*)(of + 4) = v1 * s;
                        }
                    } else if (pn < 13) {
                        const int c = c0 - C_P;
                        v4u o; o.x = pk2(v0.x, v0.y); o.y = pk2(v0.z, v0.w); o.z = pk2(v1.x, v1.y); o.w = pk2(v1.z, v1.w);
                        *(GAS v4u*)((bf16*)(ws + WS_P) + (size_t)row * RWC + c) = o;
                        const bool last = smp ? (st == DSEQ - 1) : ((row & (SEQ - 1)) == SEQ - 1);
                        if (last) { float* of = out + (smp ? O_SHS + (size_t)sb * RWC : O_SHP + (size_t)(row >> 11) * RWC) + c; *(GAS f32x4*)of = v0; *(GAS f32x4*)(of + 4) = v1; }
                    } else {
                        const bool isb = pn >= 17; const int c = c0 - (isb ? C_GB : C_GA);
                        v4u o; o.x = pk2(sigmoidf_(v0.x), sigmoidf_(v0.y)); o.y = pk2(sigmoidf_(v0.z), sigmoidf_(v0.w)); o.z = pk2(sigmoidf_(v1.x), sigmoidf_(v1.y)); o.w = pk2(sigmoidf_(v1.z), sigmoidf_(v1.w));
                        bf16* ob = smp ? (bf16*)(ws + WS_SGS) + (size_t)(isb ? MS : 0) * DM + (size_t)rs * DM + c : (isb ? sgb_p : sga_p) + (size_t)row * DM + c;
                        *(GAS v4u*)ob = o;
                    }
                }
            }
    }
};
template <bool ACCUM> struct EpiGate {
    static constexpr bool PERM = true, AFTER_DRAIN = false;
    const bf16* sg_p; const bf16* sg_s; bf16* mix;
    __device__ __forceinline__ void operator()(const f32x4 (&acc)[2][2][4][2], const pg8::Unit& u, int wr, int wc, int fr, int fq) const {
#pragma unroll
        for (int ai = 0; ai < 2; ++ai)
#pragma unroll
            for (int m = 0; m < 4; ++m) {
                const int row = u.pm * 256 + ai * 128 + wr * 64 + m * 16 + fr; const bool smp = row >= MP;
#pragma unroll
                for (int bj = 0; bj < 2; ++bj) {
                    const int c0 = u.pn * 256 + bj * 128 + wc * 32 + fq * 8;
                    const v4u g = *(const GAS v4u*)((smp ? sg_s + (size_t)(row - MP) * DM : sg_p + (size_t)row * DM) + c0);
                    f32x4 v0 = acc[ai][bj][m][0], v1 = acc[ai][bj][m][1];
                    v0.x *= bflo(g.x); v0.y *= bfhi(g.x); v0.z *= bflo(g.y); v0.w *= bfhi(g.y); v1.x *= bflo(g.z); v1.y *= bfhi(g.z); v1.z *= bflo(g.w); v1.w *= bfhi(g.w);
                    bf16* op = mix + (size_t)row * DM + c0;
                    if (ACCUM) { const v4u p = *(const GAS v4u*)op; v0.x += bflo(p.x); v0.y += bfhi(p.x); v0.z += bflo(p.y); v0.w += bfhi(p.y); v1.x += bflo(p.z); v1.y += bfhi(p.z); v1.z += bflo(p.w); v1.w += bfhi(p.w); }
                    v4u o; o.x = pk2(v0.x, v0.y); o.y = pk2(v0.z, v0.w); o.z = pk2(v1.x, v1.y); o.w = pk2(v1.z, v1.w); *(GAS v4u*)op = o;
                }
            }
    }
    __device__ __forceinline__ void small(int srow, int col, f32x4 v) const {
        const v2u g = *(const GAS v2u*)(sg_s + (size_t)srow * DM + col); bf16* op = mix + (size_t)(MP + srow) * DM + col;
        v.x *= bflo(g.x); v.y *= bfhi(g.x); v.z *= bflo(g.y); v.w *= bfhi(g.y);
        if (ACCUM) { const v2u p = *(const GAS v2u*)op; v.x += bflo(p.x); v.y += bfhi(p.x); v.z += bflo(p.y); v.w += bfhi(p.y); }
        *(GAS v2u*)op = (v2u){pk2(v.x, v.y), pk2(v.z, v.w)};
    }
};
struct EpiResid {
    static constexpr bool PERM = false, AFTER_DRAIN = false;
    const float* src_p; const float* src_s; float* dst_p; float* dst_s;
    __device__ __forceinline__ void operator()(const f32x4 (&acc)[2][2][4][2], const pg8::Unit& u, int wr, int wc, int fr, int fq) const {
#pragma unroll
        for (int ai = 0; ai < 2; ++ai)
#pragma unroll
            for (int m = 0; m < 4; ++m) {
                const int row = u.pm * 256 + ai * 128 + wr * 64 + m * 16 + fr; const bool smp = row >= MP;
                const float* s = smp ? src_s + (size_t)(row - MP) * DM : src_p + (size_t)row * DM; float* d = smp ? dst_s + (size_t)(row - MP) * DM : dst_p + (size_t)row * DM;
#pragma unroll
                for (int bj = 0; bj < 2; ++bj)
#pragma unroll
                    for (int n = 0; n < 2; ++n) { const int c = u.pn * 256 + bj * 128 + wc * 32 + n * 16 + fq * 4; *(GAS f32x4*)(d + c) = *(const GAS f32x4*)(s + c) + acc[ai][bj][m][n]; }
            }
    }
    __device__ __forceinline__ void small(int srow, int col, f32x4 v) const { *(GAS f32x4*)(dst_s + (size_t)srow * DM + col) = *(const GAS f32x4*)(src_s + (size_t)srow * DM + col) + v; }
};
struct EpiRelu2 {
    static constexpr bool PERM = true, AFTER_DRAIN = false;
    bf16* O;
    __device__ __forceinline__ void operator()(const f32x4 (&acc)[2][2][4][2], const pg8::Unit& u, int wr, int wc, int fr, int fq) const {
#pragma unroll
        for (int ai = 0; ai < 2; ++ai)
#pragma unroll
            for (int m = 0; m < 4; ++m) {
                const int row = u.pm * 256 + ai * 128 + wr * 64 + m * 16 + fr;
#pragma unroll
                for (int bj = 0; bj < 2; ++bj) {
                    const int c0 = u.pn * 256 + bj * 128 + wc * 32 + fq * 8;
                    f32x4 v0 = acc[ai][bj][m][0], v1 = acc[ai][bj][m][1];
                    v0 = __builtin_elementwise_max(v0, (f32x4){0.f, 0.f, 0.f, 0.f}); v1 = __builtin_elementwise_max(v1, (f32x4){0.f, 0.f, 0.f, 0.f}); v0 = v0 * v0; v1 = v1 * v1;
                    v4u o; o.x = pk2(v0.x, v0.y); o.y = pk2(v0.z, v0.w); o.z = pk2(v1.x, v1.y); o.w = pk2(v1.z, v1.w); *(GAS v4u*)(O + (size_t)row * DFF + c0) = o;
                }
            }
    }
    __device__ __forceinline__ void small(int srow, int col, f32x4 v) const {
        v = __builtin_elementwise_max(v, (f32x4){0.f, 0.f, 0.f, 0.f}); v = v * v; *(GAS v2u*)(O + (size_t)(MP + srow) * DFF + col) = (v2u){pk2(v.x, v.y), pk2(v.z, v.w)}; }
};

template <class Epi> __device__ __forceinline__ void sample_gemm(Frame& F, const bf16* A, const bf16* Bt, int N, int K, const Epi& E) {
    int tid_ = F.tid; asm volatile("" : "+v"(tid_));
    const int tid = tid_, lane = tid & 63, w = __builtin_amdgcn_readfirstlane(tid >> 6), fr = lane & 15, fq = lane >> 4;
    const int ntn = N / 64, ntiles = 16 * ntn, kw = K / 8, nks = kw / 32;
    LAS float* part = (LAS float*)F.lds;
    for (int tile = F.vcu; tile < ntiles; tile += F.G) {
        const int tm = tile / ntn, tn = tile % ntn;
        f32x4 acc[2][4];
#pragma unroll
        for (int i = 0; i < 2; ++i)
#pragma unroll
            for (int j = 0; j < 4; ++j) acc[i][j] = (f32x4){0.f, 0.f, 0.f, 0.f};
        const bf16* ap = A + (size_t)(32 * tm + fr) * K + w * kw + 8 * fq; const bf16* bp = Bt + (size_t)(64 * tn + fr) * K + w * kw + 8 * fq;
#pragma unroll 2
        for (int ks = 0; ks < nks; ++ks) {
            bf16x8 af[2], bfr[4];
#pragma unroll
            for (int i = 0; i < 2; ++i) af[i] = *(const GAS bf16x8*)(ap + (size_t)16 * i * K + 32 * ks);
#pragma unroll
            for (int j = 0; j < 4; ++j) bfr[j] = *(const GAS bf16x8*)(bp + (size_t)16 * j * K + 32 * ks);
#pragma unroll
            for (int i = 0; i < 2; ++i)
#pragma unroll
                for (int j = 0; j < 4; ++j) acc[i][j] = __builtin_amdgcn_mfma_f32_16x16x32_bf16(af[i], bfr[j], acc[i][j], 0, 0, 0);
        }
#pragma unroll
        for (int i = 0; i < 2; ++i)
#pragma unroll
            for (int j = 0; j < 4; ++j)
#pragma unroll
                for (int r = 0; r < 4; ++r) part[w * (32 * 68) + (16 * i + 4 * fq + r) * 68 + 16 * j + fr] = acc[i][j][r];
        __syncthreads();
        { const int row = tid >> 4, c4 = (tid & 15) * 4; f32x4 v = {0.f, 0.f, 0.f, 0.f};
#pragma unroll
          for (int ww = 0; ww < 8; ++ww) v += *(const LAS f32x4*)(part + ww * (32 * 68) + row * 68 + c4);
          E.small(32 * tm + row, 64 * tn + c4, v); }
        __syncthreads();
    }
}

struct EpiResidNorm {
    static constexpr bool PERM = false, AFTER_DRAIN = false;
    const float* src_p; const float* src_s; float* dst_p; float* dst_s; const float* g2; bf16* hn; float* ssq;
    __device__ __forceinline__ void operator()(const f32x4 (&acc)[2][2][4][2], const pg8::Unit& u, int wr, int wc, int fr, int fq) const {
        f32x4 gv[2][2];
#pragma unroll
        for (int bj = 0; bj < 2; ++bj)
#pragma unroll
            for (int n = 0; n < 2; ++n) gv[bj][n] = *(const GAS f32x4*)(g2 + u.pn * 256 + bj * 128 + wc * 32 + n * 16 + fq * 4);
#pragma unroll
        for (int ai = 0; ai < 2; ++ai)
#pragma unroll
            for (int m = 0; m < 4; ++m) {
                const int row = u.pm * 256 + ai * 128 + wr * 64 + m * 16 + fr;
                const float* s = src_p + (size_t)row * DM; float* d = dst_p + (size_t)row * DM; bf16* hrow = hn + (size_t)row * DM;
                float q = 0.f;
#pragma unroll
                for (int bj = 0; bj < 2; ++bj)
#pragma unroll
                    for (int n = 0; n < 2; ++n) { const int c = u.pn * 256 + bj * 128 + wc * 32 + n * 16 + fq * 4; const f32x4 x1 = *(const GAS f32x4*)(s + c) + acc[ai][bj][m][n];
                        *(GAS f32x4*)(d + c) = x1; q += (x1.x * x1.x + x1.y * x1.y) + (x1.z * x1.z + x1.w * x1.w);
                        const f32x4 hv = x1 * gv[bj][n]; *(GAS v2u*)(hrow + c) = (v2u){pk2(hv.x, hv.y), pk2(hv.z, hv.w)}; }
                q += __shfl_xor(q, 16); q += __shfl_xor(q, 32);
                if (fq == 0) ssq[(size_t)row * 16 + u.pn * 4 + wc] = q;
            }
    }
    __device__ __forceinline__ void small(int srow, int col, f32x4 v) const {
        const f32x4 x1 = *(const GAS f32x4*)(src_s + (size_t)srow * DM + col) + v; *(GAS f32x4*)(dst_s + (size_t)srow * DM + col) = x1;
        const f32x4 hv = x1 * *(const GAS f32x4*)(g2 + col); *(GAS v2u*)(hn + (size_t)(MP + srow) * DM + col) = (v2u){pk2(hv.x, hv.y), pk2(hv.z, hv.w)};
        float q = (x1.x * x1.x + x1.y * x1.y) + (x1.z * x1.z + x1.w * x1.w);
        q += __shfl_xor(q, 1); q += __shfl_xor(q, 2); q += __shfl_xor(q, 4); q += __shfl_xor(q, 8);
        if ((threadIdx.x & 15) == 0) ssq[(size_t)(MP + srow) * 16 + (col >> 6)] = q;
    }
};
struct EpiRelu2N {
    static constexpr bool PERM = true, AFTER_DRAIN = false;
    bf16* O; const float* ssq;
    __device__ __forceinline__ float rstd_of(size_t row) const { const f32x4 a = *(const GAS f32x4*)(ssq + row * 16), b = *(const GAS f32x4*)(ssq + row * 16 + 4), c = *(const GAS f32x4*)(ssq + row * 16 + 8), d = *(const GAS f32x4*)(ssq + row * 16 + 12);
        const float s = (((a.x + a.y) + (a.z + a.w)) + ((b.x + b.y) + (b.z + b.w))) + (((c.x + c.y) + (c.z + c.w)) + ((d.x + d.y) + (d.z + d.w))); return __builtin_amdgcn_rsqf(s * (1.f / DM) + NORM_EPS); }
    __device__ __forceinline__ void operator()(const f32x4 (&acc)[2][2][4][2], const pg8::Unit& u, int wr, int wc, int fr, int fq) const {
#pragma unroll
        for (int ai = 0; ai < 2; ++ai)
#pragma unroll
            for (int m = 0; m < 4; ++m) {
                const int row = u.pm * 256 + ai * 128 + wr * 64 + m * 16 + fr; const float rs = rstd_of(row);
#pragma unroll
                for (int bj = 0; bj < 2; ++bj) {
                    const int c0 = u.pn * 256 + bj * 128 + wc * 32 + fq * 8;
                    f32x4 v0 = acc[ai][bj][m][0] * rs, v1 = acc[ai][bj][m][1] * rs;
                    v0 = __builtin_elementwise_max(v0, (f32x4){0.f, 0.f, 0.f, 0.f}); v1 = __builtin_elementwise_max(v1, (f32x4){0.f, 0.f, 0.f, 0.f}); v0 = v0 * v0; v1 = v1 * v1;
                    v4u o; o.x = pk2(v0.x, v0.y); o.y = pk2(v0.z, v0.w); o.z = pk2(v1.x, v1.y); o.w = pk2(v1.z, v1.w); *(GAS v4u*)(O + (size_t)row * DFF + c0) = o;
                }
            }
    }
    __device__ __forceinline__ void small(int srow, int col, f32x4 v) const {
        v = v * rstd_of(MP + srow); v = __builtin_elementwise_max(v, (f32x4){0.f, 0.f, 0.f, 0.f}); v = v * v; *(GAS v2u*)(O + (size_t)(MP + srow) * DFF + col) = (v2u){pk2(v.x, v.y), pk2(v.z, v.w)}; }
};

__device__ __forceinline__ void rms_row_to_f32(int lane, const float* xrow, const float* g, float* orow) {
    const GAS f32x4* xr = (const GAS f32x4*)xrow + lane; const GAS f32x4* gr = (const GAS f32x4*)g + lane;
    f32x4 v[4]; float s = 0.f;
#pragma unroll
    for (int j = 0; j < 4; ++j) { v[j] = xr[64 * j]; s += (v[j].x * v[j].x + v[j].y * v[j].y) + (v[j].z * v[j].z + v[j].w * v[j].w); }
    const float rstd = 1.0f / sqrtf(wave_sum(s) * (1.f / DM) + NORM_EPS);
    GAS f32x4* o = (GAS f32x4*)orow + lane;
#pragma unroll
    for (int j = 0; j < 4; ++j) { const f32x4 gg = gr[64 * j]; o[64 * j] = v[j] * rstd * gg; }
}
#define PHASE6 { pg8::StaticOrder S; S.init(MP, DM, F.G, (int)blockIdx.x); \
    { pg8::Gemm g{(const bf16*)(ws + WS_ATT), (const bf16*)(ws + WS_WT_AB), MP, DM, 512}; EpiGate<false> E{sga_p, (const bf16*)(ws + WS_SGS), (bf16*)(ws + WS_MIX)}; \
      pg8::gemm_phase<EpiGate<false>, pg8::StaticOrder, true, true>(F.lds, g, S, E); sample_gemm(F, (const bf16*)(ws + WS_ATT) + (size_t)MP * 512, g.Bt, DM, 512, E); } \
    { pg8::Gemm g{(const bf16*)(ws + WS_RW), (const bf16*)(ws + WS_WT_AB + MiB), MP, DM, 512}; EpiGate<true> E{sgb_p, (const bf16*)(ws + WS_SGS) + (size_t)MS * DM, (bf16*)(ws + WS_MIX)}; \
      pg8::gemm_phase<EpiGate<true>, pg8::StaticOrder, true, true>(F.lds, g, S, E); sample_gemm(F, (const bf16*)(ws + WS_RW) + (size_t)MP * 512, g.Bt, DM, 512, E); } }
#define PHASE7 { pg8::StaticOrder S; S.init(MP, DM, F.G, (int)blockIdx.x); pg8::Gemm g{(const bf16*)(ws + WS_MIX), (const bf16*)(ws + WS_WT_OUT), MP, DM, DM}; \
    EpiResidNorm E{args->in[0], args->in[1], args->out + O_YP, (float*)(ws + WS_X1S), args->in[24], (bf16*)(ws + WS_H2), (float*)(ws + WS_SSQ)}; pg8::gemm_phase<EpiResidNorm, pg8::StaticOrder, true, true>(F.lds, g, S, E); \
    sample_gemm(F, g.A + (size_t)MP * DM, g.Bt, DM, DM, E); }
#define PHASE8 { }
#define PHASE9 { pg8::StaticOrder S; S.init(MP, DFF, F.G, (int)blockIdx.x); pg8::Gemm g{(const bf16*)(ws + WS_H2), (const bf16*)(ws + WS_WT_FF1), MP, DFF, DM}; \
    EpiRelu2N E{(bf16*)(ws + WS_HFF), (const float*)(ws + WS_SSQ)}; pg8::gemm_phase<EpiRelu2N, pg8::StaticOrder, true, true>(F.lds, g, S, E); sample_gemm(F, g.A + (size_t)MP * DM, g.Bt, DFF, DM, E); }
#define PHASE10 { pg8::StaticOrder S; S.init(MP, DM, F.G, (int)blockIdx.x); pg8::Gemm g{(const bf16*)(ws + WS_HFF), (const bf16*)(ws + WS_WT_FF2), MP, DM, DFF}; \
    EpiResid E{args->out + O_YP, (const float*)(ws + WS_X1S), args->out + O_YP, (float*)(ws + WS_X1S)}; pg8::gemm_phase<EpiResid, pg8::StaticOrder, true, true>(F.lds, g, S, E); \
    sample_gemm(F, g.A + (size_t)MP * DFF, g.Bt, DM, DFF, E); }
#define PHASE11 { const int gw = F.vcu * NWAVES + F.wave, NGW = F.G * NWAVES; \
    for (int m = gw; m < MT_ROWS; m += NGW) { const float* xr = (m < MP) ? args->out + O_YP + (size_t)m * DM : (const float*)(ws + WS_X1S) + (size_t)(m - MP) * DM; \
        float* yr = (m < MP) ? args->out + O_YP + (size_t)m * DM : args->out + O_YS + (size_t)(m - MP) * DM; rms_row_to_f32(F.lane, xr, args->in[27], yr); } }
#define PHASE10DUP { pg8::StaticOrder S; S.init(MP, DM, F.G, (int)blockIdx.x); pg8::Gemm g{(const bf16*)(ws + WS_HFF), (const bf16*)(ws + WS_WT_FF2), MP, DM, DFF}; \
    EpiResid E{args->out + O_YP, (const float*)(ws + WS_X1S), (float*)(ws + WS_MIX), (float*)(ws + WS_X1S + 4 * MiB)}; pg8::gemm_phase<EpiResid, pg8::StaticOrder, true, true>(F.lds, g, S, E); \
    sample_gemm(F, g.A + (size_t)MP * DFF, g.Bt, DM, DFF, E); }

__device__ __forceinline__ int t5_bucket(int rel) {
    const int n = rel < 0 ? -rel : rel; int r = rel > 0 ? 16 : 0;
    if (n < 8) return r + n;
    return r + 8 + (n >= 12) + (n >= 16) + (n >= 23) + (n >= 32) + (n >= 46) + (n >= 64) + (n >= 91);
}
__device__ __forceinline__ unsigned ordkey(float f) { const unsigned u = __builtin_bit_cast(unsigned, f); return (u & 0x80000000u) ? ~u : (u | 0x80000000u); }

__device__ __forceinline__ void nv_attn_phase(Frame& F, CArgsP a) {
    struct Sh { float qi[512]; float q[512]; float wi[8]; unsigned key[LSP]; unsigned char sel[LSP]; float lg[LSP]; unsigned cnt; float red[256]; float o[4][64]; };
    const int half = F.tid >> 8, tid = F.tid & 255;
    LAS Sh* sh = (LAS Sh*)(F.lds + half * 32768);
    unsigned char* ws = a->ws; const float* relb = a->in[7];
    for (int pr = blockIdx.x; pr < MT_ROWS / 2; pr += F.G) {
        const int m = 2 * pr + half;
        const bool smp = m >= MP; const int b = smp ? (m - MP) >> 4 : m >> 11, t = smp ? (m - MP) & 15 : m & 2047;
        const int qpos = smp ? PAST + t : t; const int n = smp ? LS : 64 * (t / 64 + 1);
        const bf16* Ki = smp ? (const bf16*)(ws + WS_KIS) + (size_t)b * LSP * 64 : (const bf16*)(ws + WS_KIBP) + (size_t)b * SEQ * 64;
        const bf16* Kb = smp ? (const bf16*)(ws + WS_KS) + (size_t)b * LSP * 128 : (const bf16*)(ws + WS_KBP) + (size_t)b * SEQ * 128;
        const bf16* Vb = smp ? (const bf16*)(ws + WS_VS) + (size_t)b * LSP * 128 : (const bf16*)(ws + WS_VBP) + (size_t)b * SEQ * 128;
        __syncthreads();
        for (int i = tid; i < 512; i += 256) { sh->qi[i] = bf2f(((const bf16*)(ws + WS_QIB))[(size_t)m * 512 + i]); sh->q[i] = bf2f(((const bf16*)(ws + WS_QB))[(size_t)m * 512 + i]); }
        if (tid < 8) sh->wi[tid] = ((const float*)(ws + WS_WI))[(size_t)m * 8 + tid];
        __syncthreads();
        for (int s = tid; s < n; s += 256) {
            float kd[64];
#pragma unroll
            for (int d = 0; d < 64; ++d) kd[d] = bf2f(Ki[(size_t)s * 64 + d]);
            float sc = 0.f;
            for (int h = 0; h < 8; ++h) { float dot = 0.f;
#pragma unroll
                for (int d = 0; d < 64; ++d) dot = fmaf(sh->qi[h * 64 + d], kd[d], dot);
                sc = fmaf(sh->wi[h], fmaxf(dot, 0.f), sc); }
            sh->key[s] = ordkey(sc); sh->sel[s] = 1;
        }
        __syncthreads();
        if (n > 256) {
            unsigned prefix = 0u;
            for (int bit = 31; bit >= 0; --bit) {
                const unsigned cand = prefix | (1u << bit);
                if (tid == 0) sh->cnt = 0u;
                __syncthreads();
                unsigned c = 0; for (int s = tid; s < n; s += 256) c += sh->key[s] >= cand;
                atomicAdd((unsigned*)&sh->cnt, c);
                __syncthreads();
                if (sh->cnt >= 256u) prefix = cand;
                __syncthreads();
            }
            if (tid == 0) { int gt = 0; for (int s = 0; s < n; ++s) gt += sh->key[s] > prefix; int need = 256 - gt;
                for (int s = 0; s < n; ++s) { const unsigned k = sh->key[s]; unsigned char v = 0; if (k > prefix) v = 1; else if (k == prefix && need > 0) { v = 1; --need; } sh->sel[s] = v; } }
            __syncthreads();
        }
        for (int h = 0; h < 8; ++h) {
            const int j = h >> 2; float mx = -3.0e38f;
            for (int s = tid; s < n; s += 256) { float lg = -3.0e38f;
                if (sh->sel[s]) { float dot = 0.f;
#pragma unroll 8
                    for (int d = 0; d < 64; ++d) dot = fmaf(sh->q[h * 64 + d], bf2f(Kb[(size_t)s * 128 + j * 64 + d]), dot);
                    lg = dot + relb[t5_bucket(s - qpos) * 8 + h] * 1.4426950408889634f; }
                sh->lg[s] = lg; mx = fmaxf(mx, lg); }
            sh->red[tid] = mx; __syncthreads();
            for (int o = 128; o > 0; o >>= 1) { if (tid < o) sh->red[tid] = fmaxf(sh->red[tid], sh->red[tid + o]); __syncthreads(); }
            mx = sh->red[0]; __syncthreads();
            float sum = 0.f;
            for (int s = tid; s < n; s += 256) { const float p = sh->sel[s] ? exp2f(sh->lg[s] - mx) : 0.f; sh->lg[s] = p; sum += p; }
            sh->red[tid] = sum; __syncthreads();
            for (int o = 128; o > 0; o >>= 1) { if (tid < o) sh->red[tid] += sh->red[tid + o]; __syncthreads(); }
            sum = sh->red[0]; __syncthreads();
            const int d = tid & 63, grp = tid >> 6; float acc = 0.f;
            for (int s = grp; s < n; s += 4) { const float p = sh->lg[s]; if (p != 0.f) acc = fmaf(p, bf2f(Vb[(size_t)s * 128 + j * 64 + d]), acc); }
            sh->o[grp][d] = acc; __syncthreads();
            if (tid < 64) ((bf16*)(ws + WS_ATT))[(size_t)m * 512 + h * 64 + tid] = (bf16)f2bf((sh->o[0][tid] + sh->o[1][tid] + sh->o[2][tid] + sh->o[3][tid]) / sum);
            __syncthreads();
        }
    }
}

struct RwTok { float r, k, v, decay, a, g, kk, kh, b, bonus; };
__device__ __forceinline__ RwTok rw_token_prep(CArgsP a, int m, int c, LAS float* xs  , LAS float* red  ) {
    unsigned char* ws = a->ws; const bf16* P = (const bf16*)(ws + WS_P);
    const bool smp = m >= MP; const int b = smp ? (m - MP) >> 4 : m >> 11, t = smp ? (m - MP) & 15 : m & 2047;
    const float* mu = a->in[11];
    __syncthreads();
    for (int col = c; col < RWC; col += 512) { const float p = bf2f(P[(size_t)m * RWC + col]); const float pv = (t > 0) ? bf2f(P[(size_t)(m - 1) * RWC + col]) : (smp ? a->in[6][(size_t)b * RWC + col] : 0.f);
        xs[col] = p + (pv - p) * mu[col]; }
    __syncthreads();
    RwTok o; o.r = xs[c]; o.k = xs[512 + c]; o.v = xs[1024 + c];
    float wl = a->in[12][c], al = a->in[14][c], g = 0.f;
#pragma unroll 2
    for (int mm = 0; mm < 64; ++mm) { wl = fmaf(tanhf(xs[1536 + mm]), a->in[13][mm * 512 + c], wl); al = fmaf(xs[1600 + mm], a->in[15][mm * 512 + c], al); }
#pragma unroll 4
    for (int mm = 0; mm < 128; ++mm) g = fmaf(sigmoidf_(xs[1664 + mm]), a->in[16][mm * 512 + c], g);
    const float sp = (-wl > 20.f) ? -wl : log1pf(__expf(-wl));
    const float w = -sp - 0.5f; o.decay = __expf(-__expf(w)); o.a = sigmoidf_(al); o.g = g;
    const float kkr = o.k * a->in[17][c];
    red[c] = kkr * kkr; __syncthreads();
    float ss = 0.f;
#pragma unroll 8
    for (int j = 0; j < 64; ++j) ss += red[(c & ~63) + j];
    __syncthreads();
    o.kk = kkr / fmaxf(sqrtf(ss), 1e-12f);
    o.kh = o.k * (1.0f + (o.a - 1.0f) * a->in[18][c]); o.b = o.kk * o.a;
    red[c] = o.r * o.kh * a->in[19][c]; __syncthreads();
    float bs = 0.f;
#pragma unroll 8
    for (int j = 0; j < 64; ++j) bs += red[(c & ~63) + j];
    __syncthreads();
    o.bonus = bs * o.v;
    return o;
}
constexpr size_t WS_NR = 124 * MiB, WS_NKH = 141 * MiB, WS_NV = 158 * MiB, WS_NKK = 175 * MiB, WS_NB = 192 * MiB, WS_NDEC = 33 * MiB;
__device__ __forceinline__ void nv_rw_prep_phase(Frame& F, CArgsP a) {
    LAS float* xs = (LAS float*)F.lds; LAS float* red = xs + RWC; unsigned char* ws = a->ws; const int c = F.tid;
    for (int m = blockIdx.x; m < MT_ROWS; m += F.G) {
        const RwTok o = rw_token_prep(a, m, c, xs, red); const size_t i = (size_t)m * 512 + c;
        ((bf16*)(ws + WS_NR))[i] = (bf16)f2bf(o.r); ((bf16*)(ws + WS_NKH))[i] = (bf16)f2bf(o.kh); ((bf16*)(ws + WS_NV))[i] = (bf16)f2bf(o.v);
        ((bf16*)(ws + WS_NKK))[i] = (bf16)f2bf(o.kk); ((bf16*)(ws + WS_NB))[i] = (bf16)f2bf(o.b); ((float*)(ws + WS_NDEC))[i] = o.decay;
    }
}
__device__ __forceinline__ void nv_rw_scan_phase(Frame& F, CArgsP a) {
    const int chain = (int)blockIdx.x + 256 * F.wave;
    if (F.wave < 2 && chain < 320) {
    LAS float* vec = (LAS float*)F.lds + F.wave * 320;
    unsigned char* ws = a->ws; const int i = F.lane;
    const bool smp = chain >= 64; const int b = smp ? (chain - 64) >> 3 : chain >> 3, h = chain & 7; const int T = smp ? DSEQ : SEQ; const size_t m0 = smp ? MP + (size_t)b * DSEQ : (size_t)b * SEQ;
    float S[64];
    { const float* s0 = a->in[5] + (((unsigned)(smp ? b : 0) * 8 + h) * 64 + i) * 64; const float msk = smp ? 1.f : 0.f;
#pragma unroll
      for (int j = 0; j < 64; j += 4) { const f32x4 x = *(const GAS f32x4*)(s0 + j); S[j] = x.x * msk; S[j + 1] = x.y * msk; S[j + 2] = x.z * msk; S[j + 3] = x.w * msk; } }
    const bf16* pKK = (const bf16*)(ws + WS_NKK); const bf16* pB = (const bf16*)(ws + WS_NB); const bf16* pKH = (const bf16*)(ws + WS_NKH); const bf16* pR = (const bf16*)(ws + WS_NR); const bf16* pV = (const bf16*)(ws + WS_NV);
    const float* pD = (const float*)(ws + WS_NDEC); bf16* pY = (bf16*)(ws + WS_RW);
#pragma unroll 1
    for (int t = 0; t < T; ++t) {
        const unsigned idx = ((unsigned)m0 + (unsigned)t) * 512u + (unsigned)(h * 64 + i);
        vec[0 * 64 + i] = bf2f(pKK[idx]); vec[1 * 64 + i] = pD[idx]; vec[2 * 64 + i] = bf2f(pB[idx]);
        vec[3 * 64 + i] = bf2f(pKH[idx]); vec[4 * 64 + i] = bf2f(pR[idx]);
        const float v = bf2f(pV[idx]);
        LDS_WAIT(); __builtin_amdgcn_wave_barrier();
        float sa = 0.f;
#pragma unroll
        for (int j = 0; j < 64; ++j) { sa = fmaf(S[j], vec[j], sa); if ((j & 7) == 7) __builtin_amdgcn_sched_barrier(0); }
        float y = 0.f;
#pragma unroll
        for (int j = 0; j < 64; ++j) { S[j] = S[j] * vec[64 + j] - sa * vec[128 + j] + v * vec[192 + j]; y = fmaf(S[j], vec[256 + j], y); if ((j & 3) == 3) __builtin_amdgcn_sched_barrier(0); }
        pY[idx] = (bf16)f2bf(y);
        LDS_WAIT(); __builtin_amdgcn_wave_barrier();
    }
    float* o = a->out + (smp ? O_WKVS : O_WKVP) + (((unsigned)b * 8 + h) * 64 + i) * 64;
#pragma unroll
    for (int j = 0; j < 64; j += 4) *(GAS f32x4*)(o + j) = (f32x4){S[j], S[j + 1], S[j + 2], S[j + 3]};
    }
}
__device__ __forceinline__ void nv_rw_post_phase(Frame& F, CArgsP a) {
    LAS float* xs = (LAS float*)F.lds; LAS float* red = xs + RWC; const int c = F.tid;
    for (int m = blockIdx.x; m < MT_ROWS; m += F.G) {
        const RwTok o = rw_token_prep(a, m, c, xs, red);
        const float y = bf2f(((const bf16*)(a->ws + WS_RW))[(size_t)m * 512 + c]);
        red[c] = y; __syncthreads();
        float s = 0.f;
#pragma unroll 8
        for (int j = 0; j < 64; ++j) s += red[(c & ~63) + j];
        __syncthreads();
        const float mean = s * (1.f / 64.f), dv = y - mean;
        red[c] = dv * dv; __syncthreads();
        float q = 0.f;
#pragma unroll 8
        for (int j = 0; j < 64; ++j) q += red[(c & ~63) + j];
        const float yn = dv * (1.0f / sqrtf(q * (1.f / 64.f) + 64e-5f)) * a->in[20][c] + a->in[21][c];
        ((bf16*)(a->ws + WS_RW))[(size_t)m * 512 + c] = (bf16)f2bf((yn + o.bonus) * o.g);
    }
}

namespace att {
constexpr int SC_RS = 2120;
constexpr int L_SC = 0;
constexpr int SLOT = 16384;
constexpr int L_K = 0, L_V = 3 * SLOT, L_OST = 6 * SLOT;
constexpr int L_MSK = 135680;
constexpr int L_BIAS = L_MSK + 32 * 33 * 8;
constexpr int L_WS = L_BIAS + 8192;
constexpr int L_Q = L_WS + 2048;
static_assert(L_OST + 8 * 4096 <= L_MSK && L_Q + 16 <= MISC_OFF, "attention LDS map");
constexpr int N_UNITS = 512 + 32;
constexpr float NEGL = -1.0e30f;
constexpr float LOG2E = 1.4426950408889634f;
__device__ __forceinline__ int crow(int r, int hi) { return (r & 3) + 8 * (r >> 2) + 4 * hi; }
typedef short v4i16_t __attribute__((ext_vector_type(4)));
typedef float f32x2_t __attribute__((ext_vector_type(2))); typedef __bf16 bf16x2_t __attribute__((ext_vector_type(2)));
__device__ __forceinline__ unsigned cvtpk(float lo, float hi) { f32x2_t v = {lo, hi}; bf16x2_t b = __builtin_convertvector(v, bf16x2_t); return __builtin_bit_cast(unsigned, b); }
__device__ __forceinline__ float max3f(float a, float b, float c) { float r; asm("v_max3_f32 %0, %1, %2, %3" : "=v"(r) : "v"(a), "v"(b), "v"(c)); return r; }
__device__ __forceinline__ float maskp(float p, unsigned mw, int sh) { unsigned t; asm("v_bfe_i32 %0, %1, %2, 1" : "=v"(t) : "v"(mw), "i"(sh)); return __uint_as_float(__float_as_uint(p) & t); }
__device__ __forceinline__ float xhalf_max(float v) { auto rr = __builtin_amdgcn_permlane32_swap(__float_as_uint(v), __float_as_uint(v), false, false); return fmaxf(__uint_as_float(rr[0]), __uint_as_float(rr[1])); }
__device__ __forceinline__ float xhalf_sum(float v) { auto rr = __builtin_amdgcn_permlane32_swap(__float_as_uint(v), __float_as_uint(v), false, false); return __uint_as_float(rr[0]) + __uint_as_float(rr[1]); }
__device__ __forceinline__ s16x4 vtr(LAS const unsigned char* p) { return __builtin_bit_cast(s16x4, __builtin_amdgcn_ds_read_tr16_b64_v4i16((LAS v4i16_t*)p)); }

template <int NT, int FV = 0> __device__ __forceinline__ void f1_select(LAS unsigned char* ldsb, int lane, int q, int n, int nt) {
    unsigned key[NT];
#pragma unroll
    for (int r = 0; r < NT; ++r) { const int s = 64 * r + lane; key[r] = (r < nt && s < n) ? (unsigned)*(LAS const unsigned short*)(ldsb + L_SC + (q * SC_RS + s) * 2) : 0u; }
    unsigned prefix = 0u; bool early = false;
#pragma unroll 1
    for (int bit = 15; bit >= (FV == 5 ? 8 : 0); --bit) {
        const unsigned cand = prefix | (1u << bit); unsigned lc = 0u;
#pragma unroll
        for (int r = 0; r < NT; ++r) asm volatile("v_cmp_le_u32 vcc, %1, %2\n\tv_addc_co_u32 %0, vcc, 0, %0, vcc" : "+v"(lc) : "s"(cand), "v"(key[r]) : "vcc");
        int cnt = 0;
#pragma unroll
        for (int b = 0; b < 6; ++b) cnt += __popcll(__ballot((lc >> b) & 1u)) << b;
        if (cnt >= 256) prefix = cand;
        if (cnt == 256) { early = true; break; }
    }
    LAS unsigned long long* mrow = (LAS unsigned long long*)(ldsb + L_MSK) + q * 33;
    if (early) {
#pragma unroll
        for (int r = 0; r < NT; ++r) { const unsigned long long sel = __ballot(key[r] >= prefix); if (lane == 0) mrow[r] = sel; }
    } else {
        int gt = 0;
#pragma unroll
        for (int r = 0; r < NT; ++r) gt += __popcll(__ballot(key[r] > prefix));
        int need = 256 - gt;
#pragma unroll
        for (int r = 0; r < NT; ++r) {
            const bool iseq = key[r] == prefix; const unsigned long long eq = __ballot(iseq), gtm = __ballot(key[r] > prefix);
            const int rank = __popcll(eq & ((1ull << lane) - 1ull));
            const unsigned long long take = __ballot(iseq && rank < need);
            need -= __popcll(take);
            if (lane == 0) mrow[r] = gtm | take;
        }
    }
}
__device__ __forceinline__ unsigned key16x2(float a, float b) {
    int ia = (int)(a * 4096.0f) + 32768, ib = (int)(b * 4096.0f) + 32768;
    ia = ia < 0 ? 0 : (ia > 65535 ? 65535 : ia); ib = ib < 0 ? 0 : (ib > 65535 ? 65535 : ib);
    return (unsigned)ia | ((unsigned)ib << 16);
}
template <int FV = 0> __device__ __forceinline__ void f1_block(Frame& F, const bf16* Qi_rows, const float* wi_rows, int nqmask, const bf16* Ki, int n, int nt) {
    int tid_ = F.tid; asm volatile("" : "+v"(tid_));
    const int lane = tid_ & 63, wave = __builtin_amdgcn_readfirstlane(tid_ >> 6), fr = lane & 15, fq = lane >> 4;
    {
        bf16x8 qb[2][8][2]; float wv[2][8];
#pragma unroll
        for (int g = 0; g < 2; ++g) { const int qi = (16 * g + fr) & nqmask;
#pragma unroll
            for (int h = 0; h < 8; ++h)
#pragma unroll
                for (int ks = 0; ks < 2; ++ks) qb[g][h][ks] = *(const GAS bf16x8*)(Qi_rows + qi * 512 + h * 64 + 32 * ks + 8 * fq);
            const f32x4 w0 = *(const GAS f32x4*)(wi_rows + qi * 8), w1 = *(const GAS f32x4*)(wi_rows + qi * 8 + 4);
            wv[g][0] = w0.x; wv[g][1] = w0.y; wv[g][2] = w0.z; wv[g][3] = w0.w; wv[g][4] = w1.x; wv[g][5] = w1.y; wv[g][6] = w1.z; wv[g][7] = w1.w; }
        const int nkb = (n + 15) >> 4;
        const bf16* kp = Ki + (size_t)fr * 64 + 8 * fq;
        bf16x8 a0 = {}, a1 = {};
        if (wave < nkb) { a0 = *(const GAS bf16x8*)(kp + (size_t)wave * 1024); a1 = *(const GAS bf16x8*)(kp + (size_t)wave * 1024 + 32); }
        if (FV != 4 && FV != 5) for (int kb = wave; kb < nkb; kb += NWAVES) {
            bf16x8 n0 = {}, n1 = {};
            if (kb + NWAVES < nkb) { n0 = *(const GAS bf16x8*)(kp + (size_t)(kb + NWAVES) * 1024); n1 = *(const GAS bf16x8*)(kp + (size_t)(kb + NWAVES) * 1024 + 32); }
#pragma unroll
            for (int g = 0; g < 2; ++g) {
                f32x4 sc = {0.f, 0.f, 0.f, 0.f};
#pragma unroll
                for (int h = 0; h < 8; ++h) {
                    f32x4 acc = __builtin_amdgcn_mfma_f32_16x16x32_bf16(a0, qb[g][h][0], (f32x4){0.f, 0.f, 0.f, 0.f}, 0, 0, 0);
                    acc = __builtin_amdgcn_mfma_f32_16x16x32_bf16(a1, qb[g][h][1], acc, 0, 0, 0);
#pragma unroll
                    for (int r = 0; r < 4; ++r) sc[r] = fmaf(wv[g][h], fmaxf(acc[r], 0.f), sc[r]);
                }
                *(LAS v2u*)(F.lds + L_SC + ((16 * g + fr) * SC_RS + 16 * kb + 4 * fq) * 2) = (v2u){key16x2(sc[0], sc[1]), key16x2(sc[2], sc[3])};
            }
            a0 = n0; a1 = n1;
        }
    }
    __syncthreads();
    if (FV == 3) return;
    const int nper = (nqmask + 1) >> 3;
#pragma unroll 1
    for (int qq = 0; qq < nper; ++qq) {
        const int q = nper * wave + qq;
        if (nt <= 8) f1_select<8, FV>(F.lds, lane, q, n, nt);
        else if (nt <= 16) f1_select<16, FV>(F.lds, lane, q, n, nt);
        else if (nt <= 24) f1_select<24, FV>(F.lds, lane, q, n, nt);
        else f1_select<33, FV>(F.lds, lane, q, n, nt);
    }
}

__device__ __forceinline__ void glds16(const void* gsrc, unsigned lds_dst) { unsigned keep;
    asm volatile("s_mov_b32 %0, m0\n\ts_mov_b32 m0, %2\n\ts_nop 0\n\tglobal_load_lds_dwordx4 %1, off\n\ts_mov_b32 m0, %0" : "=&s"(keep) : "v"(gsrc), "s"(lds_dst) : "memory"); }
template <int V2 = 0> __device__ __forceinline__ void f2_unit(Frame& F, const float* relb, const bf16* Qrows, int nqmask, const bf16* Kg, const bf16* Vg, int ntiles, int qpos0, int near_from, bool allsel, bf16* Orows, int nq_store) {
    int tid_ = F.tid; asm volatile("" : "+v"(tid_));
    const int tid = tid_, lane = tid & 63, h = __builtin_amdgcn_readfirstlane(tid >> 6), jk = h >> 2, qcol = lane & 31, hi = lane >> 5, qi = qcol & nqmask;
    bf16x8 qf[4];
#pragma unroll
    for (int ks = 0; ks < 4; ++ks) qf[ks] = *(const GAS bf16x8*)(Qrows + qi * 512 + h * 64 + 16 * ks + 8 * hi);
    const int drow = lane >> 4, dslot = lane & 15; const unsigned ldsbase = (unsigned)(size_t)F.lds;
    size_t ksrc[2], vsrc[2];
#pragma unroll
    for (int i = 0; i < 2; ++i) { const int row = 4 * (2 * h + i) + drow;
        ksrc[i] = (size_t)row * 128 + (size_t)((dslot ^ (row & 15)) * 8); vsrc[i] = (size_t)row * 128 + (size_t)(((((dslot >> 2) ^ (row & 3)) << 2) | (dslot & 3)) * 8); }
#define ATT_DMA(kt_, slot_) do { _Pragma("unroll") for (int i_ = 0; i_ < 2; ++i_) { \
        glds16(Kg + (size_t)(kt_) * 8192 + ksrc[i_], (unsigned)__builtin_amdgcn_readfirstlane((int)(ldsbase + L_K + (slot_) * SLOT + (2 * h + i_) * 1024))); \
        glds16(Vg + (size_t)(kt_) * 8192 + vsrc[i_], (unsigned)__builtin_amdgcn_readfirstlane((int)(ldsbase + L_V + (slot_) * SLOT + (2 * h + i_) * 1024))); } } while (0)
    ATT_DMA(0, 0);
    if (ntiles > 1) { ATT_DMA(1, 1); asm volatile("s_waitcnt vmcnt(4)" ::: "memory"); } else asm volatile("s_waitcnt vmcnt(0)" ::: "memory");
    __builtin_amdgcn_s_barrier();
    f32x16 o[2]; o[0] = (f32x16){}; o[1] = (f32x16){};
    float m = 0.f, l = 0.f;
    const float bconst = relb[15 * 8 + h] * LOG2E;
    LAS float* wsf = (LAS float*)(F.lds + L_WS) + h * 64;
    const LAS float* biasl = (const LAS float*)(F.lds + L_BIAS) + h * 256;
    const LAS unsigned long long* mrow = (const LAS unsigned long long*)(F.lds + L_MSK) + qi * 33;
    int koff[4];
#pragma unroll
    for (int ks = 0; ks < 4; ++ks) koff[ks] = (lane & 31) * 256 + (((jk * 8 + 2 * ks + hi) ^ (lane & 15)) * 16);
    int voff[2];
#pragma unroll
    for (int db = 0; db < 2; ++db) voff[db] = (4 * hi + ((lane & 15) >> 2)) * 256 + (((jk * 2 + db) ^ ((lane & 15) >> 2)) * 64) + 32 * ((lane >> 4) & 1) + 8 * (lane & 3);
    int s_cur = 0, s_nxt2 = 2;
#pragma unroll 1
    for (int kt = 0; kt < ntiles; ++kt) {
        if (kt + 2 < ntiles) ATT_DMA(kt + 2, s_nxt2);
        const bool near = kt >= near_from;
        const float cinit = (near ? 0.f : bconst) - m;
        f32x16 p0, p1;
#pragma unroll
        for (int r = 0; r < 16; ++r) { p0[r] = cinit; p1[r] = cinit; }
        const LAS unsigned char* kb_ = F.lds + L_K + s_cur * SLOT;
#pragma unroll
        for (int ks = 0; ks < (V2 == 12 ? 0 : 4); ++ks) {
            const bf16x8 a0 = *(const LAS bf16x8*)(kb_ + koff[ks]), a1 = *(const LAS bf16x8*)(kb_ + koff[ks] + 32 * 256);
            p0 = __builtin_amdgcn_mfma_f32_32x32x16_bf16(a0, qf[ks], p0, 0, 0, 0);
            p1 = __builtin_amdgcn_mfma_f32_32x32x16_bf16(a1, qf[ks], p1, 0, 0, 0);
        }
        asm volatile("s_nop 15\n\ts_nop 7" : "+v"(p0), "+v"(p1));
        if (near) {
            const int rb = 64 * kt - (qpos0 + qi) + 191;
#pragma unroll
            for (int r = 0; r < 16; ++r) { const int k0 = crow(r, hi); p0[r] += biasl[rb + k0]; p1[r] += biasl[rb + k0 + 32]; }
        }
        if (V2 != 11) {
        float mx = max3f(p0[0], p0[1], p1[0]), mx2 = max3f(p0[2], p0[3], p1[1]);
        mx = max3f(mx, p1[2], p1[3]);
#pragma unroll
        for (int r = 4; r < 16; r += 4) { mx = max3f(mx, p0[r], p0[r + 1]); mx2 = max3f(mx2, p0[r + 2], p0[r + 3]); mx = max3f(mx, p1[r], p1[r + 1]); mx2 = max3f(mx2, p1[r + 2], p1[r + 3]); }
        mx = xhalf_max(fmaxf(mx, mx2));
        const bool grew = kt == 0 || __ballot(mx > 0.f) != 0ull;
        float alpha = 1.f;
        if (grew) {
            const float dl = kt == 0 ? mx : fmaxf(mx, 0.f); m += dl; alpha = __builtin_amdgcn_exp2f(-dl);
#pragma unroll
            for (int r = 0; r < 16; ++r) { p0[r] -= dl; p1[r] -= dl; }
        }
#pragma unroll
        for (int r = 0; r < 16; ++r) { p0[r] = __builtin_amdgcn_exp2f(p0[r]); p1[r] = __builtin_amdgcn_exp2f(p1[r]); }
        if (!allsel) {
            const unsigned long long mw = mrow[kt]; const unsigned mlo = (unsigned)mw >> (4 * hi), mhi = (unsigned)(mw >> 32) >> (4 * hi);
#pragma unroll
            for (int r = 0; r < 16; ++r) { p0[r] = maskp(p0[r], mlo, (r & 3) + 8 * (r >> 2)); p1[r] = maskp(p1[r], mhi, (r & 3) + 8 * (r >> 2)); }
        }
        float rs = 0.f;
#pragma unroll
        for (int r = 0; r < 16; ++r) rs += p0[r] + p1[r];
        rs = xhalf_sum(rs);
        l = l * alpha + rs;
        if (grew) {
            if (hi == 0) wsf[qcol] = alpha;
            LDS_WAIT(); __builtin_amdgcn_wave_barrier();
#pragma unroll
            for (int r = 0; r < 16; ++r) { const float al = wsf[crow(r, hi)]; o[0][r] *= al; o[1][r] *= al; }
        }
        }
        bf16x8 pa[2][2];
#pragma unroll
        for (int s = 0; s < 2; ++s) {
            v4u w0, w1;
            w0.x = cvtpk(p0[8 * s + 0], p0[8 * s + 1]); w0.y = cvtpk(p0[8 * s + 2], p0[8 * s + 3]); w0.z = cvtpk(p0[8 * s + 4], p0[8 * s + 5]); w0.w = cvtpk(p0[8 * s + 6], p0[8 * s + 7]);
            w1.x = cvtpk(p1[8 * s + 0], p1[8 * s + 1]); w1.y = cvtpk(p1[8 * s + 2], p1[8 * s + 3]); w1.z = cvtpk(p1[8 * s + 4], p1[8 * s + 5]); w1.w = cvtpk(p1[8 * s + 6], p1[8 * s + 7]);
            pa[0][s] = __builtin_bit_cast(bf16x8, w0); pa[1][s] = __builtin_bit_cast(bf16x8, w1);
        }
        const LAS unsigned char* vb_ = F.lds + L_V + s_cur * SLOT;
#pragma unroll
        for (int db = 0; db < (V2 == 10 ? 0 : 2); ++db)
#pragma unroll
            for (int kb = 0; kb < 2; ++kb)
#pragma unroll
                for (int s = 0; s < 2; ++s) {
                    const LAS unsigned char* vp = vb_ + voff[db] + (32 * kb + 16 * s) * 256;
                    const s16x4 lo = vtr(vp), hh = vtr(vp + 8 * 256);
                    const bf16x8 vf = (bf16x8){lo[0], lo[1], lo[2], lo[3], hh[0], hh[1], hh[2], hh[3]};
                    o[db] = __builtin_amdgcn_mfma_f32_32x32x16_bf16(pa[kb][s], vf, o[db], 0, 0, 0);
                }
        if (kt + 2 < ntiles) asm volatile("s_waitcnt vmcnt(4) lgkmcnt(0)" ::: "memory"); else asm volatile("s_waitcnt vmcnt(0) lgkmcnt(0)" ::: "memory");
        __builtin_amdgcn_s_barrier();
        s_cur = (s_cur == 2) ? 0 : s_cur + 1; s_nxt2 = (s_nxt2 == 2) ? 0 : s_nxt2 + 1;
    }
#undef ATT_DMA
    if (hi == 0) wsf[32 + qcol] = 1.0f / l;
    LDS_WAIT(); __builtin_amdgcn_wave_barrier();
    LAS bf16* stg = (LAS bf16*)(F.lds + L_OST) + h * 2048;
#pragma unroll
    for (int r = 0; r < 16; ++r) { const int orow = crow(r, hi); const float li = wsf[32 + orow];
        stg[orow * 64 + qcol] = (bf16)f2bf(o[0][r] * li); stg[orow * 64 + 32 + qcol] = (bf16)f2bf(o[1][r] * li); }
    LDS_WAIT(); __builtin_amdgcn_wave_barrier();
#pragma unroll
    for (int i = 0; i < 4; ++i) { const int row = i * 8 + (lane >> 3), ch = lane & 7; const v4u v = *(const LAS v4u*)(stg + row * 64 + ch * 8);
        if (row < nq_store) *(GAS v4u*)(Orows + (size_t)row * 512 + h * 64 + ch * 8) = v; }
}

template <int VAR = 0> __device__ __forceinline__ void attn_phase(Frame& F, CArgsP a, int qslot = 0) {
    unsigned char* ws = a->ws; const float* relb = a->in[7];
    for (int e = F.tid; e < 8 * 256; e += NTHREADS) { const int h = e >> 8, idx = e & 255; ((LAS float*)(F.lds + L_BIAS))[e] = relb[t5_bucket(idx - 191) * 8 + h] * LOG2E; }
    unsigned* qhead = (unsigned*)(ws + WS_CTL) + CW_QUEUE + 64 * qslot;
    for (;;) {
        __syncthreads();
        if (F.tid == 0) *(LAS unsigned*)(F.lds + L_Q) = atomicAdd(qhead, 1u);
        __syncthreads();
        const int u = (int)*(LAS volatile unsigned*)(F.lds + L_Q);
        if (u >= N_UNITS) break;
        if (u < 32) {
            const int b = u; const size_t m0 = MP + (size_t)b * DSEQ;
            if (VAR != 2 && VAR < 10) f1_block<VAR>(F, (const bf16*)(ws + WS_QIB) + m0 * 512, (const float*)(ws + WS_WI) + m0 * 8, 15, (const bf16*)(ws + WS_KIS) + (size_t)b * LSP * 64, LS, 33);
            __syncthreads();
            if (VAR == 0 || VAR == 2 || VAR >= 10) f2_unit<VAR>(F, relb, (const bf16*)(ws + WS_QB) + m0 * 512, 15, (const bf16*)(ws + WS_KS) + (size_t)b * LSP * 128, (const bf16*)(ws + WS_VS) + (size_t)b * LSP * 128, 33, PAST, 30, false,
                    (bf16*)(ws + WS_ATT) + m0 * 512, 16);
        } else {
            const int v = u - 32, qc = 31 - (v >> 4), b = (v >> 1) & 7, half = v & 1;
            const int t0 = 64 * qc + 32 * half; const size_t m0 = (size_t)b * SEQ + t0; const int n = 64 * (qc + 1);
            const bool allsel = qc < 4;
            if (!allsel && VAR != 2 && VAR < 10) {
                f1_block<VAR>(F, (const bf16*)(ws + WS_QIB) + m0 * 512, (const float*)(ws + WS_WI) + m0 * 8, 31, (const bf16*)(ws + WS_KIBP) + (size_t)b * SEQ * 64, n, qc + 1);
                __syncthreads();
            }
            if (VAR == 0 || VAR == 2 || VAR >= 10) f2_unit<VAR>(F, relb, (const bf16*)(ws + WS_QB) + m0 * 512, 31, (const bf16*)(ws + WS_KBP) + (size_t)b * SEQ * 128, (const bf16*)(ws + WS_VBP) + (size_t)b * SEQ * 128, qc + 1, t0, qc - 2, allsel,
                    (bf16*)(ws + WS_ATT) + m0 * 512, 32);
        }
    }
}
}

namespace rw {
constexpr int NCH = 2304;
constexpr int RS = 72;
constexpr int L_KKG = 0, L_BI = 9216, L_KI = 18432, L_RG = 27648, L_BGT = 36864, L_KGT = 46080, L_VT = 55296, L_GC = 64512;
constexpr int L_WL = 64768, L_AL = 82176, L_GG = 99584;
constexpr int L_LM = 64768, L_AKK = 73984, L_BRB = 83200, L_BRK = 92416, L_ADG = 101632;
constexpr int L_TW = 116992, L_AO = 126208, L_SG = 135424;
constexpr int L_LC = 116992;
constexpr int L_PAR = 152832;
static_assert(L_PAR + (7 * 64 + 448) * 4 <= MISC_OFF, "rwkv LDS map");
typedef float f32x2 __attribute__((ext_vector_type(2)));

__device__ __forceinline__ f32x4 mfma16(bf16x8 a, bf16x8 b, f32x4 c) { return __builtin_amdgcn_mfma_f32_16x16x32_bf16(a, b, c, 0, 0, 0); }
__device__ __forceinline__ bf16x8 ldsfrag(const LAS unsigned char* base, int row, int rs_elems, int col) { return *(const LAS bf16x8*)(base + (row * rs_elems + col) * 2); }
__device__ __forceinline__ bf16x8 ldsfrag2(const LAS unsigned char* base, int row, int c0, int c1) {
    const v2u lo = *(const LAS v2u*)(base + (row * RS + c0) * 2); v2u hi = {0u, 0u}; if (c1 >= 0) hi = *(const LAS v2u*)(base + (row * RS + c1) * 2);
    return __builtin_bit_cast(bf16x8, (v4u){lo.x, lo.y, hi.x, hi.y});
}
typedef short v4i16_r __attribute__((ext_vector_type(4)));
__device__ __forceinline__ v2u vtr2(const LAS unsigned char* p) { return __builtin_bit_cast(v2u, __builtin_amdgcn_ds_read_tr16_b64_v4i16((LAS v4i16_r*)p)); }
__device__ __forceinline__ bf16x8 trfrag2(const LAS unsigned char* base, int lane, int r0, int r1, int col16) {
    const int q = (lane & 15) >> 2, p = lane & 3; const v2u lo = vtr2(base + ((r0 + q) * RS + col16 + 4 * p) * 2), hi = vtr2(base + ((r1 + q) * RS + col16 + 4 * p) * 2);
    return __builtin_bit_cast(bf16x8, (v4u){lo.x, lo.y, hi.x, hi.y});
}
__device__ __forceinline__ bf16x8 accfrag(f32x4 lo, f32x4 hi) { return __builtin_bit_cast(bf16x8, (v4u){pk2(lo.x, lo.y), pk2(lo.z, lo.w), pk2(hi.x, hi.y), pk2(hi.z, hi.w)}); }
__device__ __forceinline__ void st8bf(LAS unsigned char* p, const float (&x)[8]) { *(LAS v4u*)p = (v4u){pk2(x[0], x[1]), pk2(x[2], x[3]), pk2(x[4], x[5]), pk2(x[6], x[7])}; }
__device__ __forceinline__ void ld8f(const float* p, float (&x)[8]) { const f32x4 a = *(const GAS f32x4*)p, b = *(const GAS f32x4*)(p + 4); x[0] = a.x; x[1] = a.y; x[2] = a.z; x[3] = a.w; x[4] = b.x; x[5] = b.y; x[6] = b.z; x[7] = b.w; }
__device__ __forceinline__ void ld8bf(const bf16* p, float (&x)[8]) { const v4u w = *(const GAS v4u*)p; x[0] = bflo(w.x); x[1] = bfhi(w.x); x[2] = bflo(w.y); x[3] = bfhi(w.y); x[4] = bflo(w.z); x[5] = bfhi(w.z); x[6] = bflo(w.w); x[7] = bfhi(w.w); }

__device__ __forceinline__ void unpack8(v4u w, float (&x)[8]) { x[0] = bflo(w.x); x[1] = bfhi(w.x); x[2] = bflo(w.y); x[3] = bfhi(w.y); x[4] = bflo(w.z); x[5] = bfhi(w.z); x[6] = bflo(w.w); x[7] = bfhi(w.w); }
__device__ __forceinline__ int grp_col(int g, int h, int j0) { return g < 3 ? 512 * g + h * 64 + j0 : (g < 5 ? 1536 + 64 * (g - 3) + j0 : 1664 + 64 * (g - 5) + j0); }

template <int STOP = 99> __device__ __forceinline__ void r1_unit(Frame& F, CArgsP a, int ch) {
    unsigned char* ws = a->ws; LAS unsigned char* lds = F.lds;
    int tid_ = F.tid; asm volatile("" : "+v"(tid_));
    const int tid = tid_, lane = tid & 63, w = __builtin_amdgcn_readfirstlane(tid >> 6), fr = lane & 15, fq = lane >> 4;
    const bool smp = ch >= 2048; const int h = ch & 7; const int sb = (ch - 2048) >> 3;
    const int pb = ch >> 8, pc = (ch >> 3) & 31;
    const size_t mbase = smp ? (size_t)MP + (size_t)sb * DSEQ : (size_t)pb * SEQ + (size_t)pc * 64;
    const bf16* P = (const bf16*)(ws + WS_P);
    const int t = tid >> 3, s8 = tid & 7, j0 = 8 * s8;
    const bool valid = !smp || t < DSEQ;
    const size_t m = mbase + (valid ? t : 0);
    const int prevkind = (t > 0 || (!smp && pc > 0)) ? 0 : (smp ? 2 : 1);
    float xr[8], xk[8], xv[8];
    bf16x8 bwd[2][2], bwa[2][2], bwg[2][4];
    {
        const bf16* WdT = (const bf16*)(ws + WS_WT_D); const bf16* WaT = (const bf16*)(ws + WS_WT_A); const bf16* WgT = (const bf16*)(ws + WS_WT_G);
#pragma unroll
        for (int q = 0; q < 2; ++q) { const int nrow = h * 64 + 16 * (2 * (w & 1) + q) + fr;
#pragma unroll
            for (int ks = 0; ks < 2; ++ks) { bwd[q][ks] = *(const GAS bf16x8*)(WdT + (size_t)nrow * 64 + 32 * ks + 8 * fq); bwa[q][ks] = *(const GAS bf16x8*)(WaT + (size_t)nrow * 64 + 32 * ks + 8 * fq); }
#pragma unroll
            for (int ks = 0; ks < 4; ++ks) bwg[q][ks] = *(const GAS bf16x8*)(WgT + (size_t)nrow * 128 + 32 * ks + 8 * fq); }
    }
    {
        v4u pc_[7], pp_[7];
#pragma unroll
        for (int g = 0; g < 7; ++g) { const int col = grp_col(g, h, j0); pc_[g] = *(const GAS v4u*)(P + m * RWC + col);
            if (prevkind == 0) pp_[g] = *(const GAS v4u*)(P + (m - 1) * RWC + col); else pp_[g] = (v4u){0u, 0u, 0u, 0u}; }
        const LAS float* mul = (const LAS float*)(lds + L_PAR) + 7 * 64;
#pragma unroll
        for (int g = 0; g < 7; ++g) {
            float p[8], pv[8], x[8]; unpack8(pc_[g], p); unpack8(pp_[g], pv);
            if (prevkind == 2) ld8f(a->in[6] + (size_t)sb * RWC + grp_col(g, h, j0), pv);
#pragma unroll
            for (int i = 0; i < 8; ++i) x[i] = p[i] + (pv[i] - p[i]) * mul[64 * g + j0 + i];
            if (g == 0) {
#pragma unroll
                for (int i = 0; i < 8; ++i) xr[i] = x[i]; }
            else if (g == 1) {
#pragma unroll
                for (int i = 0; i < 8; ++i) xk[i] = x[i]; }
            else if (g == 2) {
#pragma unroll
                for (int i = 0; i < 8; ++i) xv[i] = x[i]; }
            else if (g == 3) {
#pragma unroll
                for (int i = 0; i < 8; ++i) x[i] = ftanh(x[i]);
                st8bf(lds + L_TW + (t * RS + j0) * 2, x); }
            else if (g == 4) st8bf(lds + L_AO + (t * RS + j0) * 2, x);
            else {
#pragma unroll
                for (int i = 0; i < 8; ++i) x[i] = sigmoidf_(x[i]);
                st8bf(lds + L_SG + (t * 136 + 64 * (g - 5) + j0) * 2, x); }
        }
    }
    __syncthreads();
    if (STOP == 0) return;
    {
        const int mb = w >> 1;
#pragma unroll
        for (int q = 0; q < 2; ++q) {
            const int nb = 2 * (w & 1) + q;
            f32x4 cw = {0.f, 0.f, 0.f, 0.f}, ca = cw, cg = cw;
#pragma unroll
            for (int ks = 0; ks < 2; ++ks) {
                cw = mfma16(ldsfrag(lds + L_TW, 16 * mb + fr, RS, 32 * ks + 8 * fq), bwd[q][ks], cw);
                ca = mfma16(ldsfrag(lds + L_AO, 16 * mb + fr, RS, 32 * ks + 8 * fq), bwa[q][ks], ca);
            }
#pragma unroll
            for (int ks = 0; ks < 4; ++ks) cg = mfma16(ldsfrag(lds + L_SG, 16 * mb + fr, 136, 32 * ks + 8 * fq), bwg[q][ks], cg);
#pragma unroll
            for (int r = 0; r < 4; ++r) { const int o = ((16 * mb + 4 * fq + r) * 68 + 16 * nb + fr) * 4;
                *(LAS float*)(lds + L_WL + o) = cw[r]; *(LAS float*)(lds + L_AL + o) = ca[r]; *(LAS float*)(lds + L_GG + o) = cg[r]; }
        }
    }
    __syncthreads();
    if (STOP == 1) return;
    float kk[8], kh[8], bb[8], lw[8];
    {
        float w0[8], a0[8], kkp[8], kap[8], rkp[8], lnw[8], lnb[8], wl[8], al[8], gg[8];
        const int cb = h * 64 + j0;
        { const LAS f32x4* par = (const LAS f32x4*)(lds + L_PAR + j0 * 4);
#pragma unroll
          for (int q = 0; q < 2; ++q) { const f32x4 p0_ = par[q], p1_ = par[16 + q], p2_ = par[32 + q], p3_ = par[48 + q], p4_ = par[64 + q], p5_ = par[80 + q], p6_ = par[96 + q];
#pragma unroll
              for (int e = 0; e < 4; ++e) { w0[4 * q + e] = p0_[e]; a0[4 * q + e] = p1_[e]; kkp[4 * q + e] = p2_[e]; kap[4 * q + e] = p3_[e]; rkp[4 * q + e] = p4_[e]; lnw[4 * q + e] = p5_[e]; lnb[4 * q + e] = p6_[e]; } } }
        { const int o = (t * 68 + j0) * 4;
#pragma unroll
          for (int q = 0; q < 2; ++q) { const f32x4 x = *(const LAS f32x4*)(lds + L_WL + o + 16 * q), y = *(const LAS f32x4*)(lds + L_AL + o + 16 * q), z = *(const LAS f32x4*)(lds + L_GG + o + 16 * q);
#pragma unroll
              for (int e = 0; e < 4; ++e) { wl[4 * q + e] = x[e]; al[4 * q + e] = y[e]; gg[4 * q + e] = z[e]; } } }
        float ss = 0.f, bs = 0.f, av[8];
#pragma unroll
        for (int i = 0; i < 8; ++i) {
            const float z = -(w0[i] + wl[i]); const float wv = -fsoftplus(z) - 0.5f;
            lw[i] = valid ? -fexp(wv) : 0.f;
            av[i] = sigmoidf_(a0[i] + al[i]);
            kk[i] = xk[i] * kkp[i]; ss += kk[i] * kk[i];
            kh[i] = xk[i] * (1.0f + (av[i] - 1.0f) * kap[i]);
            bs += xr[i] * kh[i] * rkp[i];
        }
        ss += __shfl_xor(ss, 1); ss += __shfl_xor(ss, 2); ss += __shfl_xor(ss, 4);
        bs += __shfl_xor(bs, 1); bs += __shfl_xor(bs, 2); bs += __shfl_xor(bs, 4);
        const float inv = __builtin_amdgcn_rsqf(fmaxf(ss, 1e-24f));
        float g1[8], e1[8];
#pragma unroll
        for (int i = 0; i < 8; ++i) {
            kk[i] *= inv; bb[i] = kk[i] * av[i];
            g1[i] = lnw[i] * gg[i]; e1[i] = (lnb[i] + bs * xv[i]) * gg[i];
            if (!valid) { kk[i] = 0.f; bb[i] = 0.f; kh[i] = 0.f; xv[i] = 0.f; xr[i] = 0.f; }
        }
        if (valid) {
            *(GAS v4u*)((bf16*)(ws + WS_G1) + m * 512 + cb) = (v4u){pk2(g1[0], g1[1]), pk2(g1[2], g1[3]), pk2(g1[4], g1[5]), pk2(g1[6], g1[7])};
            *(GAS v4u*)((bf16*)(ws + WS_E) + m * 512 + cb) = (v4u){pk2(e1[0], e1[1]), pk2(e1[2], e1[3]), pk2(e1[4], e1[5]), pk2(e1[6], e1[7])};
        }
    }
    __syncthreads();
    *(LAS f32x4*)(lds + L_LC + (t * 68 + j0) * 4) = (f32x4){lw[0], lw[1], lw[2], lw[3]}; *(LAS f32x4*)(lds + L_LC + (t * 68 + j0 + 4) * 4) = (f32x4){lw[4], lw[5], lw[6], lw[7]};
    __syncthreads();
    if (tid < 64) { float cs[64];
#pragma unroll
        for (int tt = 0; tt < 64; ++tt) cs[tt] = *(const LAS float*)(lds + L_LC + (tt * 68 + tid) * 4);
#pragma unroll
        for (int tt = 1; tt < 64; ++tt) cs[tt] += cs[tt - 1];
#pragma unroll
        for (int tt = 0; tt < 64; ++tt) *(LAS float*)(lds + L_LC + (tt * 68 + tid) * 4) = cs[tt]; }
    __syncthreads();
    {
        float kkg[8], bi[8], ki[8], rg[8], bgv[8], kgv[8], Lt8[8], Lp8[8], LN8[8];
#pragma unroll
        for (int q = 0; q < 2; ++q) { const f32x4 x = *(const LAS f32x4*)(lds + L_LC + (t * 68 + j0 + 4 * q) * 4), y = *(const LAS f32x4*)(lds + L_LC + ((t > 0 ? t - 1 : 0) * 68 + j0 + 4 * q) * 4), z = *(const LAS f32x4*)(lds + L_LC + (63 * 68 + j0 + 4 * q) * 4);
#pragma unroll
            for (int e = 0; e < 4; ++e) { Lt8[4 * q + e] = x[e]; Lp8[4 * q + e] = t > 0 ? y[e] : 0.f; LN8[4 * q + e] = z[e]; } }
#pragma unroll
        for (int i = 0; i < 8; ++i) {
            const int j = j0 + i;
            const float Lt = Lt8[i], Lp = Lp8[i], LN = LN8[i];
            const float eI = fexp(-Lt), eT = fexp(Lt), eP = fexp(Lp), eC = fexp(LN - Lt);
            kkg[i] = kk[i] * eP; bi[i] = bb[i] * eI; ki[i] = kh[i] * eI; rg[i] = xr[i] * eT; bgv[i] = bb[i] * eC; kgv[i] = kh[i] * eC;
            if (t == 0) *(LAS float*)(lds + L_GC + j * 4) = fexp(LN);
        }
        st8bf(lds + L_BGT + (t * RS + j0) * 2, bgv); st8bf(lds + L_KGT + (t * RS + j0) * 2, kgv); st8bf(lds + L_VT + (t * RS + j0) * 2, xv);
        st8bf(lds + L_KKG + (t * RS + j0) * 2, kkg); st8bf(lds + L_BI + (t * RS + j0) * 2, bi); st8bf(lds + L_KI + (t * RS + j0) * 2, ki); st8bf(lds + L_RG + (t * RS + j0) * 2, rg);
    }
    __syncthreads();
    if (STOP == 2) return;
    {
        const int mb = w >> 1;
        const bf16x8 ak0 = ldsfrag(lds + L_KKG, 16 * mb + fr, RS, 8 * fq), ak1 = ldsfrag(lds + L_KKG, 16 * mb + fr, RS, 32 + 8 * fq);
        const bf16x8 ar0 = ldsfrag(lds + L_RG, 16 * mb + fr, RS, 8 * fq), ar1 = ldsfrag(lds + L_RG, 16 * mb + fr, RS, 32 + 8 * fq);
#pragma unroll
        for (int q = 0; q < 2; ++q) {
            const int nb = 2 * (w & 1) + q;
            f32x4 abk = {0.f, 0.f, 0.f, 0.f}, akk = abk, brb = abk, brk = abk;
            if (nb <= mb) {
                const bf16x8 bb0 = ldsfrag(lds + L_BI, 16 * nb + fr, RS, 8 * fq), bb1 = ldsfrag(lds + L_BI, 16 * nb + fr, RS, 32 + 8 * fq);
                const bf16x8 bk0 = ldsfrag(lds + L_KI, 16 * nb + fr, RS, 8 * fq), bk1 = ldsfrag(lds + L_KI, 16 * nb + fr, RS, 32 + 8 * fq);
                abk = mfma16(ak0, bb0, abk); abk = mfma16(ak1, bb1, abk); akk = mfma16(ak0, bk0, akk); akk = mfma16(ak1, bk1, akk);
                brb = mfma16(ar0, bb0, brb); brb = mfma16(ar1, bb1, brb); brk = mfma16(ar0, bk0, brk); brk = mfma16(ar1, bk1, brk);
            }
#pragma unroll
            for (int r = 0; r < 4; ++r) {
                const int tt = 16 * mb + 4 * fq + r, tau = 16 * nb + fr; const bool st = tau < tt, inc = tau <= tt;
                const float vabk = st ? abk[r] : 0.f;
                if (nb == mb) *(LAS float*)(lds + L_ADG + ((mb * 16 + 4 * fq + r) * 17 + fr) * 4) = vabk;
                else *(LAS bf16*)(lds + L_LM + (tt * RS + tau) * 2) = (bf16)f2bf(-vabk);
                *(LAS bf16*)(lds + L_AKK + (tt * RS + tau) * 2) = (bf16)f2bf(st ? akk[r] : 0.f);
                *(LAS bf16*)(lds + L_BRB + (tt * RS + tau) * 2) = (bf16)f2bf(inc ? brb[r] : 0.f);
                *(LAS bf16*)(lds + L_BRK + (tt * RS + tau) * 2) = (bf16)f2bf(inc ? brk[r] : 0.f);
            }
        }
    }
    __syncthreads();
    if (STOP == 3) return;
    f32x4 rhs[4];
    if (w == 0) {
        const int I = lane >> 4, c = lane & 15; float x[16];
#pragma unroll
        for (int tt = 0; tt < 16; ++tt) { float s = (tt == c) ? 1.f : 0.f;
#pragma unroll
            for (int tau = 0; tau < tt; ++tau) s -= *(const LAS float*)(lds + L_ADG + ((I * 16 + tt) * 17 + tau) * 4) * x[tau];
            x[tt] = s; }
#pragma unroll
        for (int tt = 0; tt < 16; ++tt) *(LAS bf16*)(lds + L_LM + ((16 * I + tt) * RS + 16 * I + c) * 2) = (bf16)f2bf(x[tt]);
    }
    if (w >= 4) {
        const int ib = w - 4;
        const bf16x8 v0 = trfrag2(lds + L_VT, lane, 8 * fq, 8 * fq + 4, 16 * ib), v1 = trfrag2(lds + L_VT, lane, 32 + 8 * fq, 36 + 8 * fq, 16 * ib);
#pragma unroll
        for (int mb = 0; mb < 4; ++mb) { f32x4 c = {0.f, 0.f, 0.f, 0.f};
            c = mfma16(ldsfrag(lds + L_AKK, 16 * mb + fr, RS, 8 * fq), v0, c); c = mfma16(ldsfrag(lds + L_AKK, 16 * mb + fr, RS, 32 + 8 * fq), v1, c); rhs[mb] = c; }
    } else {
#pragma unroll
        for (int mb = 0; mb < 4; ++mb)
#pragma unroll
            for (int r = 0; r < 4; ++r) rhs[mb][r] = bf2f(*(const LAS bf16*)(lds + L_KKG + ((16 * mb + 4 * fq + r) * RS + 16 * w + fr) * 2));
    }
    __syncthreads();
    const f32x4 z4 = {0.f, 0.f, 0.f, 0.f};
    f32x4 X0, X1, X2, X3;
    {
        const LAS unsigned char* LM = lds + L_LM;
        X0 = mfma16(ldsfrag2(LM, fr, 4 * fq, -1), accfrag(rhs[0], z4), z4);
        f32x4 t1 = mfma16(ldsfrag2(LM, 16 + fr, 4 * fq, -1), accfrag(X0, z4), rhs[1]);
        X1 = mfma16(ldsfrag2(LM, 16 + fr, 16 + 4 * fq, -1), accfrag(t1, z4), z4);
        f32x4 t2 = mfma16(ldsfrag2(LM, 32 + fr, 4 * fq, 16 + 4 * fq), accfrag(X0, X1), rhs[2]);
        X2 = mfma16(ldsfrag2(LM, 32 + fr, 32 + 4 * fq, -1), accfrag(t2, z4), z4);
        f32x4 t3 = mfma16(ldsfrag2(LM, 48 + fr, 4 * fq, 16 + 4 * fq), accfrag(X0, X1), rhs[3]);
        t3 = mfma16(ldsfrag2(LM, 48 + fr, 32 + 4 * fq, -1), accfrag(X2, z4), t3);
        X3 = mfma16(ldsfrag2(LM, 48 + fr, 48 + 4 * fq, -1), accfrag(t3, z4), z4);
    }
    if (STOP == 5) return;
    if (w < 4) {
        const bf16x8 xb0 = accfrag(X0, X1), xb1 = accfrag(X2, X3);
        bf16* MTg = (bf16*)(ws + WS_MT) + (size_t)ch * 4096; bf16* WYg = (bf16*)(ws + WS_WY) + (size_t)ch * 4096;
#pragma unroll
        for (int mb = 0; mb < 4; ++mb) {
            f32x4 c = mfma16(trfrag2(lds + L_BGT, lane, 4 * fq, 16 + 4 * fq, 16 * mb), xb0, z4); c = mfma16(trfrag2(lds + L_BGT, lane, 32 + 4 * fq, 48 + 4 * fq, 16 * mb), xb1, c);
            f32x4 d = mfma16(ldsfrag2(lds + L_BRB, 16 * mb + fr, 4 * fq, 16 + 4 * fq), xb0, z4); d = mfma16(ldsfrag2(lds + L_BRB, 16 * mb + fr, 32 + 4 * fq, 48 + 4 * fq), xb1, d);
#pragma unroll
            for (int r = 0; r < 4; ++r) { const int row = 16 * mb + 4 * fq + r, col = 16 * w + fr;
                const float mv = ((row == col) ? *(const LAS float*)(lds + L_GC + row * 4) : 0.f) - c[r];
                MTg[row * 64 + col] = (bf16)f2bf(mv);
                WYg[row * 64 + col] = (bf16)f2bf(bf2f(*(const LAS bf16*)(lds + L_RG + (row * RS + col) * 2)) - d[r]); }
        }
    } else {
        const int ib = w - 4;
        const f32x4 n0 = -X0, n1 = -X1, n2 = -X2, n3 = -X3;
        const bf16x8 xb0 = accfrag(n0, n1), xb1 = accfrag(n2, n3);
        const bf16x8 v0 = trfrag2(lds + L_VT, lane, 8 * fq, 8 * fq + 4, 16 * ib), v1 = trfrag2(lds + L_VT, lane, 32 + 8 * fq, 36 + 8 * fq, 16 * ib);
        v2u* NTg = (v2u*)(ws + WS_NT) + ((size_t)ch * 16 + ib * 4) * 64 + lane; v2u* YLg = (v2u*)(ws + WS_YL) + ((size_t)ch * 16 + ib * 4) * 64 + lane;
#pragma unroll
        for (int mb = 0; mb < 4; ++mb) {
            f32x4 c = mfma16(trfrag2(lds + L_KGT, lane, 8 * fq, 8 * fq + 4, 16 * mb), v0, z4); c = mfma16(trfrag2(lds + L_KGT, lane, 32 + 8 * fq, 36 + 8 * fq, 16 * mb), v1, c);
            c = mfma16(trfrag2(lds + L_BGT, lane, 4 * fq, 16 + 4 * fq, 16 * mb), xb0, c); c = mfma16(trfrag2(lds + L_BGT, lane, 32 + 4 * fq, 48 + 4 * fq, 16 * mb), xb1, c);
            f32x4 d = mfma16(ldsfrag(lds + L_BRK, 16 * mb + fr, RS, 8 * fq), v0, z4); d = mfma16(ldsfrag(lds + L_BRK, 16 * mb + fr, RS, 32 + 8 * fq), v1, d);
            d = mfma16(ldsfrag2(lds + L_BRB, 16 * mb + fr, 4 * fq, 16 + 4 * fq), xb0, d); d = mfma16(ldsfrag2(lds + L_BRB, 16 * mb + fr, 32 + 4 * fq, 48 + 4 * fq), xb1, d);
            *(GAS v2u*)(NTg + mb * 64) = (v2u){pk2(c[0], c[1]), pk2(c[2], c[3])};
            *(GAS v2u*)(YLg + mb * 64) = (v2u){pk2(d[0], d[1]), pk2(d[2], d[3])};
        }
    }
    __syncthreads();
}
template <int STOP = 99> __device__ __forceinline__ void r1_phase(Frame& F, CArgsP a) {
    {
        const int h = blockIdx.x & 7; LAS float* par = (LAS float*)(F.lds + L_PAR);
        const int pidx[7] = {12, 14, 17, 18, 19, 20, 21};
        for (int e = F.tid; e < 7 * 64; e += NTHREADS) { const int k = e >> 6, j = e & 63; const float* src = k == 0 ? a->in[12] : k == 1 ? a->in[14] : k == 2 ? a->in[17] : k == 3 ? a->in[18] : k == 4 ? a->in[19] : k == 5 ? a->in[20] : a->in[21]; par[e] = src[h * 64 + j]; }
        (void)pidx;
        for (int e = F.tid; e < 448; e += NTHREADS) { const int g = e >> 6, j = e & 63; par[7 * 64 + e] = a->in[11][grp_col(g, h, 0) + j]; }
        __syncthreads();
    }
    for (int u = blockIdx.x; u < NCH; u += F.G) r1_unit<STOP>(F, a, u);
}

__device__ __forceinline__ void r2_task(Frame& F, CArgsP a, int chain, int ib) {
    unsigned char* ws = a->ws; const int lane = F.lane, fr = lane & 15, fq = lane >> 4;
    const bool smp = chain >= 64; const int b = smp ? (chain - 64) >> 3 : chain >> 3, h = chain & 7; const int nchunks = smp ? 1 : 32;
    f32x4 S[4];
    if (smp) { const float* s0 = a->in[5] + (((size_t)b * 8 + h) * 64 + 16 * ib + fr) * 64;
#pragma unroll
        for (int mb = 0; mb < 4; ++mb) S[mb] = *(const GAS f32x4*)(s0 + 16 * mb + 4 * fq); }
    else {
#pragma unroll
        for (int mb = 0; mb < 4; ++mb) S[mb] = (f32x4){0.f, 0.f, 0.f, 0.f}; }
    v2u am[4][4], nt4[4];
#define R2_LOAD(c_) do { const int ch_ = smp ? 2048 + b * 8 + h : (b * 32 + (c_)) * 8 + h; const bf16* MTg_ = (const bf16*)(ws + WS_MT) + (size_t)ch_ * 4096; \
        const v2u* NTg_ = (const v2u*)(ws + WS_NT) + ((size_t)ch_ * 16 + ib * 4) * 64 + lane; \
        _Pragma("unroll") for (int mb = 0; mb < 4; ++mb) { const bf16* row = MTg_ + (16 * mb + fr) * 64; \
            am[mb][0] = *(const GAS v2u*)(row + 4 * fq); am[mb][1] = *(const GAS v2u*)(row + 16 + 4 * fq); am[mb][2] = *(const GAS v2u*)(row + 32 + 4 * fq); am[mb][3] = *(const GAS v2u*)(row + 48 + 4 * fq); \
            nt4[mb] = *(const GAS v2u*)(NTg_ + mb * 64); } } while (0)
    R2_LOAD(0);
#pragma unroll 1
    for (int c = 0; c < nchunks; ++c) {
        const int ch = smp ? 2048 + b * 8 + h : (b * 32 + c) * 8 + h;
        bf16* SN = (bf16*)(ws + WS_SSN) + (size_t)ch * 4096 + (16 * ib + fr) * 64;
#pragma unroll
        for (int mb = 0; mb < 4; ++mb) *(GAS v2u*)(SN + 16 * mb + 4 * fq) = (v2u){pk2(S[mb].x, S[mb].y), pk2(S[mb].z, S[mb].w)};
        const bf16x8 sb0 = accfrag(S[0], S[1]), sb1 = accfrag(S[2], S[3]);
        v2u cm[4][4], cn[4];
#pragma unroll
        for (int mb = 0; mb < 4; ++mb) { cn[mb] = nt4[mb];
#pragma unroll
            for (int q = 0; q < 4; ++q) cm[mb][q] = am[mb][q]; }
        if (c + 1 < nchunks) R2_LOAD(c + 1);
#pragma unroll
        for (int mb = 0; mb < 4; ++mb) {
            f32x4 cc = {bflo(cn[mb].x), bfhi(cn[mb].x), bflo(cn[mb].y), bfhi(cn[mb].y)};
            cc = mfma16(__builtin_bit_cast(bf16x8, (v4u){cm[mb][0].x, cm[mb][0].y, cm[mb][1].x, cm[mb][1].y}), sb0, cc);
            cc = mfma16(__builtin_bit_cast(bf16x8, (v4u){cm[mb][2].x, cm[mb][2].y, cm[mb][3].x, cm[mb][3].y}), sb1, cc);
            S[mb] = cc;
        }
    }
#undef R2_LOAD
    float* o = a->out + (smp ? O_WKVS : O_WKVP) + (((size_t)b * 8 + h) * 64 + 16 * ib + fr) * 64;
#pragma unroll
    for (int mb = 0; mb < 4; ++mb) *(GAS f32x4*)(o + 16 * mb + 4 * fq) = S[mb];
}
__device__ __forceinline__ void r2_phase(Frame& F, CArgsP a) {
    const int bx = blockIdx.x;
    if (F.wave == 0) { if (bx < 256) r2_task(F, a, bx >> 2, bx & 3); }
    else if (F.wave <= 4) { const int tsk = bx * 4 + (F.wave - 1); if (tsk < 1024) r2_task(F, a, 64 + (tsk >> 2), tsk & 3); }
}

__device__ __forceinline__ void r3_phase(Frame& F, CArgsP a) {
    unsigned char* ws = a->ws; const int lane = F.lane, fr = lane & 15, fq = lane >> 4, mb = F.wave & 3, sub = F.wave >> 2;
    for (int u2 = blockIdx.x; u2 < NCH / 2; u2 += F.G) {
        const int ch = 2 * u2 + sub; const bool smp = ch >= 2048; const int h = ch & 7;
        if (smp && mb > 0) continue;
        const size_t mbase = smp ? (size_t)MP + (size_t)((ch - 2048) >> 3) * DSEQ : (size_t)(ch >> 8) * SEQ + (size_t)((ch >> 3) & 31) * 64;
        const bf16* WYg = (const bf16*)(ws + WS_WY) + (size_t)ch * 4096 + (16 * mb + fr) * 64; const bf16* SN = (const bf16*)(ws + WS_SSN) + (size_t)ch * 4096;
        const bf16x8 a0 = *(const GAS bf16x8*)(WYg + 8 * fq), a1 = *(const GAS bf16x8*)(WYg + 32 + 8 * fq);
        f32x4 y[4];
#pragma unroll
        for (int nb = 0; nb < 4; ++nb) {
            const v2u yl = *(const GAS v2u*)((const v2u*)(ws + WS_YL) + ((size_t)ch * 16 + nb * 4 + mb) * 64 + lane);
            f32x4 c = {bflo(yl.x), bfhi(yl.x), bflo(yl.y), bfhi(yl.y)};
            const bf16* srow = SN + (16 * nb + fr) * 64;
            c = mfma16(a0, *(const GAS bf16x8*)(srow + 8 * fq), c); c = mfma16(a1, *(const GAS bf16x8*)(srow + 32 + 8 * fq), c);
            y[nb] = c;
        }
#pragma unroll
        for (int r = 0; r < 4; ++r) {
            float s = (y[0][r] + y[1][r]) + (y[2][r] + y[3][r]);
            s += __shfl_xor(s, 1); s += __shfl_xor(s, 2); s += __shfl_xor(s, 4); s += __shfl_xor(s, 8);
            const float mean = s * (1.f / 64.f);
            float q = 0.f;
#pragma unroll
            for (int nb = 0; nb < 4; ++nb) { const float d = y[nb][r] - mean; q += d * d; }
            q += __shfl_xor(q, 1); q += __shfl_xor(q, 2); q += __shfl_xor(q, 4); q += __shfl_xor(q, 8);
            const float rstd = 1.0f / sqrtf(q * (1.f / 64.f) + 64e-5f);
            const int tt = 16 * mb + 4 * fq + r;
            if (!smp || tt < DSEQ) {
                const size_t mrow = (mbase + tt) * 512 + h * 64;
#pragma unroll
                for (int nb = 0; nb < 4; ++nb) { const int i = 16 * nb + fr;
                    const float g1 = bf2f(((const bf16*)(ws + WS_G1))[mrow + i]), e1 = bf2f(((const bf16*)(ws + WS_E))[mrow + i]);
                    ((bf16*)(ws + WS_RW))[mrow + i] = (bf16)f2bf((y[nb][r] - mean) * rstd * g1 + e1); }
            }
        }
    }
}
}
#define PHASE2 { att::attn_phase(F, args); }
#define PHASE3 { rw::r1_phase(F, args); }
#define PHASE4 { rw::r2_phase(F, args); }
#define PHASE5 { rw::r3_phase(F, args); }
#define HOST_SEQUENCE RUN_PHASES(0, N_PHASES);

constexpr int N_PHASES = 12;
__global__ void __launch_bounds__(NTHREADS, 2) fwd_kernel(Args args_by_value) {
    CArgsP args = (CArgsP)__builtin_amdgcn_kernarg_segment_ptr();
    extern __shared__ __attribute__((aligned(16))) unsigned char lds[];
    Frame F;
    F.lds = (LAS unsigned char*)lds;
    F.tid = threadIdx.x; F.lane = F.tid & 63; F.wave = __builtin_amdgcn_readfirstlane(F.tid >> 6);
    F.G = gridDim.x; { const int bx = blockIdx.x; F.vcu = (F.G % 8 == 0) ? (bx % 8) * (F.G / 8) + bx / 8 : bx; }
    unsigned char* ws = args->ws;
    const int lo = args->ph_lo, hi = args->ph_hi;
    volatile LAS unsigned* MISC = (volatile LAS unsigned*)(F.lds + MISC_OFF);
    if (F.tid < 64) MISC[F.tid] = 0u;
    __syncthreads();
    XcdBarrier bar = xcd_barrier_post((unsigned*)(ws + WS_CTL) + CW_BAR, MISC + 8);
#define SEAM(k) do { if (IN(k) && IN((k) + 1)) xcd_barrier(bar); } while (0)
#define IN(k) (lo <= (k) && (k) < hi)
#ifndef DUPMASK
#define DUPMASK 0
#endif
#define DUP(k) if (DUPMASK & (1 << (k)))
    bf16* sga_p = (bf16*)args->out; bf16* sgb_p = sga_p + (size_t)MP * DM;

    if (IN(0)) {
#ifdef P0VAR
        p0_prologue<P0VAR>(F, args); xcd_barrier(bar);
#endif
        p0_prologue(F, args); } SEAM(0);
    if (IN(1)) {
        pg8::Gemm g{(const bf16*)(ws + WS_H), (const bf16*)(ws + WS_WT_IN), MT_ROWS, NPAD, DM}; pg8::StaticOrder S; S.init(MT_ROWS, NPAD, F.G, (int)blockIdx.x);
        EpiInProj E{ws, args->out, sga_p, sgb_p};
        pg8::gemm_phase<EpiInProj, pg8::StaticOrder, true, true>(F.lds, g, S, E);
        DUP(1) { xcd_barrier(bar); pg8::gemm_phase<EpiInProj, pg8::StaticOrder, true, true>(F.lds, g, S, E); }
    } SEAM(1);
    if (IN(2)) {
#ifdef ATTVAR
        att::attn_phase<ATTVAR>(F, args, 1); xcd_barrier(bar);
#endif
        PHASE2 } SEAM(2);
    if (IN(3)) {
#ifdef R1STOP
        rw::r1_phase<R1STOP>(F, args); xcd_barrier(bar);
#endif
        PHASE3 DUP(3) { xcd_barrier(bar); PHASE3 } } SEAM(3);
    if (IN(4)) { PHASE4 DUP(4) { xcd_barrier(bar); PHASE4 } } SEAM(4);
    if (IN(5)) { PHASE5 DUP(5) { xcd_barrier(bar); PHASE5 } } SEAM(5);
    if (IN(6)) { PHASE6 DUP(6) { xcd_barrier(bar); PHASE6 } } SEAM(6);
    if (IN(7)) { PHASE7 DUP(7) { xcd_barrier(bar); PHASE7 } } SEAM(7);
#ifdef XBARS
    for (int xb_ = 0; xb_ < XBARS; ++xb_) xcd_barrier(bar);
#endif
    if (IN(8)) { PHASE8 }
    if (IN(9)) { PHASE9 DUP(9) { xcd_barrier(bar); PHASE9 } } SEAM(9);
    if (IN(10)) { DUP(10) { PHASE10DUP xcd_barrier(bar); } PHASE10 } SEAM(10);
    if (IN(11)) { PHASE11 }
#undef IN
}

extern "C" void kernel_launch(void* const* d_in, const int* in_sizes, int n_in, void* d_out, int out_size, void* d_ws, size_t ws_size, hipStream_t stream) {
    static int grid = 0;
    if (grid == 0) {
        if (n_in != 28 || out_size != (int)O_END || ws_size < WS_END) { fprintf(stderr, "kernel_launch: unexpected shapes: n_in %d out %d ws %zu\n", n_in, out_size, ws_size); grid = -1; return; }
        int dev = 0, cus = 0;
        if (hipGetDevice(&dev) != hipSuccess || hipDeviceGetAttribute(&cus, hipDeviceAttributeMultiprocessorCount, dev) != hipSuccess) { grid = -1; return; }
        if (hipFuncSetAttribute((const void*)fwd_kernel, hipFuncAttributeMaxDynamicSharedMemorySize, LDS_BYTES) != hipSuccess) { fprintf(stderr, "kernel_launch: hipFuncSetAttribute failed\n"); grid = -1; return; }
        int per_cu = 0;
        if (hipOccupancyMaxActiveBlocksPerMultiprocessor(&per_cu, (const void*)fwd_kernel, NTHREADS, LDS_BYTES) != hipSuccess || per_cu < 1) fprintf(stderr, "kernel_launch: occupancy query says %d\n", per_cu);
        (void)hipGetLastError();
        grid = cus;
    }
    if (grid < 0) return;
    (void)hipMemsetAsync((char*)d_ws + WS_CTL, 0, CTL_ZERO_BYTES, stream);
    Args a{};
    for (int i = 0; i < 28; ++i) a.in[i] = (const float*)d_in[i];
    a.out = (float*)d_out; a.ws = (unsigned char*)d_ws;
#define RUN_PHASES(lo_, hi_) do { a.ph_lo = (lo_); a.ph_hi = (hi_); hipLaunchKernelGGL(fwd_kernel, dim3(grid), dim3(NTHREADS), LDS_BYTES, stream, a); } while (0)
    HOST_SEQUENCE
#undef RUN_PHASES
}
```
